# Optimizing an MI355X kernel written in HIP

```python
import jax, jax.numpy as jnp
from jax import lax
import numpy as np

D_MODEL = 2048
BATCH = 4
SEQ = 4096
DEPTH = 4

GRID_W = 64
CTX_LEN = 256
CHUNK = 128
ROWS_PER_CHUNK = CHUNK // GRID_W
MIX_W = D_MODEL
A_WIDTH = MIX_W // 2
A_HEADS = 8
A_HEAD_DIM = A_WIDTH // A_HEADS
B_WIDTH = MIX_W - A_WIDTH
B_HEADS = 4
B_DV = B_WIDTH // B_HEADS
B_DK = B_DV // 2
B_KEY_W = B_HEADS * B_DK
GATE_RANK = 16
GATE_TAU = 16.0
FFN_HIDDEN = -(-8 * D_MODEL // (3 * 256)) * 256
P_IN = 2 * A_WIDTH + 2 * B_KEY_W + 2 * B_WIDTH + 2 * GATE_RANK
EPS = 1e-6

kernel_name = 'hybrid_gmlp_gla_prefix_dit'


def rms_norm(x, g):
    xf = x.astype(jnp.float32)
    y = xf * lax.rsqrt(jnp.mean(xf * xf, axis=-1, keepdims=True) + EPS)
    return (y * g.astype(jnp.float32)).astype(x.dtype)


def layer_norm(x, g, b):
    xf = x.astype(jnp.float32)
    mu = jnp.mean(xf, axis=-1, keepdims=True)
    var = jnp.mean(jnp.square(xf - mu), axis=-1, keepdims=True)
    y = (xf - mu) * lax.rsqrt(var + EPS)
    return (y * g.astype(jnp.float32) + b.astype(jnp.float32)).astype(x.dtype)


def modulate(h, shift, scale):
    return h * (1 + scale) + shift


def split_proj(p):
    sizes = (A_WIDTH, A_WIDTH, B_KEY_W, B_KEY_W, B_WIDTH, B_WIDTH, GATE_RANK, GATE_RANK)
    out, start = [], 0
    for s in sizes:
        out.append(p[..., start:start + s])
        start += s
    return out


def spatial_gating(u, v, ln_g, ln_b, w_s, b_s, n_chunks):
    bsz, length, _ = u.shape
    u = jax.nn.gelu(u).reshape(bsz, n_chunks, CHUNK, A_HEADS, A_HEAD_DIM)
    v = jax.nn.gelu(v).reshape(bsz, length, A_HEADS, A_HEAD_DIM)
    v = layer_norm(v, ln_g.reshape(A_HEADS, A_HEAD_DIM), ln_b.reshape(A_HEADS, A_HEAD_DIM))
    v = v.reshape(bsz, n_chunks, CHUNK, A_HEADS, A_HEAD_DIM)
    mixed = jnp.einsum('hij,bnjhd->bnihd', w_s, v) + b_s.T[None, None, :, :, None]
    return (u * mixed).reshape(bsz, length, A_WIDTH)


def gla_prep(q, k, v, d_f, d_b, wd2_f, bd_f, wd2_b, bd_b):
    bsz, length, _ = q.shape
    def heads(t, d):
        return t.astype(jnp.float32).reshape(bsz, length, B_HEADS, d)
    q = heads(q, B_DK) * (B_DK ** -0.5)
    k = heads(k, B_DK)
    v = heads(v, B_DV)
    la_f = heads(jax.nn.log_sigmoid((d_f @ wd2_f + bd_f).astype(jnp.float32)) / GATE_TAU, B_DK)
    la_b = heads(jax.nn.log_sigmoid((d_b @ wd2_b + bd_b).astype(jnp.float32)) / GATE_TAU, B_DK)
    return q, k, v, la_f, la_b


def gla_scan(q, k, v, log_a, s0):
    bsz, length, nh, _ = q.shape
    n = length // CHUNK
    def to_chunks(t):
        return t.reshape(bsz, n, CHUNK, nh, t.shape[-1]).transpose(1, 0, 3, 2, 4)
    tri = jnp.tril(jnp.ones((CHUNK, CHUNK), dtype=bool))[None, None, :, :, None]
    def step(s, inp):
        qc, kc, vc, gc = inp
        b = jnp.cumsum(gc, axis=2)
        b_last = b[:, :, -1:, :]
        rel = jnp.where(tri, b[:, :, :, None, :] - b[:, :, None, :, :], -jnp.inf)
        scores = jnp.einsum('bhid,bhjd,bhijd->bhij', qc, kc, jnp.exp(rel))
        o = jnp.einsum('bhij,bhje->bhie', scores, vc) + jnp.einsum('bhid,bhde->bhie', qc * jnp.exp(b), s)
        s = jnp.exp(b_last[:, :, 0, :, None]) * s + jnp.einsum('bhjd,bhje->bhde', kc * jnp.exp(b_last - b), vc)
        return s, o
    s_fin, o = lax.scan(step, s0, (to_chunks(q), to_chunks(k), to_chunks(v), to_chunks(log_a)))
    o = o.transpose(1, 0, 3, 2, 4).reshape(bsz, length, nh, -1)
    return o, s_fin


def bidir_gla(px, pc):
    qx, kx, vx, fx, bx = px
    qc, kc, vc, fc, bc = pc
    s0 = jnp.zeros((qx.shape[0], B_HEADS, B_DK, B_DV), jnp.float32)
    flip = lambda t: jnp.flip(t, axis=1)
    oc_f, sc_f = gla_scan(qc, kc, vc, fc, s0)
    ox_f, _ = gla_scan(qx, kx, vx, fx, sc_f)
    oc_b, sc_b = gla_scan(flip(qc), flip(kc), flip(vc), flip(bc), s0)
    ox_b, _ = gla_scan(flip(qx), flip(kx), flip(vx), flip(bx), sc_b)
    return ox_f + flip(ox_b), oc_f + flip(oc_b)


def gla_out(o, g, out_g):
    bsz, length = o.shape[:2]
    y = o * lax.rsqrt(jnp.mean(o * o, axis=-1, keepdims=True) + EPS) * out_g.astype(jnp.float32).reshape(B_HEADS, B_DV)
    return y.reshape(bsz, length, B_WIDTH).astype(g.dtype) * jax.nn.silu(g)


def swiglu(h, w_in, w_out):
    a, b = jnp.split(h @ w_in, 2, axis=-1)
    return (jax.nn.silu(a) * b) @ w_out


def trunk_layer(x, xc, c_act, cc_act, w_mod, b_mod, g_pre_mix, g_post_mix, g_pre_ffn, g_post_ffn, w_in, ln_g, ln_b, w_s, b_s, wd2_f, bd_f, wd2_b, bd_b, out_g, w_out, w_ffn_in, w_ffn_out, rows, update_ctx):
    mod_x = jnp.split((c_act @ w_mod + b_mod)[:, None, :], 6, axis=-1)
    mod_c = jnp.split(cc_act @ w_mod + b_mod, 6, axis=-1)
    hx = modulate(rms_norm(x, g_pre_mix), mod_x[0], mod_x[1])
    hc = modulate(rms_norm(xc, g_pre_mix), mod_c[0], mod_c[1])
    ux, vx, qx, kx, vvx, gx, dfx, dbx = split_proj(hx @ w_in)
    uc, vc, qc, kc, vvc, gc, dfc, dbc = split_proj(hc @ w_in)
    gla_x, gla_c = bidir_gla(gla_prep(qx, kx, vvx, dfx, dbx, wd2_f, bd_f, wd2_b, bd_b),
                             gla_prep(qc, kc, vvc, dfc, dbc, wd2_f, bd_f, wd2_b, bd_b))
    a_x = spatial_gating(ux, vx, ln_g, ln_b, w_s, b_s, rows // ROWS_PER_CHUNK)
    y_x = jnp.concatenate([a_x, gla_out(gla_x, gx, out_g)], axis=-1) @ w_out
    x = x + mod_x[2] * rms_norm(y_x, g_post_mix)
    f_x = swiglu(modulate(rms_norm(x, g_pre_ffn), mod_x[3], mod_x[4]), w_ffn_in, w_ffn_out)
    x = x + mod_x[5] * rms_norm(f_x, g_post_ffn)
    if update_ctx:
        a_c = spatial_gating(uc, vc, ln_g, ln_b, w_s, b_s, xc.shape[1] // CHUNK)
        y_c = jnp.concatenate([a_c, gla_out(gla_c, gc, out_g)], axis=-1) @ w_out
        xc = xc + mod_c[2] * rms_norm(y_c, g_post_mix)
        f_c = swiglu(modulate(rms_norm(xc, g_pre_ffn), mod_c[3], mod_c[4]), w_ffn_in, w_ffn_out)
        xc = xc + mod_c[5] * rms_norm(f_c, g_post_ffn)
    return x, xc


def setup_inputs(seed: int = 0) -> dict:
    key = jax.random.key(seed)
    ks = iter(jax.random.split(key, 32))
    f32 = jnp.float32
    def nrm(shape, scale=1.0):
        return jax.random.normal(next(ks), shape, f32) * scale
    def gain(shape):
        return 1.0 + nrm(shape, 0.05)
    L = DEPTH
    return {
        'x': nrm((BATCH, SEQ, D_MODEL)),
        'c': nrm((BATCH, D_MODEL)),
        'ctx': nrm((BATCH, CTX_LEN, D_MODEL)),
        'c_ctx': nrm((D_MODEL,)),
        'w_mod': nrm((L, D_MODEL, 6 * D_MODEL), 0.5 * D_MODEL ** -0.5),
        'b_mod': nrm((L, 6 * D_MODEL), 0.01),
        'g_pre_mix': gain((L, D_MODEL)),
        'g_post_mix': gain((L, D_MODEL)),
        'g_pre_ffn': gain((L, D_MODEL)),
        'g_post_ffn': gain((L, D_MODEL)),
        'w_in': nrm((L, D_MODEL, P_IN), D_MODEL ** -0.5),
        'gmlp_ln_g': gain((L, A_WIDTH)),
        'gmlp_ln_b': nrm((L, A_WIDTH), 0.01),
        'gmlp_ws': nrm((L, A_HEADS, CHUNK, CHUNK), CHUNK ** -0.5),
        'gmlp_bs': gain((L, A_HEADS, CHUNK)),
        'gla_wd2_fwd': nrm((L, GATE_RANK, B_KEY_W), GATE_RANK ** -0.5),
        'gla_bd_fwd': nrm((L, B_KEY_W), 0.1),
        'gla_wd2_bwd': nrm((L, GATE_RANK, B_KEY_W), GATE_RANK ** -0.5),
        'gla_bd_bwd': nrm((L, B_KEY_W), 0.1),
        'gla_out_g': gain((L, B_WIDTH)),
        'w_out': nrm((L, MIX_W, D_MODEL), MIX_W ** -0.5),
        'w_ffn_in': nrm((L, D_MODEL, 2 * FFN_HIDDEN), D_MODEL ** -0.5),
        'w_ffn_out': nrm((L, FFN_HIDDEN, D_MODEL), FFN_HIDDEN ** -0.5),
    }


def reference(x, c, ctx, c_ctx, w_mod, b_mod, g_pre_mix, g_post_mix, g_pre_ffn, g_post_ffn, w_in, gmlp_ln_g, gmlp_ln_b, gmlp_ws, gmlp_bs, gla_wd2_fwd, gla_bd_fwd, gla_wd2_bwd, gla_bd_bwd, gla_out_g, w_out, w_ffn_in, w_ffn_out):
    rows = x.shape[1] // GRID_W
    c_act = jax.nn.silu(c)
    cc_act = jax.nn.silu(c_ctx)
    xc = ctx
    for i in range(DEPTH):
        x, xc = trunk_layer(x, xc, c_act, cc_act, w_mod[i], b_mod[i], g_pre_mix[i], g_post_mix[i], g_pre_ffn[i], g_post_ffn[i], w_in[i], gmlp_ln_g[i], gmlp_ln_b[i], gmlp_ws[i], gmlp_bs[i], gla_wd2_fwd[i], gla_bd_fwd[i], gla_wd2_bwd[i], gla_bd_bwd[i], gla_out_g[i], w_out[i], w_ffn_in[i], w_ffn_out[i], rows, i < DEPTH - 1)
    return x
```

```cpp
#include <hip/hip_runtime.h>
#include <cstdio>
#include <cstdint>
namespace pg8 {
#define PG8_LAS __attribute__((address_space(3)))
typedef unsigned short bf16_t;
typedef short bf16x8 __attribute__((ext_vector_type(8)));
typedef float f32x4 __attribute__((ext_vector_type(4)));
typedef unsigned u32x4 __attribute__((ext_vector_type(4)));
constexpr int BM = 256, BK = 64, HALF = 128, HTB = HALF * BK * 2  , STAGE_BYTES = 8 * HTB, NXCD = 8, WGM = 8;

__host__ __device__ __forceinline__ int lds_byte(int r, int c) { const int st = (r >> 4) * 2 + (c >> 5), rr = r & 15, cc = c & 31, ob = rr * 64 + cc * 2; return st * 1024 + (ob ^ (((ob >> 9) & 1) << 5)); }
__host__ __device__ __forceinline__ void stage_rc(int b, int& R, int& C) { const int st = b / 1024, sb = b % 1024, swz = sb ^ (((sb >> 9) & 1) << 5); R = (st >> 1) * 16 + swz / 64; C = (st & 1) * 32 + (swz % 64) / 2; }
__host__ __device__ __forceinline__ int perm32(int rho) { const int n = rho >> 4, i = rho & 15; return 8 * (i >> 2) + 4 * n + (i & 3); }

struct Unit { int pm, pn; };
struct Gemm { const bf16_t* A; const bf16_t* Bt; int M, N, K, pad; };

struct StaticOrder {
    int nM, nN, nwg, G, c;
    __host__ __device__ void init(int M, int N, int G_, int c_) { nM = M / BM; nN = N / BM; nwg = nM * nN; G = G_; c = c_; }
    __host__ __device__ bool next(int i, Unit& u) const {
        const long L = (long)i * G + c; if (L >= nwg) return false;
        int wgid = (int)L; { const int q = nwg / NXCD, r = nwg % NXCD, xcd = wgid % NXCD, off = wgid / NXCD; wgid = (xcd < r ? xcd * (q + 1) : r * (q + 1) + (xcd - r) * q) + off; }
        const int nig = WGM * nN, gid = wgid / nig, fm = gid * WGM, gsz = (nM - fm) < WGM ? (nM - fm) : WGM;
        u.pm = fm + ((wgid % nig) % gsz); u.pn = (wgid % nig) / gsz; return true;
    }
    __device__ __forceinline__ void a_ready(const Unit&) const {}
    __device__ __forceinline__ void done(const Unit&) const {}
};


__device__ __forceinline__ unsigned cvt_pk_bf16(float lo, float hi) { unsigned r; asm volatile("v_cvt_pk_bf16_f32 %0, %1, %2" : "=v"(r) : "v"(lo), "v"(hi)); return r; }
__device__ __forceinline__ float fast_sigmoid(float x) { return __builtin_amdgcn_rcpf(1.0f + __builtin_amdgcn_exp2f(-1.4426950408889634f * x)); }
__device__ __forceinline__ float gelu_tanh(float x) { const float y = 1.5957691216057308f * (x + 0.044715f * x * x * x); return x * fast_sigmoid(y); }
__device__ __forceinline__ float silu_f(float x) { return x * fast_sigmoid(x); }

struct EpiF32 {
    static constexpr bool PERM = false, AFTER_DRAIN = false;
    float* C; int ldc; int pad;
    __device__ __forceinline__ void operator()(const f32x4 (&acc)[2][2][4][2], const Unit& u, int wr, int wc, int fr, int fq) const {
        const int row0 = u.pm * BM + wr * 64 + fr, col0 = u.pn * BM + wc * 32 + 4 * fq;
#pragma unroll
        for (int ai = 0; ai < 2; ++ai)
#pragma unroll
            for (int m = 0; m < 4; ++m) { float* rowp = C + (size_t)(row0 + ai * HALF + m * 16) * ldc + col0;
#pragma unroll
                for (int bj = 0; bj < 2; ++bj)
#pragma unroll
                    for (int n = 0; n < 2; ++n) *(f32x4*)(rowp + bj * HALF + n * 16) = acc[ai][bj][m][n]; }
    }
};
struct EpiProj {
    static constexpr bool PERM = true, AFTER_DRAIN = false;
    bf16_t* O; int ldc; int ngelu;
    __device__ __forceinline__ void operator()(const f32x4 (&acc)[2][2][4][2], const Unit& u, int wr, int wc, int fr, int fq) const {
        const int row0 = u.pm * BM + wr * 64 + fr, col0 = u.pn * BM + wc * 32 + 8 * fq;
        const bool act = u.pn < ngelu;
#pragma unroll
        for (int ai = 0; ai < 2; ++ai)
#pragma unroll
            for (int m = 0; m < 4; ++m) { bf16_t* rowp = O + (size_t)(row0 + ai * HALF + m * 16) * ldc + col0;
#pragma unroll
                for (int bj = 0; bj < 2; ++bj) { f32x4 v0 = acc[ai][bj][m][0], v1 = acc[ai][bj][m][1];
                    if (act) {
#pragma unroll
                        for (int j = 0; j < 4; ++j) { v0[j] = gelu_tanh(v0[j]); v1[j] = gelu_tanh(v1[j]); } }
                    u32x4 w; w.x = cvt_pk_bf16(v0[0], v0[1]); w.y = cvt_pk_bf16(v0[2], v0[3]); w.z = cvt_pk_bf16(v1[0], v1[1]); w.w = cvt_pk_bf16(v1[2], v1[3]);
                    *(u32x4*)(rowp + bj * HALF) = w; } }
    }
};
struct EpiSwiglu {
    static constexpr bool PERM = true, AFTER_DRAIN = false;
    bf16_t* O; int ldc; int pad;
    __device__ __forceinline__ void operator()(const f32x4 (&acc)[2][2][4][2], const Unit& u, int wr, int wc, int fr, int fq) const {
        const int row0 = u.pm * BM + wr * 64 + fr, col0 = u.pn * HALF + wc * 32 + 8 * fq;
#pragma unroll
        for (int ai = 0; ai < 2; ++ai)
#pragma unroll
            for (int m = 0; m < 4; ++m) { bf16_t* rowp = O + (size_t)(row0 + ai * HALF + m * 16) * ldc + col0;
                f32x4 h0, h1;
#pragma unroll
                for (int j = 0; j < 4; ++j) { h0[j] = silu_f(acc[ai][0][m][0][j]) * acc[ai][1][m][0][j]; h1[j] = silu_f(acc[ai][0][m][1][j]) * acc[ai][1][m][1][j]; }
                u32x4 w; w.x = cvt_pk_bf16(h0[0], h0[1]); w.y = cvt_pk_bf16(h0[2], h0[3]); w.z = cvt_pk_bf16(h1[0], h1[1]); w.w = cvt_pk_bf16(h1[2], h1[3]);
                *(u32x4*)rowp = w; }
    }
};

template <class Epi, class Sched, bool ALIGN_EPI = false, bool SP2 = false>
__device__ __forceinline__ void gemm_phase(PG8_LAS unsigned char* lds, const Gemm g, const Sched& S, const Epi& E) {
    const int tid = threadIdx.x, wid = __builtin_amdgcn_readfirstlane(tid >> 6), lane = tid & 63, wr = wid >> 2, wc = wid & 3, fr = lane & 15, fq = lane >> 4;
    const int K = g.K, nt = K / BK;
    unsigned voffA[2], voffB[2];
#pragma unroll
    for (int i = 0; i < 2; ++i) { int R, C; stage_rc(tid * 16 + i * 8192, R, C); const int Rb = Epi::PERM ? ((R & ~31) + perm32(R & 31)) : R;
        voffA[i] = (unsigned)(R * K + C) * 2u; voffB[i] = (unsigned)(Rb * K + C) * 2u; }
    const size_t kstep = (size_t)(BK * 2);
    const size_t hstep = (size_t)HALF * K * 2;
    const size_t tstep = 2 * hstep;
    const unsigned ldsw = (unsigned)wid * 1024u;
    const int aoff = lds_byte(wr * 64 + fr, fq * 8), boff = lds_byte(wc * 32 + fr, fq * 8);
#define PG8_SA(b, h) (((b) * 2 + (h)) * HTB)
#define PG8_SB(b, h) ((4 + (b) * 2 + (h)) * HTB)
#define PG8_STAGE(bufoff, gbase, voff) do { _Pragma("unroll") for (int _i = 0; _i < 2; ++_i) \
        __builtin_amdgcn_global_load_lds((const unsigned*)((const char*)(gbase) + (voff)[_i]), (PG8_LAS unsigned*)(lds + (bufoff) + ldsw + _i * 8192), 16, 0, 0); } while (0)
#define PG8_LDA(dst, b, h) do { _Pragma("unroll") for (int m = 0; m < 4; ++m) _Pragma("unroll") for (int k = 0; k < 2; ++k) dst[m][k] = *(const PG8_LAS bf16x8*)(lds + PG8_SA(b, h) + aoff + m * 2048 + k * 1024); } while (0)
#define PG8_LDB(dst, b, h) do { _Pragma("unroll") for (int n = 0; n < 2; ++n) _Pragma("unroll") for (int k = 0; k < 2; ++k) dst[n][k] = *(const PG8_LAS bf16x8*)(lds + PG8_SB(b, h) + boff + n * 2048 + k * 1024); } while (0)
#define PG8_MMA(ai, bj, At, Bt) do { __builtin_amdgcn_s_setprio(1); _Pragma("unroll") for (int m = 0; m < 4; ++m) _Pragma("unroll") for (int n = 0; n < 2; ++n) _Pragma("unroll") for (int k = 0; k < 2; ++k) \
        acc[ai][bj][m][n] = __builtin_amdgcn_mfma_f32_16x16x32_bf16(Bt[n][k], At[m][k], acc[ai][bj][m][n], 0, 0, 0); __builtin_amdgcn_s_setprio(0); } while (0)
#define PG8_WAIT_V(n) asm volatile("s_waitcnt vmcnt(" #n ")" ::: "memory")
#define PG8_WAIT_L(n) asm volatile("s_waitcnt lgkmcnt(" #n ")" ::: "memory")
#define PG8_BAR __builtin_amdgcn_s_barrier()
#define PG8_SCHED __builtin_amdgcn_sched_barrier(0)
    Unit cur, nxt; int ui = 0;
    if (!S.next(0, cur)) return;
    f32x4 acc[2][2][4][2];
#pragma unroll
    for (int a = 0; a < 2; ++a)
#pragma unroll
        for (int b = 0; b < 2; ++b)
#pragma unroll
            for (int m = 0; m < 4; ++m)
#pragma unroll
                for (int n = 0; n < 2; ++n) acc[a][b][m][n] = (f32x4){0.f, 0.f, 0.f, 0.f};
    bf16x8 At[4][2], B0[2][2], B1[2][2];
    const char* cA = (const char*)g.A + (size_t)cur.pm * tstep; const char* cB = (const char*)g.Bt + (size_t)cur.pn * tstep;
    S.a_ready(cur);
    if constexpr (SP2) {
        PG8_STAGE(PG8_SB(0, 0), cB, voffB); PG8_STAGE(PG8_SB(0, 1), cB + hstep, voffB); PG8_STAGE(PG8_SA(0, 0), cA, voffA); PG8_STAGE(PG8_SA(0, 1), cA + hstep, voffA);
        if (wr == 1) PG8_BAR;
        PG8_WAIT_V(2); PG8_BAR;
        PG8_STAGE(PG8_SB(1, 0), cB + kstep, voffB); PG8_STAGE(PG8_SA(1, 0), cA + kstep, voffA); PG8_STAGE(PG8_SB(1, 1), cB + hstep + kstep, voffB);
        PG8_WAIT_V(6); PG8_BAR;
    } else {
        PG8_STAGE(PG8_SB(0, 0), cB, voffB); PG8_STAGE(PG8_SA(0, 0), cA, voffA); PG8_STAGE(PG8_SB(0, 1), cB + hstep, voffB); PG8_STAGE(PG8_SA(0, 1), cA + hstep, voffA);
        if (wr == 1) PG8_BAR;
        PG8_WAIT_V(4); PG8_BAR;
        PG8_STAGE(PG8_SB(1, 0), cB + kstep, voffB); PG8_STAGE(PG8_SA(1, 0), cA + kstep, voffA); PG8_STAGE(PG8_SB(1, 1), cB + hstep + kstep, voffB);
        PG8_WAIT_V(6); PG8_BAR;
    }
    for (;;) {
        const bool has_next = S.next(ui + 1, nxt);
        const char* nA = has_next ? (const char*)g.A + (size_t)nxt.pm * tstep : cA; const char* nB = has_next ? (const char*)g.Bt + (size_t)nxt.pn * tstep : cB;
        for (int t = 0; t < nt; t += 2) {
            const bool last = (t == nt - 2);
            const char* a1 = cA + (size_t)(t + 1) * kstep;
            const char* a2 = last ? nA : cA + (size_t)(t + 2) * kstep; const char* b2 = last ? nB : cB + (size_t)(t + 2) * kstep;
            const char* a3 = a2 + kstep; const char* b3 = b2 + kstep;
            if (last && has_next) S.a_ready(nxt);
            if constexpr (SP2) {
            PG8_LDB(B0, 0, 0); PG8_LDB(B1, 0, 1); PG8_SCHED; PG8_LDA(At, 0, 0); PG8_STAGE(PG8_SA(1, 1), a1 + hstep, voffA);
            PG8_WAIT_V(8); PG8_WAIT_L(0); PG8_BAR; PG8_MMA(0, 0, At, B0); PG8_MMA(0, 1, At, B1); PG8_BAR; PG8_SCHED;
            PG8_LDA(At, 0, 1); PG8_STAGE(PG8_SB(0, 0), b2, voffB); PG8_STAGE(PG8_SB(0, 1), b2 + hstep, voffB); PG8_STAGE(PG8_SA(0, 0), a2, voffA);
            PG8_WAIT_V(8); PG8_WAIT_L(0); PG8_BAR; PG8_MMA(1, 0, At, B0); PG8_MMA(1, 1, At, B1); PG8_BAR; PG8_SCHED;
            PG8_LDB(B0, 1, 0); PG8_LDB(B1, 1, 1); PG8_SCHED; PG8_LDA(At, 1, 0); PG8_STAGE(PG8_SA(0, 1), a2 + hstep, voffA);
            PG8_WAIT_V(8); PG8_WAIT_L(0); PG8_BAR; PG8_MMA(0, 0, At, B0); PG8_MMA(0, 1, At, B1); PG8_BAR; PG8_SCHED;
            PG8_LDA(At, 1, 1); PG8_STAGE(PG8_SB(1, 0), b3, voffB); PG8_STAGE(PG8_SB(1, 1), b3 + hstep, voffB); PG8_STAGE(PG8_SA(1, 0), a3, voffA);
            PG8_WAIT_V(8); PG8_WAIT_L(0); PG8_BAR; PG8_MMA(1, 0, At, B0); PG8_MMA(1, 1, At, B1); PG8_BAR; PG8_SCHED;
            } else {
            PG8_LDB(B0, 0, 0); PG8_SCHED; PG8_LDA(At, 0, 0); PG8_STAGE(PG8_SA(1, 1), a1 + hstep, voffA);
            PG8_WAIT_L(8); PG8_BAR; PG8_WAIT_L(0); PG8_MMA(0, 0, At, B0); PG8_BAR; PG8_SCHED;
            PG8_LDB(B1, 0, 1); PG8_STAGE(PG8_SB(0, 0), b2, voffB);
            PG8_BAR; PG8_WAIT_L(0); PG8_MMA(0, 1, At, B1); PG8_BAR;
            PG8_LDA(At, 0, 1); PG8_STAGE(PG8_SA(0, 0), a2, voffA);
            PG8_BAR; PG8_WAIT_L(0); PG8_MMA(1, 0, At, B0); PG8_BAR; PG8_SCHED;
            PG8_STAGE(PG8_SB(0, 1), b2 + hstep, voffB);
            PG8_WAIT_V(6); PG8_BAR; PG8_MMA(1, 1, At, B1); PG8_BAR;
            PG8_LDB(B0, 1, 0); PG8_SCHED; PG8_LDA(At, 1, 0); PG8_STAGE(PG8_SA(0, 1), a2 + hstep, voffA);
            PG8_WAIT_L(8); PG8_BAR; PG8_WAIT_L(0); PG8_MMA(0, 0, At, B0); PG8_BAR; PG8_SCHED;
            PG8_LDB(B1, 1, 1); PG8_STAGE(PG8_SB(1, 0), b3, voffB);
            PG8_BAR; PG8_WAIT_L(0); PG8_MMA(0, 1, At, B1); PG8_BAR;
            PG8_LDA(At, 1, 1); PG8_STAGE(PG8_SA(1, 0), a3, voffA);
            PG8_BAR; PG8_WAIT_L(0); PG8_MMA(1, 0, At, B0); PG8_BAR; PG8_SCHED;
            PG8_STAGE(PG8_SB(1, 1), b3 + hstep, voffB);
            PG8_WAIT_V(6); PG8_BAR; PG8_MMA(1, 1, At, B1); PG8_BAR;
            }
        }
        if constexpr (ALIGN_EPI) { if (wr == 0) PG8_BAR; }
        if constexpr (!Epi::AFTER_DRAIN) { E(acc, cur, wr, wc, fr, fq); S.done(cur); }
        if (!has_next) break;
#pragma unroll
        for (int a = 0; a < 2; ++a)
#pragma unroll
            for (int b = 0; b < 2; ++b)
#pragma unroll
                for (int m = 0; m < 4; ++m)
#pragma unroll
                    for (int n = 0; n < 2; ++n) acc[a][b][m][n] = (f32x4){0.f, 0.f, 0.f, 0.f};
        cur = nxt; cA = nA; cB = nB; ++ui;
        if constexpr (ALIGN_EPI) { if (wr == 1) PG8_BAR; }
    }
    PG8_WAIT_V(0);
    if constexpr (!ALIGN_EPI) { if (wr == 0) PG8_BAR; }
    PG8_BAR;
    if constexpr (Epi::AFTER_DRAIN) { E.fused(acc, cur, wr, wc, fr, fq, lds, wid, lane); S.done(cur); }
#undef PG8_SA
#undef PG8_SB
#undef PG8_STAGE
#undef PG8_LDA
#undef PG8_LDB
#undef PG8_MMA
#undef PG8_WAIT_V
#undef PG8_WAIT_L
#undef PG8_BAR
#undef PG8_SCHED
}
}

#define LAS __attribute__((address_space(3)))
typedef unsigned short bf16;
typedef float f32x4 __attribute__((ext_vector_type(4)));
typedef unsigned u32x4 __attribute__((ext_vector_type(4)));
typedef unsigned u32x2 __attribute__((ext_vector_type(2)));
constexpr int D = 2048, NB = 4, SEQ = 4096, NL = 4, CTX = 256, CH = 128;
constexpr int MX = NB * SEQ, MC = NB * CTX, M = MX + MC;
constexpr int PIN = 5152, NP = 5376, FF = 5632, NMOD = 6 * D;
constexpr int C_U = 0, C_V = 1024, C_Q = 2048, C_K = 2560, C_VV = 3072, C_G = 4096, C_DF = 5120, C_DB = 5136;
constexpr int NCHUNK = M / CH;
constexpr float EPS = 1e-6f;
constexpr size_t MiB = 1u << 20;
constexpr size_t WS_CTL = 0, WS_MOD = 1 * MiB, WS_WIN = 2 * MiB, WS_WOUT = WS_WIN + 84 * MiB, WS_WFI = WS_WOUT + 32 * MiB, WS_WFO = WS_WFI + 176 * MiB,
                 WS_X = WS_WFO + 88 * MiB, WS_H = WS_X + 136 * MiB, WS_P = WS_H + 68 * MiB, WS_CAT = WS_P + 179 * MiB, WS_Y = WS_CAT + 68 * MiB, WS_HID = WS_Y + 136 * MiB,
                 WS_AF = WS_HID + 187 * MiB, WS_AB = WS_AF + 34 * MiB, WS_OF = WS_AB + 34 * MiB, WS_OB = WS_OF + 68 * MiB, WS_END = WS_OB + 68 * MiB;
static_assert((size_t)NL * NP * D * 2 <= 84 * MiB && (size_t)NL * 2 * FF * D * 2 <= 176 * MiB && (size_t)NL * D * FF * 2 <= 88 * MiB && (size_t)M * NP * 2 <= 179 * MiB && (size_t)M * FF * 2 <= 187 * MiB, "ws map");

__device__ __forceinline__ float bf2f(bf16 b) { return __uint_as_float(((unsigned)b) << 16); }
__device__ __forceinline__ unsigned f2bf(float f) { unsigned u = __float_as_uint(f); return (u + 0x7fffu + ((u >> 16) & 1u)) >> 16; }
__device__ __forceinline__ unsigned pk2(float lo, float hi) { return f2bf(lo) | (f2bf(hi) << 16); }
__device__ __forceinline__ float wave_sum(float v) {
#pragma unroll
    for (int o = 1; o < 64; o <<= 1) v += __shfl_xor(v, o);
    return v;
}
__device__ __forceinline__ float sigmoid_acc(float x) { return 1.0f / (1.0f + __expf(-x)); }
__device__ __forceinline__ float silu_acc(float x) { return x * sigmoid_acc(x); }
__device__ __forceinline__ float log_sigmoid(float z) { return fminf(z, 0.f) - log1pf(__expf(-fabsf(z))); }
__device__ __forceinline__ int mod_row(int row) { return row < MX ? row / SEQ : NB; }

__device__ __forceinline__ int map_col(int mode, int r) {
    if (mode == 0) return r;
    if (mode == 1) return r < PIN ? r : -1;
    const int pn = r >> 8, rr = r & 255; return rr < 128 ? pn * 128 + rr : FF + pn * 128 + (rr - 128);
}
__global__ void __launch_bounds__(256) k_wconv(const float* W, bf16* T, int K, int Nsrc, int Ndst, int mode) {
    __shared__ float tile[64][65];
    const int n0 = blockIdx.x * 64, k0 = blockIdx.y * 64, l = blockIdx.z, tid = threadIdx.x;
    W += (size_t)l * K * Nsrc; T += (size_t)l * Ndst * K;
    { const int nn = tid & 63, c = map_col(mode, n0 + nn);
#pragma unroll
      for (int i = 0; i < 16; ++i) { const int kk = (tid >> 6) + 4 * i; tile[kk][nn] = c >= 0 ? W[(size_t)(k0 + kk) * Nsrc + c] : 0.f; } }
    __syncthreads();
    { const int nn = tid >> 2, kq = (tid & 3) * 16; u32x4 o0, o1;
      o0.x = pk2(tile[kq + 0][nn], tile[kq + 1][nn]); o0.y = pk2(tile[kq + 2][nn], tile[kq + 3][nn]); o0.z = pk2(tile[kq + 4][nn], tile[kq + 5][nn]); o0.w = pk2(tile[kq + 6][nn], tile[kq + 7][nn]);
      o1.x = pk2(tile[kq + 8][nn], tile[kq + 9][nn]); o1.y = pk2(tile[kq + 10][nn], tile[kq + 11][nn]); o1.z = pk2(tile[kq + 12][nn], tile[kq + 13][nn]); o1.w = pk2(tile[kq + 14][nn], tile[kq + 15][nn]);
      u32x4* dst = (u32x4*)(T + (size_t)(n0 + nn) * K + k0 + kq); dst[0] = o0; dst[1] = o1; }
}

__global__ void __launch_bounds__(256) k_mod(const float* c, const float* cctx, const float* wmod, const float* bmod, float* MOD) {
    __shared__ float act[5][D];
    const int tid = threadIdx.x, l = blockIdx.y, j = blockIdx.x * 256 + tid;
    for (int i = tid; i < 5 * D; i += 256) { const int r = i / D, k = i % D; const float v = r < NB ? c[r * D + k] : cctx[k]; act[r][k] = silu_acc(v); }
    __syncthreads();
    float a0 = 0.f, a1 = 0.f, a2 = 0.f, a3 = 0.f, a4 = 0.f;
    const float* w = wmod + (size_t)l * D * NMOD + j;
#pragma unroll 8
    for (int k = 0; k < D; ++k) { const float x = w[(size_t)k * NMOD]; a0 += act[0][k] * x; a1 += act[1][k] * x; a2 += act[2][k] * x; a3 += act[3][k] * x; a4 += act[4][k] * x; }
    const float bb = bmod[l * NMOD + j]; float* o = MOD + (size_t)l * 5 * NMOD + j;
    o[0] = a0 + bb; o[NMOD] = a1 + bb; o[2 * NMOD] = a2 + bb; o[3 * NMOD] = a3 + bb; o[4 * NMOD] = a4 + bb;
}

struct RowArgs { const float* xin_x; const float* xin_c; const float* Y; float* X; float* out; bf16* H; const float* modA; const float* modB; const float* gA; const float* gB; int mode; int write_h; int to_out; int pad; };
__device__ __forceinline__ void row_pass(const RowArgs& a, int row, int lane) {
    const int mr = mod_row(row);
    const float* xsrc = (a.mode == 2 || a.xin_x == nullptr) ? a.X + (size_t)row * D : (row < MX ? a.xin_x + (size_t)row * D : a.xin_c + (size_t)(row - MX) * D);
    f32x4 x[8];
#pragma unroll
    for (int j = 0; j < 8; ++j) x[j] = *(const f32x4*)(xsrc + 4 * lane + 256 * j);
    if (a.mode != 0) {
        const float* yr = a.Y + (size_t)row * D; const float* mg = a.modA + (size_t)mr * NMOD + (a.mode == 1 ? 2 : 5) * D;
        f32x4 y[8]; float ss = 0.f;
#pragma unroll
        for (int j = 0; j < 8; ++j) { y[j] = *(const f32x4*)(yr + 4 * lane + 256 * j); ss += (y[j][0] * y[j][0] + y[j][1] * y[j][1]) + (y[j][2] * y[j][2] + y[j][3] * y[j][3]); }
        const float rstd = rsqrtf(wave_sum(ss) * (1.f / D) + EPS);
#pragma unroll
        for (int j = 0; j < 8; ++j) { const f32x4 g = *(const f32x4*)(a.gA + 4 * lane + 256 * j), mm = *(const f32x4*)(mg + 4 * lane + 256 * j); x[j] = x[j] + mm * (y[j] * rstd * g); }
        float* dst = (a.to_out && row < MX) ? a.out + (size_t)row * D : a.X + (size_t)row * D;
        if (!(a.to_out && row >= MX)) {
#pragma unroll
            for (int j = 0; j < 8; ++j) *(f32x4*)(dst + 4 * lane + 256 * j) = x[j]; }
    }
    if (a.write_h) {
        float ss = 0.f;
#pragma unroll
        for (int j = 0; j < 8; ++j) ss += (x[j][0] * x[j][0] + x[j][1] * x[j][1]) + (x[j][2] * x[j][2] + x[j][3] * x[j][3]);
        const float rstd = rsqrtf(wave_sum(ss) * (1.f / D) + EPS);
        const float* msh = (a.mode == 1 ? a.modA + (size_t)mr * NMOD + 3 * D : a.modB + (size_t)mr * NMOD);
        const float* msc = msh + D;
        bf16* hr = a.H + (size_t)row * D;
#pragma unroll
        for (int j = 0; j < 8; ++j) { const f32x4 g = *(const f32x4*)(a.gB + 4 * lane + 256 * j), sh = *(const f32x4*)(msh + 4 * lane + 256 * j), sc = *(const f32x4*)(msc + 4 * lane + 256 * j);
            const f32x4 h = (x[j] * rstd * g) * (sc + 1.0f) + sh; u32x2 w; w.x = pk2(h[0], h[1]); w.y = pk2(h[2], h[3]); *(u32x2*)(hr + 4 * lane + 256 * j) = w; }
    }
}
__global__ void __launch_bounds__(256) k_rowpass(RowArgs a) {
    const int lane = threadIdx.x & 63, gw = blockIdx.x * 4 + (threadIdx.x >> 6), ngw = gridDim.x * 4;
    for (int row = gw; row < M; row += ngw) row_pass(a, row, lane);
}

__global__ void __launch_bounds__(256) k_gmlp_simple(const bf16* P, bf16* CAT, const float* ln_g, const float* ln_b, const float* ws, const float* bs) {
    __shared__ float vln[CH][CH];
    const int cid = blockIdx.x, h = blockIdx.y, tid = threadIdx.x;
    { const int j = tid >> 1, half = tid & 1; const bf16* vp = P + (size_t)(cid * CH + j) * NP + C_V + h * 128 + half * 64;
      float v[64]; float s = 0.f;
#pragma unroll
      for (int i = 0; i < 8; ++i) { const u32x4 w = *(const u32x4*)(vp + 8 * i);
#pragma unroll
          for (int e = 0; e < 4; ++e) { v[8 * i + 2 * e] = __uint_as_float(w[e] << 16); v[8 * i + 2 * e + 1] = __uint_as_float(w[e] & 0xffff0000u); } }
#pragma unroll
      for (int i = 0; i < 64; ++i) s += v[i];
      s += __shfl_xor(s, 1); const float mu = s * (1.f / 128.f); float q = 0.f;
#pragma unroll
      for (int i = 0; i < 64; ++i) { v[i] -= mu; q += v[i] * v[i]; }
      q += __shfl_xor(q, 1); const float rstd = rsqrtf(q * (1.f / 128.f) + EPS);
#pragma unroll
      for (int i = 0; i < 64; ++i) { const int d = half * 64 + i; vln[j][d] = v[i] * rstd * ln_g[h * 128 + d] + ln_b[h * 128 + d]; } }
    __syncthreads();
    const int d = tid & 127, ig = __builtin_amdgcn_readfirstlane(tid >> 7);
    for (int ii = 0; ii < 64; ++ii) { const int i = ig * 64 + ii; const float* wr = ws + ((size_t)h * CH + i) * CH; float acc = 0.f;
#pragma unroll 16
        for (int j = 0; j < CH; ++j) acc += wr[j] * vln[j][d];
        const size_t row = (size_t)cid * CH + i; const float u = bf2f(P[row * NP + C_U + h * 128 + d]);
        CAT[row * D + h * 128 + d] = (bf16)f2bf(u * (acc + bs[h * CH + i])); }
}

__global__ void __launch_bounds__(256) k_gla_decay(const bf16* P, const float* wd2f, const float* bdf, const float* wd2b, const float* bdb, float* AF, float* AB) {
    __shared__ float dd[4][32];
    const int tid = threadIdx.x, row0 = blockIdx.x * 4;
    if (tid < 128) { const int r = tid >> 5, c = tid & 31; dd[r][c] = bf2f(P[(size_t)(row0 + r) * NP + C_DF + c]); }
    __syncthreads();
    for (int hd = tid; hd < 512; hd += 256) {
        float wf[16], wb[16];
#pragma unroll
        for (int r = 0; r < 16; ++r) { wf[r] = wd2f[r * 512 + hd]; wb[r] = wd2b[r * 512 + hd]; }
        const float bf_ = bdf[hd], bb_ = bdb[hd];
#pragma unroll
        for (int t = 0; t < 4; ++t) { float zf = bf_, zb = bb_;
#pragma unroll
            for (int r = 0; r < 16; ++r) { zf += dd[t][r] * wf[r]; zb += dd[t][16 + r] * wb[r]; }
            AF[(size_t)(row0 + t) * 512 + hd] = __expf(log_sigmoid(zf) * (1.f / 16.f)); AB[(size_t)(row0 + t) * 512 + hd] = __expf(log_sigmoid(zb) * (1.f / 16.f)); }
    }
}
__device__ __forceinline__ int gla_row_of(int step, int b, int dir) { const bool isc = step < CTX; const int tt = isc ? step : step - CTX; const int pos = dir ? ((isc ? CTX - 1 : SEQ - 1) - tt) : tt; return isc ? MX + CTX * b + pos : SEQ * b + pos; }
__global__ void __launch_bounds__(64) k_gla_scan_simple(const bf16* P, const float* AF, const float* AB, float* OF, float* OB) {
    __shared__ __attribute__((aligned(16))) float sq[128]; __shared__ __attribute__((aligned(16))) float sk[128]; __shared__ __attribute__((aligned(16))) float sa[128];
    const int lane = threadIdx.x, eb = blockIdx.x, h = blockIdx.y, b = blockIdx.z >> 1, dir = blockIdx.z & 1, e = eb * 64 + lane;
    const float* A = dir ? AB : AF; float* O = dir ? OB : OF;
    float S[128];
#pragma unroll
    for (int d = 0; d < 128; ++d) S[d] = 0.f;
    const int NSTEP = CTX + SEQ;
#define row_of(step) gla_row_of((step), b, dir)
    float nq[2], nk[2], na[2], nv;
    { const int row = row_of(0); const bf16* pr = P + (size_t)row * NP;
#pragma unroll
      for (int i = 0; i < 2; ++i) { const int d = lane + 64 * i; nq[i] = bf2f(pr[C_Q + h * 128 + d]); nk[i] = bf2f(pr[C_K + h * 128 + d]); na[i] = A[(size_t)row * 512 + h * 128 + d]; }
      nv = bf2f(pr[C_VV + h * 256 + e]); }
    for (int step = 0; step < NSTEP; ++step) {
        const int row = row_of(step);
#pragma unroll
        for (int i = 0; i < 2; ++i) { sq[lane + 64 * i] = nq[i] * 0.08838834764831845f; sk[lane + 64 * i] = nk[i]; sa[lane + 64 * i] = na[i]; }
        const float v = nv;
        __syncthreads();
        if (step + 1 < NSTEP) { const int r2 = row_of(step + 1); const bf16* pr = P + (size_t)r2 * NP;
#pragma unroll
            for (int i = 0; i < 2; ++i) { const int d = lane + 64 * i; nq[i] = bf2f(pr[C_Q + h * 128 + d]); nk[i] = bf2f(pr[C_K + h * 128 + d]); na[i] = A[(size_t)r2 * 512 + h * 128 + d]; }
            nv = bf2f(pr[C_VV + h * 256 + e]); }
        float o = 0.f;
#pragma unroll
        for (int d4 = 0; d4 < 32; ++d4) { const f32x4 a4 = *(const f32x4*)&sa[4 * d4], k4 = *(const f32x4*)&sk[4 * d4], q4 = *(const f32x4*)&sq[4 * d4];
#pragma unroll
            for (int t = 0; t < 4; ++t) { S[4 * d4 + t] = a4[t] * S[4 * d4 + t] + k4[t] * v; o += q4[t] * S[4 * d4 + t]; } }
        O[(size_t)row * 1024 + h * 256 + e] = o;
        __syncthreads();
    }
#undef row_of
}
__global__ void __launch_bounds__(256) k_gla_out_simple(const bf16* P, const float* OF, const float* OB, const float* out_g, bf16* CAT) {
    const int row = blockIdx.x, h = threadIdx.x >> 6, lane = threadIdx.x & 63, e0 = h * 256 + 4 * lane;
    const f32x4 o = *(const f32x4*)(OF + (size_t)row * 1024 + e0) + *(const f32x4*)(OB + (size_t)row * 1024 + e0);
    const float ss = wave_sum((o[0] * o[0] + o[1] * o[1]) + (o[2] * o[2] + o[3] * o[3]));
    const float rstd = rsqrtf(ss * (1.f / 256.f) + EPS);
    const f32x4 g = *(const f32x4*)(out_g + e0); const u32x2 gw = *(const u32x2*)(P + (size_t)row * NP + C_G + e0);
    const float g0 = __uint_as_float(gw.x << 16), g1 = __uint_as_float(gw.x & 0xffff0000u), g2 = __uint_as_float(gw.y << 16), g3 = __uint_as_float(gw.y & 0xffff0000u);
    u32x2 w; w.x = pk2(o[0] * rstd * g[0] * silu_acc(g0), o[1] * rstd * g[1] * silu_acc(g1)); w.y = pk2(o[2] * rstd * g[2] * silu_acc(g2), o[3] * rstd * g[3] * silu_acc(g3));
    *(u32x2*)(CAT + (size_t)row * D + 1024 + e0) = w;
}

template <class Epi> __global__ void __launch_bounds__(512, 2) k_gemm(pg8::Gemm g, Epi E) {
    extern __shared__ __attribute__((aligned(16))) unsigned char shm[];
    pg8::StaticOrder S; S.init(g.M, g.N, (int)gridDim.x, (int)blockIdx.x);
    pg8::gemm_phase<Epi, pg8::StaticOrder, true, true>((LAS unsigned char*)shm, g, S, E);
}
template <class Epi> static void launch_gemm(const pg8::Gemm& g, const Epi& E, hipStream_t st) {
    static bool attr = false; if (!attr) { (void)hipFuncSetAttribute((const void*)k_gemm<Epi>, hipFuncAttributeMaxDynamicSharedMemorySize, pg8::STAGE_BYTES); attr = true; }
    hipLaunchKernelGGL((k_gemm<Epi>), dim3(256), dim3(512), pg8::STAGE_BYTES, st, g, E);
}

extern "C" void kernel_launch(void* const* d_in, const int* in_sizes, int n_in, void* d_out, int out_size, void* d_ws, size_t ws_size, hipStream_t stream) {
    if (n_in != 23 || ws_size < WS_END || out_size != MX * D) { fprintf(stderr, "kernel_launch: unexpected shapes (n_in %d, ws %zu, out %d)\n", n_in, ws_size, out_size); return; }
    const float* x = (const float*)d_in[0]; const float* c = (const float*)d_in[1]; const float* ctx = (const float*)d_in[2]; const float* cctx = (const float*)d_in[3];
    const float* w_mod = (const float*)d_in[4]; const float* b_mod = (const float*)d_in[5];
    const float* g_pre_mix = (const float*)d_in[6]; const float* g_post_mix = (const float*)d_in[7]; const float* g_pre_ffn = (const float*)d_in[8]; const float* g_post_ffn = (const float*)d_in[9];
    const float* w_in = (const float*)d_in[10]; const float* ln_g = (const float*)d_in[11]; const float* ln_b = (const float*)d_in[12]; const float* gws = (const float*)d_in[13]; const float* gbs = (const float*)d_in[14];
    const float* wd2f = (const float*)d_in[15]; const float* bdf = (const float*)d_in[16]; const float* wd2b = (const float*)d_in[17]; const float* bdb = (const float*)d_in[18];
    const float* out_g = (const float*)d_in[19]; const float* w_out = (const float*)d_in[20]; const float* w_fi = (const float*)d_in[21]; const float* w_fo = (const float*)d_in[22];
    unsigned char* ws = (unsigned char*)d_ws;
    float* MOD = (float*)(ws + WS_MOD); bf16* WIN = (bf16*)(ws + WS_WIN); bf16* WOUT = (bf16*)(ws + WS_WOUT); bf16* WFI = (bf16*)(ws + WS_WFI); bf16* WFO = (bf16*)(ws + WS_WFO);
    float* X = (float*)(ws + WS_X); bf16* H = (bf16*)(ws + WS_H); bf16* P = (bf16*)(ws + WS_P); bf16* CAT = (bf16*)(ws + WS_CAT); float* Y = (float*)(ws + WS_Y); bf16* HID = (bf16*)(ws + WS_HID);
    float* AF = (float*)(ws + WS_AF); float* AB = (float*)(ws + WS_AB); float* OF = (float*)(ws + WS_OF); float* OB = (float*)(ws + WS_OB);
    hipLaunchKernelGGL(k_wconv, dim3(NP / 64, D / 64, NL), dim3(256), 0, stream, w_in, WIN, D, PIN, NP, 1);
    hipLaunchKernelGGL(k_wconv, dim3(D / 64, D / 64, NL), dim3(256), 0, stream, w_out, WOUT, D, D, D, 0);
    hipLaunchKernelGGL(k_wconv, dim3(2 * FF / 64, D / 64, NL), dim3(256), 0, stream, w_fi, WFI, D, 2 * FF, 2 * FF, 2);
    hipLaunchKernelGGL(k_wconv, dim3(D / 64, FF / 64, NL), dim3(256), 0, stream, w_fo, WFO, FF, D, D, 0);
    hipLaunchKernelGGL(k_mod, dim3(NMOD / 256, NL), dim3(256), 0, stream, c, cctx, w_mod, b_mod, MOD);
    { RowArgs a{}; a.xin_x = x; a.xin_c = ctx; a.X = X; a.H = H; a.modB = MOD; a.gB = g_pre_mix; a.mode = 0; a.write_h = 1; hipLaunchKernelGGL(k_rowpass, dim3(1024), dim3(256), 0, stream, a); }
    for (int l = 0; l < NL; ++l) {
        const float* modl = MOD + (size_t)l * 5 * NMOD;
        { pg8::Gemm g{H, WIN + (size_t)l * NP * D, M, NP, D}; pg8::EpiProj E{P, NP, 8}; launch_gemm(g, E, stream); }
        hipLaunchKernelGGL(k_gmlp_simple, dim3(NCHUNK, 8), dim3(256), 0, stream, (const bf16*)P, CAT, ln_g + l * 1024, ln_b + l * 1024, gws + (size_t)l * 8 * CH * CH, gbs + l * 8 * CH);
        hipLaunchKernelGGL(k_gla_decay, dim3(M / 4), dim3(256), 0, stream, (const bf16*)P, wd2f + l * 16 * 512, bdf + l * 512, wd2b + l * 16 * 512, bdb + l * 512, AF, AB);
        hipLaunchKernelGGL(k_gla_scan_simple, dim3(4, 4, 8), dim3(64), 0, stream, (const bf16*)P, (const float*)AF, (const float*)AB, OF, OB);
        hipLaunchKernelGGL(k_gla_out_simple, dim3(M), dim3(256), 0, stream, (const bf16*)P, (const float*)OF, (const float*)OB, out_g + l * 1024, CAT);
        { pg8::Gemm g{CAT, WOUT + (size_t)l * D * D, M, D, D}; pg8::EpiF32 E{Y, D}; launch_gemm(g, E, stream); }
        { RowArgs a{}; a.xin_x = l == 0 ? x : nullptr; a.xin_c = l == 0 ? ctx : nullptr; a.Y = Y; a.X = X; a.H = H; a.modA = modl; a.gA = g_post_mix + l * D; a.gB = g_pre_ffn + l * D; a.mode = 1; a.write_h = 1;
          hipLaunchKernelGGL(k_rowpass, dim3(1024), dim3(256), 0, stream, a); }
        { pg8::Gemm g{H, WFI + (size_t)l * 2 * FF * D, M, 2 * FF, D}; pg8::EpiSwiglu E{HID, FF}; launch_gemm(g, E, stream); }
        { pg8::Gemm g{HID, WFO + (size_t)l * D * FF, M, D, FF}; pg8::EpiF32 E{Y, D}; launch_gemm(g, E, stream); }
        { RowArgs a{}; a.Y = Y; a.X = X; a.out = (float*)d_out; a.H = H; a.modA = modl; a.modB = modl + 5 * NMOD; a.gA = g_post_ffn + l * D; a.gB = g_pre_mix + (l + 1 < NL ? l + 1 : l) * D; a.mode = 2; a.write_h = (l + 1 < NL); a.to_out = (l + 1 == NL);
          hipLaunchKernelGGL(k_rowpass, dim3(1024), dim3(256), 0, stream, a); }
    }
}
```

```cpp
#include <hip/hip_runtime.h>
#include <cstdio>
#include <cstdint>
namespace pg8 {
#define PG8_LAS __attribute__((address_space(3)))
typedef unsigned short bf16_t;
typedef short bf16x8 __attribute__((ext_vector_type(8)));
typedef float f32x4 __attribute__((ext_vector_type(4)));
typedef unsigned u32x4 __attribute__((ext_vector_type(4)));
constexpr int BM = 256, BK = 64, HALF = 128, HTB = HALF * BK * 2  , STAGE_BYTES = 8 * HTB, NXCD = 8, WGM = 8;

__host__ __device__ __forceinline__ int lds_byte(int r, int c) { const int st = (r >> 4) * 2 + (c >> 5), rr = r & 15, cc = c & 31, ob = rr * 64 + cc * 2; return st * 1024 + (ob ^ (((ob >> 9) & 1) << 5)); }
__host__ __device__ __forceinline__ void stage_rc(int b, int& R, int& C) { const int st = b / 1024, sb = b % 1024, swz = sb ^ (((sb >> 9) & 1) << 5); R = (st >> 1) * 16 + swz / 64; C = (st & 1) * 32 + (swz % 64) / 2; }
__host__ __device__ __forceinline__ int perm32(int rho) { const int n = rho >> 4, i = rho & 15; return 8 * (i >> 2) + 4 * n + (i & 3); }

struct Unit { int pm, pn; };
struct Gemm { const bf16_t* A; const bf16_t* Bt; int M, N, K, pad; };

struct StaticOrder {
    int nM, nN, nwg, G, c;
    __host__ __device__ void init(int M, int N, int G_, int c_) { nM = M / BM; nN = N / BM; nwg = nM * nN; G = G_; c = c_; }
    __host__ __device__ bool next(int i, Unit& u) const {
        const long L = (long)i * G + c; if (L >= nwg) return false;
        int wgid = (int)L; { const int q = nwg / NXCD, r = nwg % NXCD, xcd = wgid % NXCD, off = wgid / NXCD; wgid = (xcd < r ? xcd * (q + 1) : r * (q + 1) + (xcd - r) * q) + off; }
        const int nig = WGM * nN, gid = wgid / nig, fm = gid * WGM, gsz = (nM - fm) < WGM ? (nM - fm) : WGM;
        u.pm = fm + ((wgid % nig) % gsz); u.pn = (wgid % nig) / gsz; return true;
    }
    __device__ __forceinline__ void a_ready(const Unit&) const {}
    __device__ __forceinline__ void done(const Unit&) const {}
};


__device__ __forceinline__ unsigned cvt_pk_bf16(float lo, float hi) { unsigned r; asm volatile("v_cvt_pk_bf16_f32 %0, %1, %2" : "=v"(r) : "v"(lo), "v"(hi)); return r; }
__device__ __forceinline__ float fast_sigmoid(float x) { return __builtin_amdgcn_rcpf(1.0f + __builtin_amdgcn_exp2f(-1.4426950408889634f * x)); }
__device__ __forceinline__ float gelu_tanh(float x) { const float y = 1.5957691216057308f * (x + 0.044715f * x * x * x); return x * fast_sigmoid(y); }
__device__ __forceinline__ float silu_f(float x) { return x * fast_sigmoid(x); }

struct EpiF32 {
    static constexpr bool PERM = false, AFTER_DRAIN = false;
    float* C; int ldc; int pad;
    __device__ __forceinline__ void operator()(const f32x4 (&acc)[2][2][4][2], const Unit& u, int wr, int wc, int fr, int fq) const {
        const int row0 = u.pm * BM + wr * 64 + fr, col0 = u.pn * BM + wc * 32 + 4 * fq;
#pragma unroll
        for (int ai = 0; ai < 2; ++ai)
#pragma unroll
            for (int m = 0; m < 4; ++m) { float* rowp = C + (size_t)(row0 + ai * HALF + m * 16) * ldc + col0;
#pragma unroll
                for (int bj = 0; bj < 2; ++bj)
#pragma unroll
                    for (int n = 0; n < 2; ++n) *(f32x4*)(rowp + bj * HALF + n * 16) = acc[ai][bj][m][n]; }
    }
};
struct EpiProj {
    static constexpr bool PERM = true, AFTER_DRAIN = false;
    bf16_t* O; int ldc; int ngelu;
    __device__ __forceinline__ void operator()(const f32x4 (&acc)[2][2][4][2], const Unit& u, int wr, int wc, int fr, int fq) const {
        const int row0 = u.pm * BM + wr * 64 + fr, col0 = u.pn * BM + wc * 32 + 8 * fq;
        const bool act = u.pn < ngelu;
#pragma unroll
        for (int ai = 0; ai < 2; ++ai)
#pragma unroll
            for (int m = 0; m < 4; ++m) { bf16_t* rowp = O + (size_t)(row0 + ai * HALF + m * 16) * ldc + col0;
#pragma unroll
                for (int bj = 0; bj < 2; ++bj) { f32x4 v0 = acc[ai][bj][m][0], v1 = acc[ai][bj][m][1];
                    if (act) {
#pragma unroll
                        for (int j = 0; j < 4; ++j) { v0[j] = gelu_tanh(v0[j]); v1[j] = gelu_tanh(v1[j]); } }
                    u32x4 w; w.x = cvt_pk_bf16(v0[0], v0[1]); w.y = cvt_pk_bf16(v0[2], v0[3]); w.z = cvt_pk_bf16(v1[0], v1[1]); w.w = cvt_pk_bf16(v1[2], v1[3]);
                    *(u32x4*)(rowp + bj * HALF) = w; } }
    }
};
struct EpiSwiglu {
    static constexpr bool PERM = true, AFTER_DRAIN = false;
    bf16_t* O; int ldc; int pad;
    __device__ __forceinline__ void operator()(const f32x4 (&acc)[2][2][4][2], const Unit& u, int wr, int wc, int fr, int fq) const {
        const int row0 = u.pm * BM + wr * 64 + fr, col0 = u.pn * HALF + wc * 32 + 8 * fq;
#pragma unroll
        for (int ai = 0; ai < 2; ++ai)
#pragma unroll
            for (int m = 0; m < 4; ++m) { bf16_t* rowp = O + (size_t)(row0 + ai * HALF + m * 16) * ldc + col0;
                f32x4 h0, h1;
#pragma unroll
                for (int j = 0; j < 4; ++j) { h0[j] = silu_f(acc[ai][0][m][0][j]) * acc[ai][1][m][0][j]; h1[j] = silu_f(acc[ai][0][m][1][j]) * acc[ai][1][m][1][j]; }
                u32x4 w; w.x = cvt_pk_bf16(h0[0], h0[1]); w.y = cvt_pk_bf16(h0[2], h0[3]); w.z = cvt_pk_bf16(h1[0], h1[1]); w.w = cvt_pk_bf16(h1[2], h1[3]);
                *(u32x4*)rowp = w; }
    }
};

template <class Epi, class Sched, bool ALIGN_EPI = false, bool SP2 = false>
__device__ __forceinline__ void gemm_phase(PG8_LAS unsigned char* lds, const Gemm g, const Sched& S, const Epi& E) {
    const int tid = threadIdx.x, wid = __builtin_amdgcn_readfirstlane(tid >> 6), lane = tid & 63, wr = wid >> 2, wc = wid & 3, fr = lane & 15, fq = lane >> 4;
    const int K = g.K, nt = K / BK;
    unsigned voffA[2], voffB[2];
#pragma unroll
    for (int i = 0; i < 2; ++i) { int R, C; stage_rc(tid * 16 + i * 8192, R, C); const int Rb = Epi::PERM ? ((R & ~31) + perm32(R & 31)) : R;
        voffA[i] = (unsigned)(R * K + C) * 2u; voffB[i] = (unsigned)(Rb * K + C) * 2u; }
    const size_t kstep = (size_t)(BK * 2);
    const size_t hstep = (size_t)HALF * K * 2;
    const size_t tstep = 2 * hstep;
    const unsigned ldsw = (unsigned)wid * 1024u;
    const int aoff = lds_byte(wr * 64 + fr, fq * 8), boff = lds_byte(wc * 32 + fr, fq * 8);
#define PG8_SA(b, h) (((b) * 2 + (h)) * HTB)
#define PG8_SB(b, h) ((4 + (b) * 2 + (h)) * HTB)
#define PG8_STAGE(bufoff, gbase, voff) do { _Pragma("unroll") for (int _i = 0; _i < 2; ++_i) \
        __builtin_amdgcn_global_load_lds((const unsigned*)((const char*)(gbase) + (voff)[_i]), (PG8_LAS unsigned*)(lds + (bufoff) + ldsw + _i * 8192), 16, 0, 0); } while (0)
#define PG8_LDA(dst, b, h) do { _Pragma("unroll") for (int m = 0; m < 4; ++m) _Pragma("unroll") for (int k = 0; k < 2; ++k) dst[m][k] = *(const PG8_LAS bf16x8*)(lds + PG8_SA(b, h) + aoff + m * 2048 + k * 1024); } while (0)
#define PG8_LDB(dst, b, h) do { _Pragma("unroll") for (int n = 0; n < 2; ++n) _Pragma("unroll") for (int k = 0; k < 2; ++k) dst[n][k] = *(const PG8_LAS bf16x8*)(lds + PG8_SB(b, h) + boff + n * 2048 + k * 1024); } while (0)
#define PG8_MMA(ai, bj, At, Bt) do { __builtin_amdgcn_s_setprio(1); _Pragma("unroll") for (int m = 0; m < 4; ++m) _Pragma("unroll") for (int n = 0; n < 2; ++n) _Pragma("unroll") for (int k = 0; k < 2; ++k) \
        acc[ai][bj][m][n] = __builtin_amdgcn_mfma_f32_16x16x32_bf16(Bt[n][k], At[m][k], acc[ai][bj][m][n], 0, 0, 0); __builtin_amdgcn_s_setprio(0); } while (0)
#define PG8_WAIT_V(n) asm volatile("s_waitcnt vmcnt(" #n ")" ::: "memory")
#define PG8_WAIT_L(n) asm volatile("s_waitcnt lgkmcnt(" #n ")" ::: "memory")
#define PG8_BAR __builtin_amdgcn_s_barrier()
#define PG8_SCHED __builtin_amdgcn_sched_barrier(0)
    Unit cur, nxt; int ui = 0;
    if (!S.next(0, cur)) return;
    f32x4 acc[2][2][4][2];
#pragma unroll
    for (int a = 0; a < 2; ++a)
#pragma unroll
        for (int b = 0; b < 2; ++b)
#pragma unroll
            for (int m = 0; m < 4; ++m)
#pragma unroll
                for (int n = 0; n < 2; ++n) acc[a][b][m][n] = (f32x4){0.f, 0.f, 0.f, 0.f};
    bf16x8 At[4][2], B0[2][2], B1[2][2];
    const char* cA = (const char*)g.A + (size_t)cur.pm * tstep; const char* cB = (const char*)g.Bt + (size_t)cur.pn * tstep;
    S.a_ready(cur);
    if constexpr (SP2) {
        PG8_STAGE(PG8_SB(0, 0), cB, voffB); PG8_STAGE(PG8_SB(0, 1), cB + hstep, voffB); PG8_STAGE(PG8_SA(0, 0), cA, voffA); PG8_STAGE(PG8_SA(0, 1), cA + hstep, voffA);
        if (wr == 1) PG8_BAR;
        PG8_WAIT_V(2); PG8_BAR;
        PG8_STAGE(PG8_SB(1, 0), cB + kstep, voffB); PG8_STAGE(PG8_SA(1, 0), cA + kstep, voffA); PG8_STAGE(PG8_SB(1, 1), cB + hstep + kstep, voffB);
        PG8_WAIT_V(6); PG8_BAR;
    } else {
        PG8_STAGE(PG8_SB(0, 0), cB, voffB); PG8_STAGE(PG8_SA(0, 0), cA, voffA); PG8_STAGE(PG8_SB(0, 1), cB + hstep, voffB); PG8_STAGE(PG8_SA(0, 1), cA + hstep, voffA);
        if (wr == 1) PG8_BAR;
        PG8_WAIT_V(4); PG8_BAR;
        PG8_STAGE(PG8_SB(1, 0), cB + kstep, voffB); PG8_STAGE(PG8_SA(1, 0), cA + kstep, voffA); PG8_STAGE(PG8_SB(1, 1), cB + hstep + kstep, voffB);
        PG8_WAIT_V(6); PG8_BAR;
    }
    for (;;) {
        const bool has_next = S.next(ui + 1, nxt);
        const char* nA = has_next ? (const char*)g.A + (size_t)nxt.pm * tstep : cA; const char* nB = has_next ? (const char*)g.Bt + (size_t)nxt.pn * tstep : cB;
        for (int t = 0; t < nt; t += 2) {
            const bool last = (t == nt - 2);
            const char* a1 = cA + (size_t)(t + 1) * kstep;
            const char* a2 = last ? nA : cA + (size_t)(t + 2) * kstep; const char* b2 = last ? nB : cB + (size_t)(t + 2) * kstep;
            const char* a3 = a2 + kstep; const char* b3 = b2 + kstep;
            if (last && has_next) S.a_ready(nxt);
            if constexpr (SP2) {
            PG8_LDB(B0, 0, 0); PG8_LDB(B1, 0, 1); PG8_SCHED; PG8_LDA(At, 0, 0); PG8_STAGE(PG8_SA(1, 1), a1 + hstep, voffA);
            PG8_WAIT_V(8); PG8_WAIT_L(0); PG8_BAR; PG8_MMA(0, 0, At, B0); PG8_MMA(0, 1, At, B1); PG8_BAR; PG8_SCHED;
            PG8_LDA(At, 0, 1); PG8_STAGE(PG8_SB(0, 0), b2, voffB); PG8_STAGE(PG8_SB(0, 1), b2 + hstep, voffB); PG8_STAGE(PG8_SA(0, 0), a2, voffA);
            PG8_WAIT_V(8); PG8_WAIT_L(0); PG8_BAR; PG8_MMA(1, 0, At, B0); PG8_MMA(1, 1, At, B1); PG8_BAR; PG8_SCHED;
            PG8_LDB(B0, 1, 0); PG8_LDB(B1, 1, 1); PG8_SCHED; PG8_LDA(At, 1, 0); PG8_STAGE(PG8_SA(0, 1), a2 + hstep, voffA);
            PG8_WAIT_V(8); PG8_WAIT_L(0); PG8_BAR; PG8_MMA(0, 0, At, B0); PG8_MMA(0, 1, At, B1); PG8_BAR; PG8_SCHED;
            PG8_LDA(At, 1, 1); PG8_STAGE(PG8_SB(1, 0), b3, voffB); PG8_STAGE(PG8_SB(1, 1), b3 + hstep, voffB); PG8_STAGE(PG8_SA(1, 0), a3, voffA);
            PG8_WAIT_V(8); PG8_WAIT_L(0); PG8_BAR; PG8_MMA(1, 0, At, B0); PG8_MMA(1, 1, At, B1); PG8_BAR; PG8_SCHED;
            } else {
            PG8_LDB(B0, 0, 0); PG8_SCHED; PG8_LDA(At, 0, 0); PG8_STAGE(PG8_SA(1, 1), a1 + hstep, voffA);
            PG8_WAIT_L(8); PG8_BAR; PG8_WAIT_L(0); PG8_MMA(0, 0, At, B0); PG8_BAR; PG8_SCHED;
            PG8_LDB(B1, 0, 1); PG8_STAGE(PG8_SB(0, 0), b2, voffB);
            PG8_BAR; PG8_WAIT_L(0); PG8_MMA(0, 1, At, B1); PG8_BAR;
            PG8_LDA(At, 0, 1); PG8_STAGE(PG8_SA(0, 0), a2, voffA);
            PG8_BAR; PG8_WAIT_L(0); PG8_MMA(1, 0, At, B0); PG8_BAR; PG8_SCHED;
            PG8_STAGE(PG8_SB(0, 1), b2 + hstep, voffB);
            PG8_WAIT_V(6); PG8_BAR; PG8_MMA(1, 1, At, B1); PG8_BAR;
            PG8_LDB(B0, 1, 0); PG8_SCHED; PG8_LDA(At, 1, 0); PG8_STAGE(PG8_SA(0, 1), a2 + hstep, voffA);
            PG8_WAIT_L(8); PG8_BAR; PG8_WAIT_L(0); PG8_MMA(0, 0, At, B0); PG8_BAR; PG8_SCHED;
            PG8_LDB(B1, 1, 1); PG8_STAGE(PG8_SB(1, 0), b3, voffB);
            PG8_BAR; PG8_WAIT_L(0); PG8_MMA(0, 1, At, B1); PG8_BAR;
            PG8_LDA(At, 1, 1); PG8_STAGE(PG8_SA(1, 0), a3, voffA);
            PG8_BAR; PG8_WAIT_L(0); PG8_MMA(1, 0, At, B0); PG8_BAR; PG8_SCHED;
            PG8_STAGE(PG8_SB(1, 1), b3 + hstep, voffB);
            PG8_WAIT_V(6); PG8_BAR; PG8_MMA(1, 1, At, B1); PG8_BAR;
            }
        }
        if constexpr (ALIGN_EPI) { if (wr == 0) PG8_BAR; }
        if constexpr (!Epi::AFTER_DRAIN) { E(acc, cur, wr, wc, fr, fq); S.done(cur); }
        if (!has_next) break;
#pragma unroll
        for (int a = 0; a < 2; ++a)
#pragma unroll
            for (int b = 0; b < 2; ++b)
#pragma unroll
                for (int m = 0; m < 4; ++m)
#pragma unroll
                    for (int n = 0; n < 2; ++n) acc[a][b][m][n] = (f32x4){0.f, 0.f, 0.f, 0.f};
        cur = nxt; cA = nA; cB = nB; ++ui;
        if constexpr (ALIGN_EPI) { if (wr == 1) PG8_BAR; }
    }
    PG8_WAIT_V(0);
    if constexpr (!ALIGN_EPI) { if (wr == 0) PG8_BAR; }
    PG8_BAR;
    if constexpr (Epi::AFTER_DRAIN) { E.fused(acc, cur, wr, wc, fr, fq, lds, wid, lane); S.done(cur); }
#undef PG8_SA
#undef PG8_SB
#undef PG8_STAGE
#undef PG8_LDA
#undef PG8_LDB
#undef PG8_MMA
#undef PG8_WAIT_V
#undef PG8_WAIT_L
#undef PG8_BAR
#undef PG8_SCHED
}
}
#define XB_TMO      128
#define XB_XCNT(j)  (256  + 64 * (j))
#define XB_XSUB(j)  (1280 + 64 * (j))
#define XB_XGEN(j)  (2304 + 64 * (j))
#define XB_TOP      3328
#define XB_TOPGEN   3392
#define XCD_BAR_WORDS 3456
#define XB_SPIN_CAP (1u << 18)
#define LAS __attribute__((address_space(3)))

__device__ __forceinline__ unsigned xb_ld(unsigned* p)              { return __hip_atomic_load(p, __ATOMIC_RELAXED, __HIP_MEMORY_SCOPE_AGENT); }
__device__ __forceinline__ unsigned xb_add(unsigned* p, unsigned v) { return __hip_atomic_fetch_add(p, v, __ATOMIC_RELAXED, __HIP_MEMORY_SCOPE_AGENT); }
__device__ __forceinline__ unsigned xb_xcc_id() { return (unsigned)__builtin_amdgcn_s_getreg((3 << 11) | 20) & 0xFu; }
#define XB_SPIN(cond, bar) do { unsigned _sp = 0; while (cond) { __builtin_amdgcn_s_sleep(1); \
    if ((++_sp & 255u) == 0u) { if (xb_ld(&(bar)[XB_TMO])) break; if (_sp > XB_SPIN_CAP) { atomicAdd(&(bar)[XB_TMO], 1u); break; } } } } while (0)

struct XcdBarrier {
    unsigned* bar; unsigned x;
    volatile LAS unsigned* st;
};

__device__ __forceinline__ XcdBarrier xcd_barrier_post(unsigned* bar, volatile LAS unsigned* st) {
    XcdBarrier b; b.bar = bar; b.x = xb_xcc_id(); b.st = st;
    if (threadIdx.x == 0) (void)xb_add(&bar[XB_XCNT(b.x)], 1u);
    return b;
}
__device__ __forceinline__ void xcd_barrier_complete(unsigned* bar, unsigned x, unsigned& nloc, unsigned& nx) {
    const unsigned G = gridDim.x * gridDim.y * gridDim.z;
    unsigned sum, cnt, mine, sp = 0u;
    for (;;) {
        sum = 0u; cnt = 0u; mine = 0u;
#pragma unroll
        for (unsigned j = 0; j < 16; ++j) { const unsigned c = xb_ld(&bar[XB_XCNT(j)]); sum += c; cnt += (c > 0u) ? 1u : 0u; mine = (j == x) ? c : mine; }
        if (sum == G) break;
        __builtin_amdgcn_s_sleep(1);
        if ((++sp & 255u) == 0u) { if (xb_ld(&bar[XB_TMO])) break; if (sp > XB_SPIN_CAP) { atomicAdd(&bar[XB_TMO], 1u); break; } }
    }
    nloc = mine > 0u ? mine : 1u; nx = cnt > 0u ? cnt : 1u;
}

__device__ __forceinline__ void xcd_barrier(const XcdBarrier& b) {
    asm volatile("s_waitcnt vmcnt(0)" ::: "memory");
    __syncthreads();
    if (threadIdx.x == 0) {
        unsigned* bar = b.bar;
        __builtin_amdgcn_s_waitcnt(0);
        unsigned nloc = b.st[0], nx = b.st[1];
        if (nloc == 0u) { xcd_barrier_complete(bar, b.x, nloc, nx); b.st[0] = nloc; b.st[1] = nx; }
        const unsigned old = xb_add(&bar[XB_XSUB(b.x)], 1u);
        const unsigned gen = old / nloc;
        if (old + 1u == (gen + 1u) * nloc) {
            __builtin_amdgcn_fence(__ATOMIC_RELEASE, "agent");
            asm volatile("s_waitcnt vmcnt(0)" ::: "memory");
            const unsigned og = xb_add(&bar[XB_TOP], 1u);
            const unsigned tg = og / nx;
            if (og + 1u == (tg + 1u) * nx) xb_add(&bar[XB_TOPGEN], 1u);
            else XB_SPIN(xb_ld(&bar[XB_TOPGEN]) == tg, bar);
            __builtin_amdgcn_fence(__ATOMIC_ACQUIRE, "agent");
            xb_add(&bar[XB_XGEN(b.x)], 1u);
            asm volatile("s_waitcnt vmcnt(0)" ::: "memory");
        } else {
            XB_SPIN(xb_ld(&bar[XB_XGEN(b.x)]) == gen, bar);
            __builtin_amdgcn_fence(__ATOMIC_ACQUIRE, "agent");
            asm volatile("s_waitcnt vmcnt(0)" ::: "memory");
        }
    }
    __syncthreads();
}

typedef unsigned short bf16;
typedef float f32x4 __attribute__((ext_vector_type(4)));
typedef unsigned u32x4 __attribute__((ext_vector_type(4)));
typedef unsigned u32x2 __attribute__((ext_vector_type(2)));
constexpr int D = 2048, NB = 4, SEQ = 4096, NL = 4, CTX = 256, CH = 128;
constexpr int MX = NB * SEQ, MC = NB * CTX, M = MX + MC;
constexpr int PIN = 5152, NP = 5376, FF = 5632, NMOD = 6 * D;
constexpr int C_U = 0, C_V = 1024, C_Q = 2048, C_K = 2560, C_VV = 3072, C_G = 4096, C_DF = 5120, C_DB = 5136;
constexpr int NCHUNK = M / CH;
constexpr float EPS = 1e-6f;
constexpr size_t MiB = 1u << 20;
constexpr size_t WS_CTL = 0, WS_MOD = 1 * MiB, ZERO_BYTES = 2 * MiB, WS_WIN = 2 * MiB, WS_WOUT = WS_WIN + 84 * MiB, WS_WFI = WS_WOUT + 32 * MiB, WS_WFO = WS_WFI + 176 * MiB,
                 WS_X = WS_WFO + 88 * MiB, WS_H = WS_X + 136 * MiB, WS_P = WS_H + 68 * MiB, WS_CAT = WS_P + 179 * MiB, WS_Y = WS_CAT + 68 * MiB, WS_HID = WS_Y + 136 * MiB,
                 WS_AF = WS_HID + 187 * MiB, WS_AB = WS_AF + 34 * MiB, WS_OF = WS_AB + 34 * MiB, WS_OB = WS_OF + 68 * MiB, WS_END = WS_OB + 68 * MiB;
static_assert((size_t)NL * NP * D * 2 <= 84 * MiB && (size_t)NL * 2 * FF * D * 2 <= 176 * MiB && (size_t)NL * D * FF * 2 <= 88 * MiB && (size_t)M * NP * 2 <= 179 * MiB && (size_t)M * FF * 2 <= 187 * MiB, "ws map");
constexpr int CW_BAR = 4096;
constexpr int LDS_SCR = 131072, MISC_OFF = LDS_SCR, LDS_BYTES = 147456;

__device__ __forceinline__ float bf2f(bf16 b) { return __uint_as_float(((unsigned)b) << 16); }
__device__ __forceinline__ unsigned f2bf(float f) { unsigned u = __float_as_uint(f); return (u + 0x7fffu + ((u >> 16) & 1u)) >> 16; }
__device__ __forceinline__ unsigned pk2(float lo, float hi) { return f2bf(lo) | (f2bf(hi) << 16); }
__device__ __forceinline__ float wave_sum(float v) {
#pragma unroll
    for (int o = 1; o < 64; o <<= 1) v += __shfl_xor(v, o);
    return v;
}
__device__ __forceinline__ float sigmoid_acc(float x) { return 1.0f / (1.0f + __expf(-x)); }
__device__ __forceinline__ float silu_acc(float x) { return x * sigmoid_acc(x); }
__device__ __forceinline__ float log_sigmoid(float z) { return fminf(z, 0.f) - log1pf(__expf(-fabsf(z))); }
__device__ __forceinline__ int mod_row(int row) { return row < MX ? row / SEQ : NB; }
#define LDS_WAIT() asm volatile("s_waitcnt lgkmcnt(0)" ::: "memory")


__device__ __forceinline__ int map_col(int mode, int r) {
    if (mode == 0) return r;
    if (mode == 1) return r < PIN ? r : -1;
    const int pn = r >> 8, rr = r & 255; return rr < 128 ? pn * 128 + rr : FF + pn * 128 + (rr - 128);
}
__device__ __forceinline__ void transpose_item(const float* W, int K, int Nsrc, bf16* T, int n0, int c0, int k0, LAS float* scr, int lane) {
    if (c0 >= 0) {
#pragma unroll 8
        for (int i = 0; i < 32; ++i) { const int kk = 2 * i + (lane >> 5); scr[kk * 33 + (lane & 31)] = W[(size_t)(k0 + kk) * Nsrc + c0 + (lane & 31)]; }
    } else {
#pragma unroll 8
        for (int i = 0; i < 32; ++i) { const int kk = 2 * i + (lane >> 5); scr[kk * 33 + (lane & 31)] = 0.f; }
    }
    LDS_WAIT(); asm volatile("" ::: "memory");
    const int c = lane & 7;
#pragma unroll
    for (int j = 0; j < 4; ++j) { const int n = (lane >> 3) + 8 * j; const LAS float* s = scr + (8 * c) * 33 + n;
        u32x4 o; o.x = pk2(s[0 * 33], s[1 * 33]); o.y = pk2(s[2 * 33], s[3 * 33]); o.z = pk2(s[4 * 33], s[5 * 33]); o.w = pk2(s[6 * 33], s[7 * 33]);
        *(u32x4*)(T + (size_t)(n0 + n) * K + k0 + 8 * c) = o; }
    LDS_WAIT(); asm volatile("" ::: "memory");
}
__device__ __forceinline__ void conv_matrix(const float* W, bf16* T, int K, int Nsrc, int Ndst, int mode, int& it0, int gw, int ngw, LAS float* scr, int lane) {
    const int nblk = Ndst / 32, per_layer = (K / 64) * nblk, total = NL * per_layer;
    int first = ((gw - it0) % ngw + ngw) % ngw;
    for (int it = first; it < total; it += ngw) {
        const int l = it / per_layer, r = it % per_layer, kb = r / nblk, nb = r % nblk;
        transpose_item(W + (size_t)l * K * Nsrc, K, Nsrc, T + (size_t)l * Ndst * K, 32 * nb, map_col(mode, 32 * nb), 64 * kb, scr, lane);
    }
    it0 += total;
}
struct RowArgs { const float* xin_x; const float* xin_c; const float* Y; float* X; float* out; bf16* H; const float* modA; const float* modB; const float* gA; const float* gB; int mode; int write_h; int to_out; int pad; };
__device__ __forceinline__ void row_pass(const RowArgs& a, int row, int lane) {
    const int mr = mod_row(row);
    const float* xsrc = (a.mode == 2 || a.xin_x == nullptr) ? a.X + (size_t)row * D : (row < MX ? a.xin_x + (size_t)row * D : a.xin_c + (size_t)(row - MX) * D);
    f32x4 x[8];
#pragma unroll
    for (int j = 0; j < 8; ++j) x[j] = *(const f32x4*)(xsrc + 4 * lane + 256 * j);
    if (a.mode != 0) {
        const float* yr = a.Y + (size_t)row * D; const float* mg = a.modA + (size_t)mr * NMOD + (a.mode == 1 ? 2 : 5) * D;
        f32x4 y[8]; float ss = 0.f;
#pragma unroll
        for (int j = 0; j < 8; ++j) { y[j] = *(const f32x4*)(yr + 4 * lane + 256 * j); ss += (y[j][0] * y[j][0] + y[j][1] * y[j][1]) + (y[j][2] * y[j][2] + y[j][3] * y[j][3]); }
        const float rstd = rsqrtf(wave_sum(ss) * (1.f / D) + EPS);
#pragma unroll
        for (int j = 0; j < 8; ++j) { const f32x4 g = *(const f32x4*)(a.gA + 4 * lane + 256 * j), mm = *(const f32x4*)(mg + 4 * lane + 256 * j); x[j] = x[j] + mm * (y[j] * rstd * g); }
        float* dst = (a.to_out && row < MX) ? a.out + (size_t)row * D : a.X + (size_t)row * D;
        if (!(a.to_out && row >= MX)) {
#pragma unroll
            for (int j = 0; j < 8; ++j) *(f32x4*)(dst + 4 * lane + 256 * j) = x[j]; }
    }
    if (a.write_h) {
        float ss = 0.f;
#pragma unroll
        for (int j = 0; j < 8; ++j) ss += (x[j][0] * x[j][0] + x[j][1] * x[j][1]) + (x[j][2] * x[j][2] + x[j][3] * x[j][3]);
        const float rstd = rsqrtf(wave_sum(ss) * (1.f / D) + EPS);
        const float* msh = (a.mode == 1 ? a.modA + (size_t)mr * NMOD + 3 * D : a.modB + (size_t)mr * NMOD);
        const float* msc = msh + D;
        bf16* hr = a.H + (size_t)row * D;
#pragma unroll
        for (int j = 0; j < 8; ++j) { const f32x4 g = *(const f32x4*)(a.gB + 4 * lane + 256 * j), sh = *(const f32x4*)(msh + 4 * lane + 256 * j), sc = *(const f32x4*)(msc + 4 * lane + 256 * j);
            const f32x4 h = (x[j] * rstd * g) * (sc + 1.0f) + sh; u32x2 w; w.x = pk2(h[0], h[1]); w.y = pk2(h[2], h[3]); *(u32x2*)(hr + 4 * lane + 256 * j) = w; }
    }
}

__device__ __forceinline__ void gmlp_unit_simple(const bf16* P, bf16* CAT, const float* ln_g, const float* ln_b, const float* ws, const float* bs, int cid, int h, LAS float* vln, int tid) {
    { const int j = tid >> 2, qd = tid & 3; const bf16* vp = P + (size_t)(cid * CH + j) * NP + C_V + h * 128 + qd * 32;
      float v[32]; float s = 0.f;
#pragma unroll
      for (int i = 0; i < 4; ++i) { const u32x4 w = *(const u32x4*)(vp + 8 * i);
#pragma unroll
          for (int e = 0; e < 4; ++e) { v[8 * i + 2 * e] = __uint_as_float(w[e] << 16); v[8 * i + 2 * e + 1] = __uint_as_float(w[e] & 0xffff0000u); } }
#pragma unroll
      for (int i = 0; i < 32; ++i) s += v[i];
      s += __shfl_xor(s, 1); s += __shfl_xor(s, 2); const float mu = s * (1.f / 128.f); float q = 0.f;
#pragma unroll
      for (int i = 0; i < 32; ++i) { v[i] -= mu; q += v[i] * v[i]; }
      q += __shfl_xor(q, 1); q += __shfl_xor(q, 2); const float rstd = rsqrtf(q * (1.f / 128.f) + EPS);
#pragma unroll
      for (int i = 0; i < 32; ++i) { const int d = qd * 32 + i; vln[j * CH + d] = v[i] * rstd * ln_g[h * 128 + d] + ln_b[h * 128 + d]; } }
    __syncthreads();
    const int d = tid & 127, ig = __builtin_amdgcn_readfirstlane(tid >> 7);
    for (int ii = 0; ii < 32; ++ii) { const int i = ig * 32 + ii; const float* wr = ws + ((size_t)h * CH + i) * CH; float acc = 0.f;
#pragma unroll 16
        for (int j = 0; j < CH; ++j) acc += wr[j] * vln[j * CH + d];
        const size_t row = (size_t)cid * CH + i; const float u = bf2f(P[row * NP + C_U + h * 128 + d]);
        CAT[row * D + h * 128 + d] = (bf16)f2bf(u * (acc + bs[h * CH + i])); }
    __syncthreads();
}

__device__ __forceinline__ void gla_decay_item(const bf16* P, const float* wd2f, const float* bdf, const float* wd2b, const float* bdb, float* AF, float* AB, int row0, LAS float* dd, int lane) {
#pragma unroll
    for (int i = 0; i < 4; ++i) { const int idx = lane + 64 * i, r = idx >> 5, c = idx & 31; dd[idx] = bf2f(P[(size_t)(row0 + r) * NP + C_DF + c]); }
    LDS_WAIT(); asm volatile("" ::: "memory");
#pragma unroll 1
    for (int hi = 0; hi < 8; ++hi) { const int hd = lane + 64 * hi;
        float wf[16], wb[16];
#pragma unroll
        for (int r = 0; r < 16; ++r) { wf[r] = wd2f[r * 512 + hd]; wb[r] = wd2b[r * 512 + hd]; }
        const float bf_ = bdf[hd], bb_ = bdb[hd];
#pragma unroll 1
        for (int t = 0; t < 8; ++t) { float zf = bf_, zb = bb_;
#pragma unroll
            for (int r = 0; r < 16; ++r) { zf += dd[t * 32 + r] * wf[r]; zb += dd[t * 32 + 16 + r] * wb[r]; }
            AF[(size_t)(row0 + t) * 512 + hd] = __expf(log_sigmoid(zf) * (1.f / 16.f)); AB[(size_t)(row0 + t) * 512 + hd] = __expf(log_sigmoid(zb) * (1.f / 16.f)); }
    }
    LDS_WAIT(); asm volatile("" ::: "memory");
}
__device__ __forceinline__ int gla_row_of(int step, int b, int dir) { const bool isc = step < CTX; const int tt = isc ? step : step - CTX; const int pos = dir ? ((isc ? CTX - 1 : SEQ - 1) - tt) : tt; return isc ? MX + CTX * b + pos : SEQ * b + pos; }
__device__ __forceinline__ void gla_scan_task(const bf16* P, const float* AF, const float* AB, float* OF, float* OB, int task, LAS float* sl, int lane) {
    const int eb = task & 3, h = (task >> 2) & 3, dir = (task >> 4) & 1, b = task >> 5, e = eb * 64 + lane;
    const float* A = dir ? AB : AF; float* O = dir ? OB : OF;
    LAS float* sq = sl; LAS float* sk = sl + 128; LAS float* sa = sl + 256;
    float S[128];
#pragma unroll
    for (int d = 0; d < 128; ++d) S[d] = 0.f;
    const int NSTEP = CTX + SEQ;
    float nq[2], nk[2], na[2], nv;
    { const int row = gla_row_of(0, b, dir); const bf16* pr = P + (size_t)row * NP;
#pragma unroll
      for (int i = 0; i < 2; ++i) { const int d = lane + 64 * i; nq[i] = bf2f(pr[C_Q + h * 128 + d]); nk[i] = bf2f(pr[C_K + h * 128 + d]); na[i] = A[(size_t)row * 512 + h * 128 + d]; }
      nv = bf2f(pr[C_VV + h * 256 + e]); }
    for (int step = 0; step < NSTEP; ++step) {
        const int row = gla_row_of(step, b, dir);
#pragma unroll
        for (int i = 0; i < 2; ++i) { sq[lane + 64 * i] = nq[i] * 0.08838834764831845f; sk[lane + 64 * i] = nk[i]; sa[lane + 64 * i] = na[i]; }
        const float v = nv;
        LDS_WAIT(); asm volatile("" ::: "memory");
        if (step + 1 < NSTEP) { const int r2 = gla_row_of(step + 1, b, dir); const bf16* pr = P + (size_t)r2 * NP;
#pragma unroll
            for (int i = 0; i < 2; ++i) { const int d = lane + 64 * i; nq[i] = bf2f(pr[C_Q + h * 128 + d]); nk[i] = bf2f(pr[C_K + h * 128 + d]); na[i] = A[(size_t)r2 * 512 + h * 128 + d]; }
            nv = bf2f(pr[C_VV + h * 256 + e]); }
        float o = 0.f;
#pragma unroll
        for (int d4 = 0; d4 < 32; ++d4) { const f32x4 a4 = *(const LAS f32x4*)&sa[4 * d4], k4 = *(const LAS f32x4*)&sk[4 * d4], q4 = *(const LAS f32x4*)&sq[4 * d4];
#pragma unroll
            for (int t = 0; t < 4; ++t) { S[4 * d4 + t] = a4[t] * S[4 * d4 + t] + k4[t] * v; o += q4[t] * S[4 * d4 + t]; } }
        O[(size_t)row * 1024 + h * 256 + e] = o;
        LDS_WAIT(); asm volatile("" ::: "memory");
    }
}
__device__ __forceinline__ void gla_out_item(const bf16* P, const float* OF, const float* OB, const float* out_g, bf16* CAT, int row, int h, int lane) {
    const int e0 = h * 256 + 4 * lane;
    const f32x4 o = *(const f32x4*)(OF + (size_t)row * 1024 + e0) + *(const f32x4*)(OB + (size_t)row * 1024 + e0);
    const float ss = wave_sum((o[0] * o[0] + o[1] * o[1]) + (o[2] * o[2] + o[3] * o[3]));
    const float rstd = rsqrtf(ss * (1.f / 256.f) + EPS);
    const f32x4 g = *(const f32x4*)(out_g + e0); const u32x2 gw = *(const u32x2*)(P + (size_t)row * NP + C_G + e0);
    const float g0 = __uint_as_float(gw.x << 16), g1 = __uint_as_float(gw.x & 0xffff0000u), g2 = __uint_as_float(gw.y << 16), g3 = __uint_as_float(gw.y & 0xffff0000u);
    u32x2 w; w.x = pk2(o[0] * rstd * g[0] * silu_acc(g0), o[1] * rstd * g[1] * silu_acc(g1)); w.y = pk2(o[2] * rstd * g[2] * silu_acc(g2), o[3] * rstd * g[3] * silu_acc(g3));
    *(u32x2*)(CAT + (size_t)row * D + 1024 + e0) = w;
}

constexpr int NPH = 2 + 9 * NL;
struct Args { const float* in[23]; float* out; unsigned char* ws; int ph_lo, ph_hi, li, pad; };

#define IN(k) (lo <= (k) && (k) < hi)
#define SEAM(k) do { if (IN(k) && IN((k) + 1)) xcd_barrier(bar); } while (0)
template <int l> __device__ __forceinline__ void run_layer(const Args& a, LAS unsigned char* lds, const XcdBarrier& bar, int tid, int lane, int wave, int G, int bid, int gw, int ngw, int lo, int hi) {
    unsigned char* ws = a.ws;
    const float* x = a.in[0]; const float* ctx = a.in[2];
    const float* g_pre_mix = a.in[6]; const float* g_post_mix = a.in[7]; const float* g_pre_ffn = a.in[8]; const float* g_post_ffn = a.in[9];
    const float* ln_g = a.in[11]; const float* ln_b = a.in[12]; const float* gws = a.in[13]; const float* gbs = a.in[14];
    const float* wd2f = a.in[15]; const float* bdf = a.in[16]; const float* wd2b = a.in[17]; const float* bdb = a.in[18];
    const float* out_g = a.in[19];
    float* MOD = (float*)(ws + WS_MOD); bf16* WIN = (bf16*)(ws + WS_WIN); bf16* WOUT = (bf16*)(ws + WS_WOUT); bf16* WFI = (bf16*)(ws + WS_WFI); bf16* WFO = (bf16*)(ws + WS_WFO);
    float* X = (float*)(ws + WS_X); bf16* H = (bf16*)(ws + WS_H); bf16* P = (bf16*)(ws + WS_P); bf16* CAT = (bf16*)(ws + WS_CAT); float* Y = (float*)(ws + WS_Y); bf16* HID = (bf16*)(ws + WS_HID);
    float* AF = (float*)(ws + WS_AF); float* AB = (float*)(ws + WS_AB); float* OF = (float*)(ws + WS_OF); float* OB = (float*)(ws + WS_OB);
        const int pb = 2 + 9 * l;
        const float* modl = MOD + (size_t)l * 5 * NMOD;
        if (IN(pb + 0)) { pg8::Gemm g{H, WIN + (size_t)l * NP * D, M, NP, D}; pg8::StaticOrder S; S.init(M, NP, G, bid); pg8::EpiProj E{P, NP, 8};
            pg8::gemm_phase<pg8::EpiProj, pg8::StaticOrder, true, true>(lds, g, S, E); }
        SEAM(pb + 0);
        if (IN(pb + 1)) {
            for (int u = bid; u < NCHUNK * 8; u += G)
                gmlp_unit_simple(P, CAT, ln_g + l * 1024, ln_b + l * 1024, gws + (size_t)l * 8 * CH * CH, gbs + l * 8 * CH, u >> 3, u & 7, (LAS float*)lds, tid);
            LAS float* dd = (LAS float*)(lds + wave * 1024);
            for (int it = gw; it < M / 8; it += ngw) gla_decay_item(P, wd2f + l * 16 * 512, bdf + l * 512, wd2b + l * 16 * 512, bdb + l * 512, AF, AB, it * 8, dd, lane);
        }
        SEAM(pb + 1);
        if (IN(pb + 2)) {
            if (wave == 0 && bid < 128) gla_scan_task(P, AF, AB, OF, OB, bid, (LAS float*)lds, lane);
        }
        SEAM(pb + 2);
        if (IN(pb + 3)) {
            for (int it = gw; it < M * 4; it += ngw) gla_out_item(P, OF, OB, out_g + l * 1024, CAT, it >> 2, it & 3, lane);
        }
        SEAM(pb + 3);
        if (IN(pb + 4)) { pg8::Gemm g{CAT, WOUT + (size_t)l * D * D, M, D, D}; pg8::StaticOrder S; S.init(M, D, G, bid); pg8::EpiF32 E{Y, D};
            pg8::gemm_phase<pg8::EpiF32, pg8::StaticOrder, true, true>(lds, g, S, E); }
        SEAM(pb + 4);
        if (IN(pb + 5)) {
            RowArgs r{}; r.xin_x = l == 0 ? x : nullptr; r.xin_c = l == 0 ? ctx : nullptr; r.Y = Y; r.X = X; r.H = H; r.modA = modl; r.gA = g_post_mix + l * D; r.gB = g_pre_ffn + l * D; r.mode = 1; r.write_h = 1;
            for (int row = gw; row < M; row += ngw) row_pass(r, row, lane);
        }
        SEAM(pb + 5);
        if (IN(pb + 6)) { pg8::Gemm g{H, WFI + (size_t)l * 2 * FF * D, M, 2 * FF, D}; pg8::StaticOrder S; S.init(M, 2 * FF, G, bid); pg8::EpiSwiglu E{HID, FF};
            pg8::gemm_phase<pg8::EpiSwiglu, pg8::StaticOrder, true, true>(lds, g, S, E); }
        SEAM(pb + 6);
        if (IN(pb + 7)) { pg8::Gemm g{HID, WFO + (size_t)l * D * FF, M, D, FF}; pg8::StaticOrder S; S.init(M, D, G, bid); pg8::EpiF32 E{Y, D};
            pg8::gemm_phase<pg8::EpiF32, pg8::StaticOrder, true, true>(lds, g, S, E); }
        SEAM(pb + 7);
        if (IN(pb + 8)) {
            RowArgs r{}; r.Y = Y; r.X = X; r.out = a.out; r.H = H; r.modA = modl; r.modB = modl + 5 * NMOD; r.gA = g_post_ffn + l * D; r.gB = g_pre_mix + (l + 1 < NL ? l + 1 : l) * D; r.mode = 2; r.write_h = (l + 1 < NL); r.to_out = (l + 1 == NL);
            for (int row = gw; row < M; row += ngw) row_pass(r, row, lane);
        }
        SEAM(pb + 8);
}
__global__ void __launch_bounds__(512, 2) mega(Args a) {
    extern __shared__ __attribute__((aligned(16))) unsigned char lds_raw[];
    LAS unsigned char* lds = (LAS unsigned char*)lds_raw;
    const int tid = threadIdx.x, lane = tid & 63, wave = __builtin_amdgcn_readfirstlane(tid >> 6);
    const int G = gridDim.x, bid = blockIdx.x, gw = bid * 8 + wave, ngw = G * 8;
    volatile LAS unsigned* MISC = (volatile LAS unsigned*)(lds + MISC_OFF);
    if (tid < 32) MISC[tid] = 0u;
    __syncthreads();
    unsigned char* ws = a.ws;
    const int lo = a.ph_lo, hi = a.ph_hi;
    XcdBarrier bar; bar.bar = (unsigned*)(ws + WS_CTL) + CW_BAR + a.li * XCD_BAR_WORDS; bar.x = 0; bar.st = nullptr;
    if (hi - lo > 1) bar = xcd_barrier_post((unsigned*)(ws + WS_CTL) + CW_BAR + a.li * XCD_BAR_WORDS, MISC + 8);
    const float* x = a.in[0]; const float* c = a.in[1]; const float* ctx = a.in[2]; const float* cctx = a.in[3];
    const float* w_mod = a.in[4]; const float* b_mod = a.in[5];
    const float* g_pre_mix = a.in[6]; const float* g_post_mix = a.in[7]; const float* g_pre_ffn = a.in[8]; const float* g_post_ffn = a.in[9];
    const float* w_in = a.in[10]; const float* ln_g = a.in[11]; const float* ln_b = a.in[12]; const float* gws = a.in[13]; const float* gbs = a.in[14];
    const float* wd2f = a.in[15]; const float* bdf = a.in[16]; const float* wd2b = a.in[17]; const float* bdb = a.in[18];
    const float* out_g = a.in[19]; const float* w_out = a.in[20]; const float* w_fi = a.in[21]; const float* w_fo = a.in[22];
    float* MOD = (float*)(ws + WS_MOD); bf16* WIN = (bf16*)(ws + WS_WIN); bf16* WOUT = (bf16*)(ws + WS_WOUT); bf16* WFI = (bf16*)(ws + WS_WFI); bf16* WFO = (bf16*)(ws + WS_WFO);
    float* X = (float*)(ws + WS_X); bf16* H = (bf16*)(ws + WS_H); bf16* P = (bf16*)(ws + WS_P); bf16* CAT = (bf16*)(ws + WS_CAT); float* Y = (float*)(ws + WS_Y); bf16* HID = (bf16*)(ws + WS_HID);
    float* AF = (float*)(ws + WS_AF); float* AB = (float*)(ws + WS_AB); float* OF = (float*)(ws + WS_OF); float* OB = (float*)(ws + WS_OB);

    if (IN(0)) {
        LAS float* act = (LAS float*)(lds + 8 * 8448);
        for (int i = tid; i < 5 * D; i += 512) { const int r = i / D, k = i % D; const float v = r < NB ? c[r * D + k] : cctx[k]; act[i] = silu_acc(v); }
        __syncthreads();
        for (int item = wave * G + bid; item < NL * (NMOD / 32); item += ngw) {
            const int cg = item % (NMOD / 32), l = item / (NMOD / 32), kq = lane >> 3;
            const int j = cg * 32 + 4 * (lane & 7);
            const float* w = w_mod + ((size_t)l * D + kq) * NMOD + j;
            f32x4 a0 = {0.f, 0.f, 0.f, 0.f}, a1 = a0, a2 = a0, a3 = a0, a4 = a0;
#pragma unroll 8
            for (int i = 0; i < D / 8; ++i) { const f32x4 xv = *(const f32x4*)(w + (size_t)(8 * i) * NMOD); const int k = 8 * i + kq;
                a0 += xv * act[0 * D + k]; a1 += xv * act[1 * D + k]; a2 += xv * act[2 * D + k]; a3 += xv * act[3 * D + k]; a4 += xv * act[4 * D + k]; }
#pragma unroll
            for (int t = 0; t < 4; ++t) {
#pragma unroll
                for (int o = 8; o < 64; o <<= 1) { a0[t] += __shfl_xor(a0[t], o); a1[t] += __shfl_xor(a1[t], o); a2[t] += __shfl_xor(a2[t], o); a3[t] += __shfl_xor(a3[t], o); a4[t] += __shfl_xor(a4[t], o); } }
            if (kq == 0) { const f32x4 bb = *(const f32x4*)(b_mod + (size_t)l * NMOD + j); float* o = MOD + (size_t)l * 5 * NMOD + j;
                *(f32x4*)(o) = a0 + bb; *(f32x4*)(o + NMOD) = a1 + bb; *(f32x4*)(o + 2 * NMOD) = a2 + bb; *(f32x4*)(o + 3 * NMOD) = a3 + bb; *(f32x4*)(o + 4 * NMOD) = a4 + bb; }
        }
        LAS float* scr = (LAS float*)(lds + wave * 8448);
        int it0 = 0;
        conv_matrix(w_in, WIN, D, PIN, NP, 1, it0, gw, ngw, scr, lane);
        conv_matrix(w_out, WOUT, D, D, D, 0, it0, gw, ngw, scr, lane);
        conv_matrix(w_fi, WFI, D, 2 * FF, 2 * FF, 2, it0, gw, ngw, scr, lane);
        conv_matrix(w_fo, WFO, FF, D, D, 0, it0, gw, ngw, scr, lane);
    }
    SEAM(0);
    if (IN(1)) {
        RowArgs r{}; r.xin_x = x; r.xin_c = ctx; r.X = X; r.H = H; r.modB = MOD; r.gB = g_pre_mix; r.mode = 0; r.write_h = 1;
        for (int row = gw; row < M; row += ngw) row_pass(r, row, lane);
    }
    SEAM(1);
    run_layer<0>(a, lds, bar, tid, lane, wave, G, bid, gw, ngw, lo, hi);
    run_layer<1>(a, lds, bar, tid, lane, wave, G, bid, gw, ngw, lo, hi);
    run_layer<2>(a, lds, bar, tid, lane, wave, G, bid, gw, ngw, lo, hi);
    run_layer<3>(a, lds, bar, tid, lane, wave, G, bid, gw, ngw, lo, hi);
#undef IN
#undef SEAM
}

#ifndef MK_SPLIT
#define MK_SPLIT 0
#endif
extern "C" void kernel_launch(void* const* d_in, const int* in_sizes, int n_in, void* d_out, int out_size, void* d_ws, size_t ws_size, hipStream_t stream) {
    static int grid = 0;
    if (grid == 0) {
        if (n_in != 23 || ws_size < WS_END || out_size != MX * D) { fprintf(stderr, "kernel_launch: unexpected shapes (n_in %d, ws %zu, out %d)\n", n_in, ws_size, out_size); grid = -1; return; }
        int dev = 0, cus = 0, per_cu = 0;
        if (hipGetDevice(&dev) != hipSuccess || hipDeviceGetAttribute(&cus, hipDeviceAttributeMultiprocessorCount, dev) != hipSuccess) { grid = -1; return; }
        if (hipFuncSetAttribute((const void*)mega, hipFuncAttributeMaxDynamicSharedMemorySize, LDS_BYTES) != hipSuccess) { fprintf(stderr, "kernel_launch: hipFuncSetAttribute failed\n"); grid = -1; return; }
        if (hipOccupancyMaxActiveBlocksPerMultiprocessor(&per_cu, (const void*)mega, 512, LDS_BYTES) != hipSuccess || per_cu < 1) { fprintf(stderr, "kernel_launch: occupancy query says %d\n", per_cu); }
        (void)hipGetLastError();
        grid = cus;
    }
    if (grid < 0) return;
    (void)hipMemsetAsync((char*)d_ws + WS_CTL, 0, ZERO_BYTES, stream);
    Args a{};
    for (int i = 0; i < 23; ++i) a.in[i] = (const float*)d_in[i];
    a.out = (float*)d_out; a.ws = (unsigned char*)d_ws;
#if MK_SPLIT
    for (int p = 0; p < NPH; ++p) { a.ph_lo = p; a.ph_hi = p + 1; a.li = 0; hipLaunchKernelGGL(mega, dim3(grid), dim3(512), LDS_BYTES, stream, a); }
#else
    a.ph_lo = 0; a.ph_hi = NPH; a.li = 0;
    hipLaunchKernelGGL(mega, dim3(grid), dim3(512), LDS_BYTES, stream, a);
#endif
}
```

```cpp
#include <hip/hip_runtime.h>
#include <cstdio>
#include <cstdint>
namespace pg8 {
#define PG8_LAS __attribute__((address_space(3)))
typedef unsigned short bf16_t;
typedef short bf16x8 __attribute__((ext_vector_type(8)));
typedef float f32x4 __attribute__((ext_vector_type(4)));
typedef unsigned u32x4 __attribute__((ext_vector_type(4)));
constexpr int BM = 256, BK = 64, HALF = 128, HTB = HALF * BK * 2  , STAGE_BYTES = 8 * HTB, NXCD = 8, WGM = 8;

__host__ __device__ __forceinline__ int lds_byte(int r, int c) { const int st = (r >> 4) * 2 + (c >> 5), rr = r & 15, cc = c & 31, ob = rr * 64 + cc * 2; return st * 1024 + (ob ^ (((ob >> 9) & 1) << 5)); }
__host__ __device__ __forceinline__ void stage_rc(int b, int& R, int& C) { const int st = b / 1024, sb = b % 1024, swz = sb ^ (((sb >> 9) & 1) << 5); R = (st >> 1) * 16 + swz / 64; C = (st & 1) * 32 + (swz % 64) / 2; }
__host__ __device__ __forceinline__ int perm32(int rho) { const int n = rho >> 4, i = rho & 15; return 8 * (i >> 2) + 4 * n + (i & 3); }

struct Unit { int pm, pn; };
struct Gemm { const bf16_t* A; const bf16_t* Bt; int M, N, K, pad; };

struct StaticOrder {
    int nM, nN, nwg, G, c;
    __host__ __device__ void init(int M, int N, int G_, int c_) { nM = M / BM; nN = N / BM; nwg = nM * nN; G = G_; c = c_; }
    __host__ __device__ bool next(int i, Unit& u) const {
        const long L = (long)i * G + c; if (L >= nwg) return false;
        int wgid = (int)L; { const int q = nwg / NXCD, r = nwg % NXCD, xcd = wgid % NXCD, off = wgid / NXCD; wgid = (xcd < r ? xcd * (q + 1) : r * (q + 1) + (xcd - r) * q) + off; }
        const int nig = WGM * nN, gid = wgid / nig, fm = gid * WGM, gsz = (nM - fm) < WGM ? (nM - fm) : WGM;
        u.pm = fm + ((wgid % nig) % gsz); u.pn = (wgid % nig) / gsz; return true;
    }
    __device__ __forceinline__ void a_ready(const Unit&) const {}
    __device__ __forceinline__ void done(const Unit&) const {}
};


__device__ __forceinline__ unsigned cvt_pk_bf16(float lo, float hi) { unsigned r; asm volatile("v_cvt_pk_bf16_f32 %0, %1, %2" : "=v"(r) : "v"(lo), "v"(hi)); return r; }
__device__ __forceinline__ float fast_sigmoid(float x) { return __builtin_amdgcn_rcpf(1.0f + __builtin_amdgcn_exp2f(-1.4426950408889634f * x)); }
__device__ __forceinline__ float gelu_tanh(float x) { const float y = 1.5957691216057308f * (x + 0.044715f * x * x * x); return x * fast_sigmoid(y); }
__device__ __forceinline__ float silu_f(float x) { return x * fast_sigmoid(x); }

struct EpiF32 {
    static constexpr bool PERM = false, AFTER_DRAIN = false;
    float* C; int ldc; int pad;
    __device__ __forceinline__ void operator()(const f32x4 (&acc)[2][2][4][2], const Unit& u, int wr, int wc, int fr, int fq) const {
        const int row0 = u.pm * BM + wr * 64 + fr, col0 = u.pn * BM + wc * 32 + 4 * fq;
#pragma unroll
        for (int ai = 0; ai < 2; ++ai)
#pragma unroll
            for (int m = 0; m < 4; ++m) { float* rowp = C + (size_t)(row0 + ai * HALF + m * 16) * ldc + col0;
#pragma unroll
                for (int bj = 0; bj < 2; ++bj)
#pragma unroll
                    for (int n = 0; n < 2; ++n) *(f32x4*)(rowp + bj * HALF + n * 16) = acc[ai][bj][m][n]; }
    }
};
struct EpiProj {
    static constexpr bool PERM = true, AFTER_DRAIN = false;
    bf16_t* O; int ldc; int ngelu;
    __device__ __forceinline__ void operator()(const f32x4 (&acc)[2][2][4][2], const Unit& u, int wr, int wc, int fr, int fq) const {
        const int row0 = u.pm * BM + wr * 64 + fr, col0 = u.pn * BM + wc * 32 + 8 * fq;
        const bool act = u.pn < ngelu;
#pragma unroll
        for (int ai = 0; ai < 2; ++ai)
#pragma unroll
            for (int m = 0; m < 4; ++m) { bf16_t* rowp = O + (size_t)(row0 + ai * HALF + m * 16) * ldc + col0;
#pragma unroll
                for (int bj = 0; bj < 2; ++bj) { f32x4 v0 = acc[ai][bj][m][0], v1 = acc[ai][bj][m][1];
                    if (act) {
#pragma unroll
                        for (int j = 0; j < 4; ++j) { v0[j] = gelu_tanh(v0[j]); v1[j] = gelu_tanh(v1[j]); } }
                    u32x4 w; w.x = cvt_pk_bf16(v0[0], v0[1]); w.y = cvt_pk_bf16(v0[2], v0[3]); w.z = cvt_pk_bf16(v1[0], v1[1]); w.w = cvt_pk_bf16(v1[2], v1[3]);
                    *(u32x4*)(rowp + bj * HALF) = w; } }
    }
};
struct EpiSwiglu {
    static constexpr bool PERM = true, AFTER_DRAIN = false;
    bf16_t* O; int ldc; int pad;
    __device__ __forceinline__ void operator()(const f32x4 (&acc)[2][2][4][2], const Unit& u, int wr, int wc, int fr, int fq) const {
        const int row0 = u.pm * BM + wr * 64 + fr, col0 = u.pn * HALF + wc * 32 + 8 * fq;
#pragma unroll
        for (int ai = 0; ai < 2; ++ai)
#pragma unroll
            for (int m = 0; m < 4; ++m) { bf16_t* rowp = O + (size_t)(row0 + ai * HALF + m * 16) * ldc + col0;
                f32x4 h0, h1;
#pragma unroll
                for (int j = 0; j < 4; ++j) { h0[j] = silu_f(acc[ai][0][m][0][j]) * acc[ai][1][m][0][j]; h1[j] = silu_f(acc[ai][0][m][1][j]) * acc[ai][1][m][1][j]; }
                u32x4 w; w.x = cvt_pk_bf16(h0[0], h0[1]); w.y = cvt_pk_bf16(h0[2], h0[3]); w.z = cvt_pk_bf16(h1[0], h1[1]); w.w = cvt_pk_bf16(h1[2], h1[3]);
                *(u32x4*)rowp = w; }
    }
};

template <class Epi, class Sched, bool ALIGN_EPI = false, bool SP2 = false>
__device__ __forceinline__ void gemm_phase(PG8_LAS unsigned char* lds, const Gemm g, const Sched& S, const Epi& E) {
    int tid_o = threadIdx.x; asm volatile("" : "+v"(tid_o));
    const int tid = tid_o, wid = __builtin_amdgcn_readfirstlane(tid >> 6), lane = tid & 63, wr = wid >> 2, wc = wid & 3, fr = lane & 15, fq = lane >> 4;
    const int K = g.K, nt = K / BK;
    unsigned voffA[2], voffB[2];
#pragma unroll
    for (int i = 0; i < 2; ++i) { int R, C; stage_rc(tid * 16 + i * 8192, R, C); const int Rb = Epi::PERM ? ((R & ~31) + perm32(R & 31)) : R;
        voffA[i] = (unsigned)(R * K + C) * 2u; voffB[i] = (unsigned)(Rb * K + C) * 2u; }
    const size_t kstep = (size_t)(BK * 2);
    const size_t hstep = (size_t)HALF * K * 2;
    const size_t tstep = 2 * hstep;
    const unsigned ldsw = (unsigned)wid * 1024u;
    const int aoff = lds_byte(wr * 64 + fr, fq * 8), boff = lds_byte(wc * 32 + fr, fq * 8);
#define PG8_SA(b, h) (((b) * 2 + (h)) * HTB)
#define PG8_SB(b, h) ((4 + (b) * 2 + (h)) * HTB)
#define PG8_STAGE(bufoff, gbase, voff) do { _Pragma("unroll") for (int _i = 0; _i < 2; ++_i) \
        __builtin_amdgcn_global_load_lds((const unsigned*)((const char*)(gbase) + (voff)[_i]), (PG8_LAS unsigned*)(lds + (bufoff) + ldsw + _i * 8192), 16, 0, 0); } while (0)
#define PG8_LDA(dst, b, h) do { _Pragma("unroll") for (int m = 0; m < 4; ++m) _Pragma("unroll") for (int k = 0; k < 2; ++k) dst[m][k] = *(const PG8_LAS bf16x8*)(lds + PG8_SA(b, h) + aoff + m * 2048 + k * 1024); } while (0)
#define PG8_LDB(dst, b, h) do { _Pragma("unroll") for (int n = 0; n < 2; ++n) _Pragma("unroll") for (int k = 0; k < 2; ++k) dst[n][k] = *(const PG8_LAS bf16x8*)(lds + PG8_SB(b, h) + boff + n * 2048 + k * 1024); } while (0)
#define PG8_MMA(ai, bj, At, Bt) do { __builtin_amdgcn_s_setprio(1); _Pragma("unroll") for (int m = 0; m < 4; ++m) _Pragma("unroll") for (int n = 0; n < 2; ++n) _Pragma("unroll") for (int k = 0; k < 2; ++k) \
        acc[ai][bj][m][n] = __builtin_amdgcn_mfma_f32_16x16x32_bf16(Bt[n][k], At[m][k], acc[ai][bj][m][n], 0, 0, 0); __builtin_amdgcn_s_setprio(0); } while (0)
#define PG8_WAIT_V(n) asm volatile("s_waitcnt vmcnt(" #n ")" ::: "memory")
#define PG8_WAIT_L(n) asm volatile("s_waitcnt lgkmcnt(" #n ")" ::: "memory")
#define PG8_BAR __builtin_amdgcn_s_barrier()
#define PG8_SCHED __builtin_amdgcn_sched_barrier(0)
    Unit cur, nxt; int ui = 0;
    if (!S.next(0, cur)) return;
    f32x4 acc[2][2][4][2];
#pragma unroll
    for (int a = 0; a < 2; ++a)
#pragma unroll
        for (int b = 0; b < 2; ++b)
#pragma unroll
            for (int m = 0; m < 4; ++m)
#pragma unroll
                for (int n = 0; n < 2; ++n) acc[a][b][m][n] = (f32x4){0.f, 0.f, 0.f, 0.f};
    bf16x8 At[4][2], B0[2][2], B1[2][2];
    const char* cA = (const char*)g.A + (size_t)cur.pm * tstep; const char* cB = (const char*)g.Bt + (size_t)cur.pn * tstep;
    S.a_ready(cur);
    if constexpr (SP2) {
        PG8_STAGE(PG8_SB(0, 0), cB, voffB); PG8_STAGE(PG8_SB(0, 1), cB + hstep, voffB); PG8_STAGE(PG8_SA(0, 0), cA, voffA); PG8_STAGE(PG8_SA(0, 1), cA + hstep, voffA);
        if (wr == 1) PG8_BAR;
        PG8_WAIT_V(2); PG8_BAR;
        PG8_STAGE(PG8_SB(1, 0), cB + kstep, voffB); PG8_STAGE(PG8_SA(1, 0), cA + kstep, voffA); PG8_STAGE(PG8_SB(1, 1), cB + hstep + kstep, voffB);
        PG8_WAIT_V(6); PG8_BAR;
    } else {
        PG8_STAGE(PG8_SB(0, 0), cB, voffB); PG8_STAGE(PG8_SA(0, 0), cA, voffA); PG8_STAGE(PG8_SB(0, 1), cB + hstep, voffB); PG8_STAGE(PG8_SA(0, 1), cA + hstep, voffA);
        if (wr == 1) PG8_BAR;
        PG8_WAIT_V(4); PG8_BAR;
        PG8_STAGE(PG8_SB(1, 0), cB + kstep, voffB); PG8_STAGE(PG8_SA(1, 0), cA + kstep, voffA); PG8_STAGE(PG8_SB(1, 1), cB + hstep + kstep, voffB);
        PG8_WAIT_V(6); PG8_BAR;
    }
    for (;;) {
        const bool has_next = S.next(ui + 1, nxt);
        const char* nA = has_next ? (const char*)g.A + (size_t)nxt.pm * tstep : cA; const char* nB = has_next ? (const char*)g.Bt + (size_t)nxt.pn * tstep : cB;
        for (int t = 0; t < nt; t += 2) {
            const bool last = (t == nt - 2);
            const char* a1 = cA + (size_t)(t + 1) * kstep;
            const char* a2 = last ? nA : cA + (size_t)(t + 2) * kstep; const char* b2 = last ? nB : cB + (size_t)(t + 2) * kstep;
            const char* a3 = a2 + kstep; const char* b3 = b2 + kstep;
            if (last && has_next) S.a_ready(nxt);
            if constexpr (SP2) {
            PG8_LDB(B0, 0, 0); PG8_LDB(B1, 0, 1); PG8_SCHED; PG8_LDA(At, 0, 0); PG8_STAGE(PG8_SA(1, 1), a1 + hstep, voffA);
            PG8_WAIT_V(8); PG8_WAIT_L(0); PG8_BAR; PG8_MMA(0, 0, At, B0); PG8_MMA(0, 1, At, B1); PG8_BAR; PG8_SCHED;
            PG8_LDA(At, 0, 1); PG8_STAGE(PG8_SB(0, 0), b2, voffB); PG8_STAGE(PG8_SB(0, 1), b2 + hstep, voffB); PG8_STAGE(PG8_SA(0, 0), a2, voffA);
            PG8_WAIT_V(8); PG8_WAIT_L(0); PG8_BAR; PG8_MMA(1, 0, At, B0); PG8_MMA(1, 1, At, B1); PG8_BAR; PG8_SCHED;
            PG8_LDB(B0, 1, 0); PG8_LDB(B1, 1, 1); PG8_SCHED; PG8_LDA(At, 1, 0); PG8_STAGE(PG8_SA(0, 1), a2 + hstep, voffA);
            PG8_WAIT_V(8); PG8_WAIT_L(0); PG8_BAR; PG8_MMA(0, 0, At, B0); PG8_MMA(0, 1, At, B1); PG8_BAR; PG8_SCHED;
            PG8_LDA(At, 1, 1); PG8_STAGE(PG8_SB(1, 0), b3, voffB); PG8_STAGE(PG8_SB(1, 1), b3 + hstep, voffB); PG8_STAGE(PG8_SA(1, 0), a3, voffA);
            PG8_WAIT_V(8); PG8_WAIT_L(0); PG8_BAR; PG8_MMA(1, 0, At, B0); PG8_MMA(1, 1, At, B1); PG8_BAR; PG8_SCHED;
            } else {
            PG8_LDB(B0, 0, 0); PG8_SCHED; PG8_LDA(At, 0, 0); PG8_STAGE(PG8_SA(1, 1), a1 + hstep, voffA);
            PG8_WAIT_L(8); PG8_BAR; PG8_WAIT_L(0); PG8_MMA(0, 0, At, B0); PG8_BAR; PG8_SCHED;
            PG8_LDB(B1, 0, 1); PG8_STAGE(PG8_SB(0, 0), b2, voffB);
            PG8_BAR; PG8_WAIT_L(0); PG8_MMA(0, 1, At, B1); PG8_BAR;
            PG8_LDA(At, 0, 1); PG8_STAGE(PG8_SA(0, 0), a2, voffA);
            PG8_BAR; PG8_WAIT_L(0); PG8_MMA(1, 0, At, B0); PG8_BAR; PG8_SCHED;
            PG8_STAGE(PG8_SB(0, 1), b2 + hstep, voffB);
            PG8_WAIT_V(6); PG8_BAR; PG8_MMA(1, 1, At, B1); PG8_BAR;
            PG8_LDB(B0, 1, 0); PG8_SCHED; PG8_LDA(At, 1, 0); PG8_STAGE(PG8_SA(0, 1), a2 + hstep, voffA);
            PG8_WAIT_L(8); PG8_BAR; PG8_WAIT_L(0); PG8_MMA(0, 0, At, B0); PG8_BAR; PG8_SCHED;
            PG8_LDB(B1, 1, 1); PG8_STAGE(PG8_SB(1, 0), b3, voffB);
            PG8_BAR; PG8_WAIT_L(0); PG8_MMA(0, 1, At, B1); PG8_BAR;
            PG8_LDA(At, 1, 1); PG8_STAGE(PG8_SA(1, 0), a3, voffA);
            PG8_BAR; PG8_WAIT_L(0); PG8_MMA(1, 0, At, B0); PG8_BAR; PG8_SCHED;
            PG8_STAGE(PG8_SB(1, 1), b3 + hstep, voffB);
            PG8_WAIT_V(6); PG8_BAR; PG8_MMA(1, 1, At, B1); PG8_BAR;
            }
        }
        if constexpr (ALIGN_EPI) { if (wr == 0) PG8_BAR; }
        if constexpr (!Epi::AFTER_DRAIN) { E(acc, cur, wr, wc, fr, fq); S.done(cur); }
        if (!has_next) break;
#pragma unroll
        for (int a = 0; a < 2; ++a)
#pragma unroll
            for (int b = 0; b < 2; ++b)
#pragma unroll
                for (int m = 0; m < 4; ++m)
#pragma unroll
                    for (int n = 0; n < 2; ++n) acc[a][b][m][n] = (f32x4){0.f, 0.f, 0.f, 0.f};
        cur = nxt; cA = nA; cB = nB; ++ui;
        if constexpr (ALIGN_EPI) { if (wr == 1) PG8_BAR; }
    }
    PG8_WAIT_V(0);
    if constexpr (!ALIGN_EPI) { if (wr == 0) PG8_BAR; }
    PG8_BAR;
    if constexpr (Epi::AFTER_DRAIN) { E.fused(acc, cur, wr, wc, fr, fq, lds, wid, lane); S.done(cur); }
#undef PG8_SA
#undef PG8_SB
#undef PG8_STAGE
#undef PG8_LDA
#undef PG8_LDB
#undef PG8_MMA
#undef PG8_WAIT_V
#undef PG8_WAIT_L
#undef PG8_BAR
#undef PG8_SCHED
}
}
#define XB_TMO      128
#define XB_XCNT(j)  (256  + 64 * (j))
#define XB_XSUB(j)  (1280 + 64 * (j))
#define XB_XGEN(j)  (2304 + 64 * (j))
#define XB_TOP      3328
#define XB_TOPGEN   3392
#define XCD_BAR_WORDS 3456
#define XB_SPIN_CAP (1u << 18)
#define LAS __attribute__((address_space(3)))

__device__ __forceinline__ unsigned xb_ld(unsigned* p)              { return __hip_atomic_load(p, __ATOMIC_RELAXED, __HIP_MEMORY_SCOPE_AGENT); }
__device__ __forceinline__ unsigned xb_add(unsigned* p, unsigned v) { return __hip_atomic_fetch_add(p, v, __ATOMIC_RELAXED, __HIP_MEMORY_SCOPE_AGENT); }
__device__ __forceinline__ unsigned xb_xcc_id() { return (unsigned)__builtin_amdgcn_s_getreg((3 << 11) | 20) & 0xFu; }
#define XB_SPIN(cond, bar) do { unsigned _sp = 0; while (cond) { __builtin_amdgcn_s_sleep(1); \
    if ((++_sp & 255u) == 0u) { if (xb_ld(&(bar)[XB_TMO])) break; if (_sp > XB_SPIN_CAP) { atomicAdd(&(bar)[XB_TMO], 1u); break; } } } } while (0)

struct XcdBarrier {
    unsigned* bar; unsigned x;
    volatile LAS unsigned* st;
};

__device__ __forceinline__ XcdBarrier xcd_barrier_post(unsigned* bar, volatile LAS unsigned* st) {
    XcdBarrier b; b.bar = bar; b.x = xb_xcc_id(); b.st = st;
    if (threadIdx.x == 0) (void)xb_add(&bar[XB_XCNT(b.x)], 1u);
    return b;
}
__device__ __forceinline__ void xcd_barrier_complete(unsigned* bar, unsigned x, unsigned& nloc, unsigned& nx) {
    const unsigned G = gridDim.x * gridDim.y * gridDim.z;
    unsigned sum, cnt, mine, sp = 0u;
    for (;;) {
        sum = 0u; cnt = 0u; mine = 0u;
#pragma unroll
        for (unsigned j = 0; j < 16; ++j) { const unsigned c = xb_ld(&bar[XB_XCNT(j)]); sum += c; cnt += (c > 0u) ? 1u : 0u; mine = (j == x) ? c : mine; }
        if (sum == G) break;
        __builtin_amdgcn_s_sleep(1);
        if ((++sp & 255u) == 0u) { if (xb_ld(&bar[XB_TMO])) break; if (sp > XB_SPIN_CAP) { atomicAdd(&bar[XB_TMO], 1u); break; } }
    }
    nloc = mine > 0u ? mine : 1u; nx = cnt > 0u ? cnt : 1u;
}

__device__ __forceinline__ void xcd_barrier(const XcdBarrier& b) {
    asm volatile("s_waitcnt vmcnt(0)" ::: "memory");
    __syncthreads();
    if (threadIdx.x == 0) {
        unsigned* bar = b.bar;
        __builtin_amdgcn_s_waitcnt(0);
        unsigned nloc = b.st[0], nx = b.st[1];
        if (nloc == 0u) { xcd_barrier_complete(bar, b.x, nloc, nx); b.st[0] = nloc; b.st[1] = nx; }
        const unsigned old = xb_add(&bar[XB_XSUB(b.x)], 1u);
        const unsigned gen = old / nloc;
        if (old + 1u == (gen + 1u) * nloc) {
            __builtin_amdgcn_fence(__ATOMIC_RELEASE, "agent");
            asm volatile("s_waitcnt vmcnt(0)" ::: "memory");
            const unsigned og = xb_add(&bar[XB_TOP], 1u);
            const unsigned tg = og / nx;
            if (og + 1u == (tg + 1u) * nx) xb_add(&bar[XB_TOPGEN], 1u);
            else XB_SPIN(xb_ld(&bar[XB_TOPGEN]) == tg, bar);
            __builtin_amdgcn_fence(__ATOMIC_ACQUIRE, "agent");
            xb_add(&bar[XB_XGEN(b.x)], 1u);
            asm volatile("s_waitcnt vmcnt(0)" ::: "memory");
        } else {
            XB_SPIN(xb_ld(&bar[XB_XGEN(b.x)]) == gen, bar);
            __builtin_amdgcn_fence(__ATOMIC_ACQUIRE, "agent");
            asm volatile("s_waitcnt vmcnt(0)" ::: "memory");
        }
    }
    __syncthreads();
}

typedef unsigned short bf16;
typedef float f32x4 __attribute__((ext_vector_type(4)));
typedef unsigned u32x4 __attribute__((ext_vector_type(4)));
typedef unsigned u32x2 __attribute__((ext_vector_type(2)));
constexpr int D = 2048, NB = 4, SEQ = 4096, NL = 4, CTX = 256, CH = 128;
constexpr int MX = NB * SEQ, MC = NB * CTX, M = MX + MC;
constexpr int PIN = 5152, NP = 5376, FF = 5632, NMOD = 6 * D;
constexpr int C_U = 0, C_V = 1024, C_Q = 2048, C_K = 2560, C_VV = 3072, C_G = 4096, C_DF = 5120, C_DB = 5136;
constexpr int NCHUNK = M / CH;
constexpr float EPS = 1e-6f;
constexpr size_t MiB = 1u << 20;
constexpr size_t WS_CTL = 0, WS_MOD = 1 * MiB, ZERO_BYTES = 2 * MiB, WS_WIN = 2 * MiB, WS_WOUT = WS_WIN + 84 * MiB, WS_WFI = WS_WOUT + 32 * MiB, WS_WFO = WS_WFI + 176 * MiB,
                 WS_X = WS_WFO + 88 * MiB, WS_H = WS_X + 136 * MiB, WS_P = WS_H + 68 * MiB, WS_CAT = WS_P + 179 * MiB, WS_Y = WS_CAT + 68 * MiB, WS_HID = WS_Y + 136 * MiB,
                 WS_DS = WS_HID + 187 * MiB, WS_SP = WS_DS + 136 * MiB, WS_DEC = WS_SP + 68 * MiB, WS_END = WS_DEC + 1 * MiB;
static_assert((size_t)NL * NP * D * 2 <= 84 * MiB && (size_t)NL * 2 * FF * D * 2 <= 176 * MiB && (size_t)NL * D * FF * 2 <= 88 * MiB && (size_t)M * NP * 2 <= 179 * MiB && (size_t)M * FF * 2 <= 187 * MiB, "ws map");
constexpr int CW_BAR = 4096;
constexpr int LDS_BYTES = 163840, MISC_OFF = LDS_BYTES - 256;

__device__ __forceinline__ float bf2f(bf16 b) { return __uint_as_float(((unsigned)b) << 16); }
__device__ __forceinline__ unsigned f2bf(float f) { unsigned u = __float_as_uint(f); return (u + 0x7fffu + ((u >> 16) & 1u)) >> 16; }
__device__ __forceinline__ unsigned pk2(float lo, float hi) { return f2bf(lo) | (f2bf(hi) << 16); }
__device__ __forceinline__ float wave_sum(float v) {
#pragma unroll
    for (int o = 1; o < 64; o <<= 1) v += __shfl_xor(v, o);
    return v;
}
__device__ __forceinline__ float sigmoid_acc(float x) { return 1.0f / (1.0f + __expf(-x)); }
__device__ __forceinline__ float silu_acc(float x) { return x * sigmoid_acc(x); }
__device__ __forceinline__ float log_sigmoid(float z) { return fminf(z, 0.f) - log1pf(__expf(-fabsf(z))); }
__device__ __forceinline__ int mod_row(int row) { return row < MX ? row / SEQ : NB; }
#define LDS_WAIT() asm volatile("s_waitcnt lgkmcnt(0)" ::: "memory")


__device__ __forceinline__ int map_col(int mode, int r) {
    if (mode == 0) return r;
    if (mode == 1) return r < PIN ? r : -1;
    const int pn = r >> 8, rr = r & 255; return rr < 128 ? pn * 128 + rr : FF + pn * 128 + (rr - 128);
}
__device__ __forceinline__ void transpose_item(const float* W, int K, int Nsrc, bf16* T, int n0, int c0, int k0, LAS float* scr, int lane) {
    if (c0 >= 0) {
#pragma unroll 8
        for (int i = 0; i < 32; ++i) { const int kk = 2 * i + (lane >> 5); scr[kk * 33 + (lane & 31)] = W[(size_t)(k0 + kk) * Nsrc + c0 + (lane & 31)]; }
    } else {
#pragma unroll 8
        for (int i = 0; i < 32; ++i) { const int kk = 2 * i + (lane >> 5); scr[kk * 33 + (lane & 31)] = 0.f; }
    }
    LDS_WAIT(); asm volatile("" ::: "memory");
    const int c = lane & 7;
#pragma unroll
    for (int j = 0; j < 4; ++j) { const int n = (lane >> 3) + 8 * j; const LAS float* s = scr + (8 * c) * 33 + n;
        u32x4 o; o.x = pk2(s[0 * 33], s[1 * 33]); o.y = pk2(s[2 * 33], s[3 * 33]); o.z = pk2(s[4 * 33], s[5 * 33]); o.w = pk2(s[6 * 33], s[7 * 33]);
        *(u32x4*)(T + (size_t)(n0 + n) * K + k0 + 8 * c) = o; }
    LDS_WAIT(); asm volatile("" ::: "memory");
}
__device__ __forceinline__ void conv_matrix(const float* W, bf16* T, int K, int Nsrc, int Ndst, int mode, int& it0, int gw, int ngw, LAS float* scr, int lane) {
    const int nblk = Ndst / 32, per_layer = (K / 64) * nblk, total = NL * per_layer;
    int first = ((gw - it0) % ngw + ngw) % ngw;
    for (int it = first; it < total; it += ngw) {
        const int l = it / per_layer, r = it % per_layer, kb = r / nblk, nb = r % nblk;
        transpose_item(W + (size_t)l * K * Nsrc, K, Nsrc, T + (size_t)l * Ndst * K, 32 * nb, map_col(mode, 32 * nb), 64 * kb, scr, lane);
    }
    it0 += total;
}
struct RowArgs { const float* xin_x; const float* xin_c; const float* Y; float* X; float* out; bf16* H; const float* modA; const float* modB; const float* gA; const float* gB; int mode; int write_h; int to_out; int pad; };
__device__ __forceinline__ void row_pass(const RowArgs& a, int row, int lane) {
    const int mr = mod_row(row);
    const float* xsrc = (a.mode == 2 || a.xin_x == nullptr) ? a.X + (size_t)row * D : (row < MX ? a.xin_x + (size_t)row * D : a.xin_c + (size_t)(row - MX) * D);
    f32x4 x[8];
#pragma unroll
    for (int j = 0; j < 8; ++j) x[j] = *(const f32x4*)(xsrc + 4 * lane + 256 * j);
    if (a.mode != 0) {
        const float* yr = a.Y + (size_t)row * D; const float* mg = a.modA + (size_t)mr * NMOD + (a.mode == 1 ? 2 : 5) * D;
        f32x4 y[8]; float ss = 0.f;
#pragma unroll
        for (int j = 0; j < 8; ++j) { y[j] = *(const f32x4*)(yr + 4 * lane + 256 * j); ss += (y[j][0] * y[j][0] + y[j][1] * y[j][1]) + (y[j][2] * y[j][2] + y[j][3] * y[j][3]); }
        const float rstd = rsqrtf(wave_sum(ss) * (1.f / D) + EPS);
#pragma unroll
        for (int j = 0; j < 8; ++j) { const f32x4 g = *(const f32x4*)(a.gA + 4 * lane + 256 * j), mm = *(const f32x4*)(mg + 4 * lane + 256 * j); x[j] = x[j] + mm * (y[j] * rstd * g); }
        float* dst = (a.to_out && row < MX) ? a.out + (size_t)row * D : a.X + (size_t)row * D;
        if (!(a.to_out && row >= MX)) {
#pragma unroll
            for (int j = 0; j < 8; ++j) *(f32x4*)(dst + 4 * lane + 256 * j) = x[j]; }
    }
    if (a.write_h) {
        float ss = 0.f;
#pragma unroll
        for (int j = 0; j < 8; ++j) ss += (x[j][0] * x[j][0] + x[j][1] * x[j][1]) + (x[j][2] * x[j][2] + x[j][3] * x[j][3]);
        const float rstd = rsqrtf(wave_sum(ss) * (1.f / D) + EPS);
        const float* msh = (a.mode == 1 ? a.modA + (size_t)mr * NMOD + 3 * D : a.modB + (size_t)mr * NMOD);
        const float* msc = msh + D;
        bf16* hr = a.H + (size_t)row * D;
#pragma unroll
        for (int j = 0; j < 8; ++j) { const f32x4 g = *(const f32x4*)(a.gB + 4 * lane + 256 * j), sh = *(const f32x4*)(msh + 4 * lane + 256 * j), sc = *(const f32x4*)(msc + 4 * lane + 256 * j);
            const f32x4 h = (x[j] * rstd * g) * (sc + 1.0f) + sh; u32x2 w; w.x = pk2(h[0], h[1]); w.y = pk2(h[2], h[3]); *(u32x2*)(hr + 4 * lane + 256 * j) = w; }
    }
}

__device__ __forceinline__ void gmlp_unit_simple(const bf16* P, bf16* CAT, const float* ln_g, const float* ln_b, const float* ws, const float* bs, int cid, int h, LAS float* vln, int tid) {
    { const int j = tid >> 2, qd = tid & 3; const bf16* vp = P + (size_t)(cid * CH + j) * NP + C_V + h * 128 + qd * 32;
      float v[32]; float s = 0.f;
#pragma unroll
      for (int i = 0; i < 4; ++i) { const u32x4 w = *(const u32x4*)(vp + 8 * i);
#pragma unroll
          for (int e = 0; e < 4; ++e) { v[8 * i + 2 * e] = __uint_as_float(w[e] << 16); v[8 * i + 2 * e + 1] = __uint_as_float(w[e] & 0xffff0000u); } }
#pragma unroll
      for (int i = 0; i < 32; ++i) s += v[i];
      s += __shfl_xor(s, 1); s += __shfl_xor(s, 2); const float mu = s * (1.f / 128.f); float q = 0.f;
#pragma unroll
      for (int i = 0; i < 32; ++i) { v[i] -= mu; q += v[i] * v[i]; }
      q += __shfl_xor(q, 1); q += __shfl_xor(q, 2); const float rstd = rsqrtf(q * (1.f / 128.f) + EPS);
#pragma unroll
      for (int i = 0; i < 32; ++i) { const int d = qd * 32 + i; vln[j * CH + d] = v[i] * rstd * ln_g[h * 128 + d] + ln_b[h * 128 + d]; } }
    __syncthreads();
    const int d = tid & 127, ig = __builtin_amdgcn_readfirstlane(tid >> 7);
    for (int ii = 0; ii < 32; ++ii) { const int i = ig * 32 + ii; const float* wr = ws + ((size_t)h * CH + i) * CH; float acc = 0.f;
#pragma unroll 16
        for (int j = 0; j < CH; ++j) acc += wr[j] * vln[j * CH + d];
        const size_t row = (size_t)cid * CH + i; const float u = bf2f(P[row * NP + C_U + h * 128 + d]);
        CAT[row * D + h * 128 + d] = (bf16)f2bf(u * (acc + bs[h * CH + i])); }
    __syncthreads();
}


typedef short bf16x8 __attribute__((ext_vector_type(8)));
typedef short s16x4 __attribute__((ext_vector_type(4)));
typedef short v4i16_t __attribute__((ext_vector_type(4)));
constexpr int PQ = 288, PV = 544;
constexpr int L_QT = 0, L_KT = 36864, L_ST = 0, L_V = 73728, L_DF = 143360, L_TOT = 151552;
__device__ __forceinline__ s16x4 tr_read(const LAS unsigned char* p) { return __builtin_bit_cast(s16x4, __builtin_amdgcn_ds_read_tr16_b64_v4i16((LAS v4i16_t*)p)); }
__device__ __forceinline__ bf16x8 cat8(s16x4 lo, s16x4 hi) { return (bf16x8){lo[0], lo[1], lo[2], lo[3], hi[0], hi[1], hi[2], hi[3]}; }
__device__ __forceinline__ float logsig_fast(float z) { return fminf(z, 0.f) - __logf(1.0f + __expf(-fabsf(z))); }
__device__ __forceinline__ f32x4 mfma16(bf16x8 a, bf16x8 b, f32x4 c) { return __builtin_amdgcn_mfma_f32_16x16x32_bf16(a, b, c, 0, 0, 0); }

__device__ __forceinline__ void load_v_tile(const bf16* P, int cid, int h, LAS unsigned char* V, int tid) {
#pragma unroll
    for (int i = 0; i < 8; ++i) { const int idx = tid + 512 * i, row = idx >> 5, ch = idx & 31;
        const u32x4 w = *(const u32x4*)(P + (size_t)(cid * CH + row) * NP + C_VV + h * 256 + ch * 8); *(LAS u32x4*)(V + row * PV + ch * 16) = w; }
}
template <int MODE> __device__ __forceinline__ void gla_prep(const bf16* P, const float* wd2, const float* bd, float* dec_out, int cid, int h, int dir, LAS unsigned char* lds, int tid) {
    LAS float* DF = (LAS float*)(lds + L_DF); LAS float* TOT = (LAS float*)(lds + L_TOT);
    LAS bf16* QT = (LAS bf16*)(lds + L_QT); LAS bf16* KT = (LAS bf16*)(lds + L_KT);
    asm volatile("" : "+v"(tid));
    const int d = tid & 127, seg = tid >> 7;
    { const int j = tid >> 2, r0 = (tid & 3) * 4; const u32x2 w = *(const u32x2*)(P + (size_t)(cid * CH + j) * NP + (dir ? C_DB : C_DF) + r0);
      const f32x4 f = {__uint_as_float(w.x << 16), __uint_as_float(w.x & 0xffff0000u), __uint_as_float(w.y << 16), __uint_as_float(w.y & 0xffff0000u)}; *(LAS f32x4*)(DF + j * 16 + r0) = f; }
    float wd[16];
#pragma unroll
    for (int r = 0; r < 16; ++r) wd[r] = wd2[r * 512 + h * 128 + d];
    const float bdv = bd[h * 128 + d];
    __syncthreads();
    float bl[32]; float run = 0.f;
#pragma unroll
    for (int jj = 0; jj < 32; ++jj) { const int pos = 32 * seg + jj, j = dir ? 127 - pos : pos; const LAS f32x4* dfp = (const LAS f32x4*)(DF + j * 16);
        const f32x4 a = dfp[0], b = dfp[1], c = dfp[2], e = dfp[3];
        float z = bdv;
        z += a[0] * wd[0]; z += a[1] * wd[1]; z += a[2] * wd[2]; z += a[3] * wd[3]; z += b[0] * wd[4]; z += b[1] * wd[5]; z += b[2] * wd[6]; z += b[3] * wd[7];
        z += c[0] * wd[8]; z += c[1] * wd[9]; z += c[2] * wd[10]; z += c[3] * wd[11]; z += e[0] * wd[12]; z += e[1] * wd[13]; z += e[2] * wd[14]; z += e[3] * wd[15];
        run += logsig_fast(z) * (1.f / 16.f); bl[jj] = run; }
    TOT[seg * 128 + d] = run;
    __syncthreads();
    float off = 0.f, tot = 0.f;
#pragma unroll
    for (int s = 0; s < 4; ++s) { const float t = TOT[s * 128 + d]; tot += t; off += (s < seg) ? t : 0.f; }
    if (MODE == 0) { if (seg == 0) dec_out[d] = __expf(tot); }
#pragma unroll
    for (int j8 = 0; j8 < 4; ++j8) {
        float kv[8], qv[8];
#pragma unroll
        for (int t = 0; t < 8; ++t) { const int pos = 32 * seg + 8 * j8 + t, j = dir ? 127 - pos : pos; const bf16* pr = P + (size_t)(cid * CH + j) * NP + h * 128 + d;
            kv[t] = bf2f(pr[C_K]); qv[t] = (MODE == 1) ? bf2f(pr[C_Q]) : 0.f; }
#pragma unroll
        for (int t = 0; t < 8; ++t) { const int jj = 8 * j8 + t, pos = 32 * seg + jj, j = dir ? 127 - pos : pos; const float b = bl[jj] + off;
            if (MODE == 0) { KT[j * (PQ / 2) + d] = (bf16)f2bf(kv[t] * __expf(tot - b)); }
            else { QT[j * (PQ / 2) + d] = (bf16)f2bf(qv[t] * 0.08838834764831845f * __expf(b)); KT[j * (PQ / 2) + d] = (bf16)f2bf(kv[t] * __expf(-b)); } }
        asm volatile("" ::: "memory");
    }
}
__device__ __forceinline__ void gla_g1_unit(const bf16* P, const float* wd2, const float* bd, float* DS, float* DEC, int cid, int h, int dir, LAS unsigned char* lds, int tid, int lane, int wave) {
    const int unit = (cid * 4 + h) * 2 + dir;
    asm volatile("" : "+v"(tid));
    load_v_tile(P, cid, h, lds + L_V, tid);
    gla_prep<0>(P, wd2, bd, DEC + (size_t)unit * 128, cid, h, dir, lds, tid);
    __syncthreads();
    int t2 = tid; asm volatile("" : "+v"(t2)); (void)lane;
    const int wdb = wave >> 1, we = wave & 1, g = (t2 >> 4) & 3, li = t2 & 15, q = li >> 2, p = li & 3;
    f32x4 acc[2][8];
#pragma unroll
    for (int dt = 0; dt < 2; ++dt)
#pragma unroll
        for (int et = 0; et < 8; ++et) acc[dt][et] = (f32x4){0.f, 0.f, 0.f, 0.f};
    const LAS unsigned char* KT = lds + L_KT; const LAS unsigned char* V = lds + L_V;
#pragma unroll
    for (int ks = 0; ks < 4; ++ks) { const int row = 32 * ks + 8 * g + q;
        bf16x8 X[2];
#pragma unroll
        for (int dt = 0; dt < 2; ++dt) X[dt] = cat8(tr_read(KT + row * PQ + (32 * wdb + 16 * dt + 4 * p) * 2), tr_read(KT + (row + 4) * PQ + (32 * wdb + 16 * dt + 4 * p) * 2));
#pragma unroll
        for (int et = 0; et < 8; ++et) { const bf16x8 Y = cat8(tr_read(V + row * PV + (128 * we + 16 * et + 4 * p) * 2), tr_read(V + (row + 4) * PV + (128 * we + 16 * et + 4 * p) * 2));
            acc[0][et] = mfma16(X[0], Y, acc[0][et]); acc[1][et] = mfma16(X[1], Y, acc[1][et]); } }
#pragma unroll
    for (int dt = 0; dt < 2; ++dt)
#pragma unroll
        for (int et = 0; et < 8; ++et) { const int e = 128 * we + 16 * et + li, d0 = 32 * wdb + 16 * dt + 4 * g; *(f32x4*)(DS + ((size_t)unit * 256 + e) * 128 + d0) = acc[dt][et]; }
    __syncthreads();
}
__device__ __forceinline__ int gla_chain_cid(int s, int b, int dir) { return dir ? (s < 2 ? 128 + 2 * b + (1 - s) : 32 * b + 31 - (s - 2)) : (s < 2 ? 128 + 2 * b + s : 32 * b + (s - 2)); }
__device__ __forceinline__ void gla_g2_item(const float* DS, const float* DEC, bf16* SP, int item) {
    const int chain = item >> 13, ed = item & 8191, b = chain >> 3, h = (chain >> 1) & 3, dir = chain & 1, e = ed >> 5, d0 = (ed & 31) * 4;
    f32x4 S = {0.f, 0.f, 0.f, 0.f};
#pragma unroll 2
    for (int s = 0; s < 34; ++s) { const int cid = gla_chain_cid(s, b, dir), unit = (cid * 4 + h) * 2 + dir; const size_t off = ((size_t)unit * 256 + e) * 128 + d0;
        const f32x4 dec = *(const f32x4*)(DEC + (size_t)unit * 128 + d0), ds = *(const f32x4*)(DS + off);
        u32x2 w; w.x = pk2(S[0], S[1]); w.y = pk2(S[2], S[3]); *(u32x2*)(SP + off) = w;
        S = dec * S + ds; }
}
__device__ __forceinline__ void gla_g3_unit(const bf16* P, const float* wd2f, const float* bdf, const float* wd2b, const float* bdb, const bf16* SP, const float* out_g, bf16* CAT,
                                            int cid, int h, LAS unsigned char* lds, int tid, int lane, int wave) {
    asm volatile("" : "+v"(tid));
    load_v_tile(P, cid, h, lds + L_V, tid);
    const int w = wave; (void)lane;
    const LAS unsigned char* QT = lds + L_QT; const LAS unsigned char* KT = lds + L_KT; LAS unsigned char* ST = lds + L_ST; const LAS unsigned char* V = lds + L_V;
    f32x4 o[16];
#pragma unroll
    for (int et = 0; et < 16; ++et) o[et] = (f32x4){0.f, 0.f, 0.f, 0.f};
#pragma unroll
    for (int dir = 0; dir < 2; ++dir) {
        const int unit = (cid * 4 + h) * 2 + dir;
        gla_prep<1>(P, dir ? wd2b : wd2f, dir ? bdb : bdf, nullptr, cid, h, dir, lds, tid);
        __syncthreads();
        int t2 = tid; asm volatile("" : "+v"(t2));
        const int g = (t2 >> 4) & 3, li = t2 & 15, q = li >> 2, p = li & 3;
        u32x4 sp[8];
#pragma unroll
        for (int i = 0; i < 8; ++i) sp[i] = *(const u32x4*)(SP + (size_t)unit * 32768 + (size_t)(tid + 512 * i) * 8);
        bf16x8 Yq[4];
#pragma unroll
        for (int ks = 0; ks < 4; ++ks) Yq[ks] = *(const LAS bf16x8*)(QT + (16 * w + li) * PQ + (32 * ks + 8 * g) * 2);
        bf16x8 Pf[4];
#pragma unroll
        for (int kp = 0; kp < 4; ++kp) {
            f32x4 s0 = {0.f, 0.f, 0.f, 0.f}, s1 = {0.f, 0.f, 0.f, 0.f};
            const int t0 = 2 * kp, t1 = 2 * kp + 1;
            const bool a0 = dir ? (t0 >= w) : (t0 <= w), a1 = dir ? (t1 >= w) : (t1 <= w);
            if (a0) {
#pragma unroll
                for (int ks = 0; ks < 4; ++ks) s0 = mfma16(*(const LAS bf16x8*)(KT + (16 * t0 + li) * PQ + (32 * ks + 8 * g) * 2), Yq[ks], s0); }
            if (a1) {
#pragma unroll
                for (int ks = 0; ks < 4; ++ks) s1 = mfma16(*(const LAS bf16x8*)(KT + (16 * t1 + li) * PQ + (32 * ks + 8 * g) * 2), Yq[ks], s1); }
            if (t0 == w) {
#pragma unroll
                for (int r = 0; r < 4; ++r) { const bool keep = dir ? (4 * g + r >= li) : (4 * g + r <= li); s0[r] = keep ? s0[r] : 0.f; } }
            if (t1 == w) {
#pragma unroll
                for (int r = 0; r < 4; ++r) { const bool keep = dir ? (4 * g + r >= li) : (4 * g + r <= li); s1[r] = keep ? s1[r] : 0.f; } }
            u32x4 pw; pw.x = pg8::cvt_pk_bf16(s0[0], s0[1]); pw.y = pg8::cvt_pk_bf16(s0[2], s0[3]); pw.z = pg8::cvt_pk_bf16(s1[0], s1[1]); pw.w = pg8::cvt_pk_bf16(s1[2], s1[3]);
            Pf[kp] = __builtin_bit_cast(bf16x8, pw);
        }
#pragma unroll
        for (int kp = 0; kp < 4; ++kp) {
            const bool act = dir ? (2 * kp + 1 >= w) : (2 * kp <= w);
            if (act) {
#pragma unroll
                for (int et = 0; et < 16; ++et) { const bf16x8 Xv = cat8(tr_read(V + (32 * kp + 4 * g + q) * PV + (16 * et + 4 * p) * 2), tr_read(V + (32 * kp + 16 + 4 * g + q) * PV + (16 * et + 4 * p) * 2));
                    o[et] = mfma16(Xv, Pf[kp], o[et]); } }
        }
        __syncthreads();
#pragma unroll
        for (int i = 0; i < 8; ++i) { const int idx = tid + 512 * i; *(LAS u32x4*)(ST + (idx >> 4) * PQ + (idx & 15) * 16) = sp[i]; }
        __syncthreads();
#pragma unroll
        for (int et = 0; et < 16; ++et)
#pragma unroll
            for (int ks = 0; ks < 4; ++ks) o[et] = mfma16(*(const LAS bf16x8*)(ST + (16 * et + li) * PQ + (32 * ks + 8 * g) * 2), Yq[ks], o[et]);
        __syncthreads();
    }
    int t3 = tid; asm volatile("" : "+v"(t3));
    const int g = (t3 >> 4) & 3, li = t3 & 15;
    float ss = 0.f;
#pragma unroll
    for (int et = 0; et < 16; ++et) ss += (o[et][0] * o[et][0] + o[et][1] * o[et][1]) + (o[et][2] * o[et][2] + o[et][3] * o[et][3]);
    ss += __shfl_xor(ss, 16); ss += __shfl_xor(ss, 32);
    const float rstd = rsqrtf(ss * (1.f / 256.f) + EPS);
    const size_t row = (size_t)cid * CH + 16 * w + li;
#pragma unroll
    for (int et = 0; et < 16; ++et) { const int e0 = h * 256 + 16 * et + 4 * g; const f32x4 gg = *(const f32x4*)(out_g + e0); const u32x2 gw = *(const u32x2*)(P + row * NP + C_G + e0);
        const float g0 = __uint_as_float(gw.x << 16), g1 = __uint_as_float(gw.x & 0xffff0000u), g2 = __uint_as_float(gw.y << 16), g3 = __uint_as_float(gw.y & 0xffff0000u);
        u32x2 ow; ow.x = pk2(o[et][0] * rstd * gg[0] * silu_acc(g0), o[et][1] * rstd * gg[1] * silu_acc(g1)); ow.y = pk2(o[et][2] * rstd * gg[2] * silu_acc(g2), o[et][3] * rstd * gg[3] * silu_acc(g3));
        *(u32x2*)(CAT + row * D + 1024 + e0) = ow; }
}

constexpr int NPH = 2 + 9 * NL;
struct Args { const float* in[23]; float* out; unsigned char* ws; int ph_lo, ph_hi, li, pad; };

#define IN(k) (lo <= (k) && (k) < hi)
#define PHASE_IDS() int tid = tid0; asm volatile("" : "+v"(tid)); const int lane = tid & 63, wave = __builtin_amdgcn_readfirstlane(tid >> 6), gw = bid * 8 + wave, ngw = G * 8; (void)lane; (void)gw; (void)ngw
#define SEAM(k) do { if (IN(k) && IN((k) + 1)) xcd_barrier(bar); } while (0)
template <int l> __device__ __forceinline__ void run_layer(const Args& a, LAS unsigned char* lds, const XcdBarrier& bar, int tid0, int G, int bid, int lo, int hi) {
    unsigned char* ws = a.ws;
    const float* x = a.in[0]; const float* ctx = a.in[2];
    const float* g_pre_mix = a.in[6]; const float* g_post_mix = a.in[7]; const float* g_pre_ffn = a.in[8]; const float* g_post_ffn = a.in[9];
    const float* ln_g = a.in[11]; const float* ln_b = a.in[12]; const float* gws = a.in[13]; const float* gbs = a.in[14];
    const float* wd2f = a.in[15]; const float* bdf = a.in[16]; const float* wd2b = a.in[17]; const float* bdb = a.in[18];
    const float* out_g = a.in[19];
    float* MOD = (float*)(ws + WS_MOD); bf16* WIN = (bf16*)(ws + WS_WIN); bf16* WOUT = (bf16*)(ws + WS_WOUT); bf16* WFI = (bf16*)(ws + WS_WFI); bf16* WFO = (bf16*)(ws + WS_WFO);
    float* X = (float*)(ws + WS_X); bf16* H = (bf16*)(ws + WS_H); bf16* P = (bf16*)(ws + WS_P); bf16* CAT = (bf16*)(ws + WS_CAT); float* Y = (float*)(ws + WS_Y); bf16* HID = (bf16*)(ws + WS_HID);
    float* DS = (float*)(ws + WS_DS); bf16* SP = (bf16*)(ws + WS_SP); float* DEC = (float*)(ws + WS_DEC);
        const int pb = 2 + 9 * l;
        const float* modl = MOD + (size_t)l * 5 * NMOD;
        if (IN(pb + 0)) { pg8::Gemm g{H, WIN + (size_t)l * NP * D, M, NP, D}; pg8::StaticOrder S; S.init(M, NP, G, bid); pg8::EpiProj E{P, NP, 8};
            pg8::gemm_phase<pg8::EpiProj, pg8::StaticOrder, true, true>(lds, g, S, E); }
        SEAM(pb + 0);
        if (IN(pb + 1)) { PHASE_IDS();
            for (int u = bid; u < NCHUNK * 8; u += G)
                gmlp_unit_simple(P, CAT, ln_g + l * 1024, ln_b + l * 1024, gws + (size_t)l * 8 * CH * CH, gbs + l * 8 * CH, u >> 3, u & 7, (LAS float*)lds, tid);
            for (int u = bid; u < NCHUNK * 8; u += G) { const int dir = u & 1, h = (u >> 1) & 3, cid = u >> 3;
                gla_g1_unit(P, (dir ? wd2b : wd2f) + l * 16 * 512, (dir ? bdb : bdf) + l * 512, DS, DEC, cid, h, dir, lds, tid, lane, wave); }
        }
        SEAM(pb + 1);
        if (IN(pb + 2)) { PHASE_IDS();
            for (int it = bid * 512 + tid; it < 32 * 8192; it += G * 512) gla_g2_item(DS, DEC, SP, it);
        }
        SEAM(pb + 2);
        if (IN(pb + 3)) { PHASE_IDS();
            for (int u = bid; u < NCHUNK * 4; u += G)
                gla_g3_unit(P, wd2f + l * 16 * 512, bdf + l * 512, wd2b + l * 16 * 512, bdb + l * 512, SP, out_g + l * 1024, CAT, u >> 2, u & 3, lds, tid, lane, wave);
        }
        SEAM(pb + 3);
        if (IN(pb + 4)) { pg8::Gemm g{CAT, WOUT + (size_t)l * D * D, M, D, D}; pg8::StaticOrder S; S.init(M, D, G, bid); pg8::EpiF32 E{Y, D};
            pg8::gemm_phase<pg8::EpiF32, pg8::StaticOrder, true, true>(lds, g, S, E); }
        SEAM(pb + 4);
        if (IN(pb + 5)) { PHASE_IDS();
            RowArgs r{}; r.xin_x = l == 0 ? x : nullptr; r.xin_c = l == 0 ? ctx : nullptr; r.Y = Y; r.X = X; r.H = H; r.modA = modl; r.gA = g_post_mix + l * D; r.gB = g_pre_ffn + l * D; r.mode = 1; r.write_h = 1;
            for (int row = gw; row < M; row += ngw) row_pass(r, row, lane);
        }
        SEAM(pb + 5);
        if (IN(pb + 6)) { pg8::Gemm g{H, WFI + (size_t)l * 2 * FF * D, M, 2 * FF, D}; pg8::StaticOrder S; S.init(M, 2 * FF, G, bid); pg8::EpiSwiglu E{HID, FF};
            pg8::gemm_phase<pg8::EpiSwiglu, pg8::StaticOrder, true, true>(lds, g, S, E); }
        SEAM(pb + 6);
        if (IN(pb + 7)) { pg8::Gemm g{HID, WFO + (size_t)l * D * FF, M, D, FF}; pg8::StaticOrder S; S.init(M, D, G, bid); pg8::EpiF32 E{Y, D};
            pg8::gemm_phase<pg8::EpiF32, pg8::StaticOrder, true, true>(lds, g, S, E); }
        SEAM(pb + 7);
        if (IN(pb + 8)) { PHASE_IDS();
            RowArgs r{}; r.Y = Y; r.X = X; r.out = a.out; r.H = H; r.modA = modl; r.modB = modl + 5 * NMOD; r.gA = g_post_ffn + l * D; r.gB = g_pre_mix + (l + 1 < NL ? l + 1 : l) * D; r.mode = 2; r.write_h = (l + 1 < NL); r.to_out = (l + 1 == NL);
            for (int row = gw; row < M; row += ngw) row_pass(r, row, lane);
        }
        SEAM(pb + 8);
}
__global__ void __launch_bounds__(512, 2) mega(Args a) {
    extern __shared__ __attribute__((aligned(16))) unsigned char lds_raw[];
    LAS unsigned char* lds = (LAS unsigned char*)lds_raw;
    const int tid0 = threadIdx.x;
    const int G = gridDim.x, bid = blockIdx.x;
    volatile LAS unsigned* MISC = (volatile LAS unsigned*)(lds + MISC_OFF);
    if (tid0 < 32) MISC[tid0] = 0u;
    __syncthreads();
    unsigned char* ws = a.ws;
    const int lo = a.ph_lo, hi = a.ph_hi;
    XcdBarrier bar; bar.bar = (unsigned*)(ws + WS_CTL) + CW_BAR + a.li * XCD_BAR_WORDS; bar.x = 0; bar.st = nullptr;
    if (hi - lo > 1) bar = xcd_barrier_post((unsigned*)(ws + WS_CTL) + CW_BAR + a.li * XCD_BAR_WORDS, MISC + 8);
    const float* x = a.in[0]; const float* c = a.in[1]; const float* ctx = a.in[2]; const float* cctx = a.in[3];
    const float* w_mod = a.in[4]; const float* b_mod = a.in[5];
    const float* g_pre_mix = a.in[6]; const float* g_post_mix = a.in[7]; const float* g_pre_ffn = a.in[8]; const float* g_post_ffn = a.in[9];
    const float* w_in = a.in[10]; const float* ln_g = a.in[11]; const float* ln_b = a.in[12]; const float* gws = a.in[13]; const float* gbs = a.in[14];
    const float* wd2f = a.in[15]; const float* bdf = a.in[16]; const float* wd2b = a.in[17]; const float* bdb = a.in[18];
    const float* out_g = a.in[19]; const float* w_out = a.in[20]; const float* w_fi = a.in[21]; const float* w_fo = a.in[22];
    float* MOD = (float*)(ws + WS_MOD); bf16* WIN = (bf16*)(ws + WS_WIN); bf16* WOUT = (bf16*)(ws + WS_WOUT); bf16* WFI = (bf16*)(ws + WS_WFI); bf16* WFO = (bf16*)(ws + WS_WFO);
    float* X = (float*)(ws + WS_X); bf16* H = (bf16*)(ws + WS_H); bf16* P = (bf16*)(ws + WS_P); bf16* CAT = (bf16*)(ws + WS_CAT); float* Y = (float*)(ws + WS_Y); bf16* HID = (bf16*)(ws + WS_HID);
    float* DS = (float*)(ws + WS_DS); bf16* SP = (bf16*)(ws + WS_SP); float* DEC = (float*)(ws + WS_DEC);

    if (IN(0)) { PHASE_IDS();
        LAS float* act = (LAS float*)(lds + 8 * 8448);
        for (int i = tid; i < 5 * D; i += 512) { const int r = i / D, k = i % D; const float v = r < NB ? c[r * D + k] : cctx[k]; act[i] = silu_acc(v); }
        __syncthreads();
        for (int item = wave * G + bid; item < NL * (NMOD / 32); item += ngw) {
            const int cg = item % (NMOD / 32), l = item / (NMOD / 32), kq = lane >> 3;
            const int j = cg * 32 + 4 * (lane & 7);
            const float* w = w_mod + ((size_t)l * D + kq) * NMOD + j;
            f32x4 a0 = {0.f, 0.f, 0.f, 0.f}, a1 = a0, a2 = a0, a3 = a0, a4 = a0;
#pragma unroll 8
            for (int i = 0; i < D / 8; ++i) { const f32x4 xv = *(const f32x4*)(w + (size_t)(8 * i) * NMOD); const int k = 8 * i + kq;
                a0 += xv * act[0 * D + k]; a1 += xv * act[1 * D + k]; a2 += xv * act[2 * D + k]; a3 += xv * act[3 * D + k]; a4 += xv * act[4 * D + k]; }
#pragma unroll
            for (int t = 0; t < 4; ++t) {
#pragma unroll
                for (int o = 8; o < 64; o <<= 1) { a0[t] += __shfl_xor(a0[t], o); a1[t] += __shfl_xor(a1[t], o); a2[t] += __shfl_xor(a2[t], o); a3[t] += __shfl_xor(a3[t], o); a4[t] += __shfl_xor(a4[t], o); } }
            if (kq == 0) { const f32x4 bb = *(const f32x4*)(b_mod + (size_t)l * NMOD + j); float* o = MOD + (size_t)l * 5 * NMOD + j;
                *(f32x4*)(o) = a0 + bb; *(f32x4*)(o + NMOD) = a1 + bb; *(f32x4*)(o + 2 * NMOD) = a2 + bb; *(f32x4*)(o + 3 * NMOD) = a3 + bb; *(f32x4*)(o + 4 * NMOD) = a4 + bb; }
        }
        LAS float* scr = (LAS float*)(lds + wave * 8448);
        int it0 = 0;
        conv_matrix(w_in, WIN, D, PIN, NP, 1, it0, gw, ngw, scr, lane);
        conv_matrix(w_out, WOUT, D, D, D, 0, it0, gw, ngw, scr, lane);
        conv_matrix(w_fi, WFI, D, 2 * FF, 2 * FF, 2, it0, gw, ngw, scr, lane);
        conv_matrix(w_fo, WFO, FF, D, D, 0, it0, gw, ngw, scr, lane);
    }
    SEAM(0);
    if (IN(1)) { PHASE_IDS();
        RowArgs r{}; r.xin_x = x; r.xin_c = ctx; r.X = X; r.H = H; r.modB = MOD; r.gB = g_pre_mix; r.mode = 0; r.write_h = 1;
        for (int row = gw; row < M; row += ngw) row_pass(r, row, lane);
    }
    SEAM(1);
    run_layer<0>(a, lds, bar, tid0, G, bid, lo, hi);
    run_layer<1>(a, lds, bar, tid0, G, bid, lo, hi);
    run_layer<2>(a, lds, bar, tid0, G, bid, lo, hi);
    run_layer<3>(a, lds, bar, tid0, G, bid, lo, hi);
#undef IN
#undef SEAM
}

#ifndef MK_SPLIT
#define MK_SPLIT 0
#endif
extern "C" void kernel_launch(void* const* d_in, const int* in_sizes, int n_in, void* d_out, int out_size, void* d_ws, size_t ws_size, hipStream_t stream) {
    static int grid = 0;
    if (grid == 0) {
        if (n_in != 23 || ws_size < WS_END || out_size != MX * D) { fprintf(stderr, "kernel_launch: unexpected shapes (n_in %d, ws %zu, out %d)\n", n_in, ws_size, out_size); grid = -1; return; }
        int dev = 0, cus = 0, per_cu = 0;
        if (hipGetDevice(&dev) != hipSuccess || hipDeviceGetAttribute(&cus, hipDeviceAttributeMultiprocessorCount, dev) != hipSuccess) { grid = -1; return; }
        if (hipFuncSetAttribute((const void*)mega, hipFuncAttributeMaxDynamicSharedMemorySize, LDS_BYTES) != hipSuccess) { fprintf(stderr, "kernel_launch: hipFuncSetAttribute failed\n"); grid = -1; return; }
        if (hipOccupancyMaxActiveBlocksPerMultiprocessor(&per_cu, (const void*)mega, 512, LDS_BYTES) != hipSuccess || per_cu < 1) { fprintf(stderr, "kernel_launch: occupancy query says %d\n", per_cu); }
        (void)hipGetLastError();
        grid = cus;
    }
    if (grid < 0) return;
    (void)hipMemsetAsync((char*)d_ws + WS_CTL, 0, ZERO_BYTES, stream);
    Args a{};
    for (int i = 0; i < 23; ++i) a.in[i] = (const float*)d_in[i];
    a.out = (float*)d_out; a.ws = (unsigned char*)d_ws;
#if MK_SPLIT
    for (int p = 0; p < NPH; ++p) { a.ph_lo = p; a.ph_hi = p + 1; a.li = 0; hipLaunchKernelGGL(mega, dim3(grid), dim3(512), LDS_BYTES, stream, a); }
#else
    a.ph_lo = 0; a.ph_hi = NPH; a.li = 0;
    hipLaunchKernelGGL(mega, dim3(grid), dim3(512), LDS_BYTES, stream, a);
#endif
}
```

```cpp
#include <hip/hip_runtime.h>
#include <cstdio>
#include <cstdint>
namespace pg8 {
#define PG8_LAS __attribute__((address_space(3)))
typedef unsigned short bf16_t;
typedef short bf16x8 __attribute__((ext_vector_type(8)));
typedef float f32x4 __attribute__((ext_vector_type(4)));
typedef unsigned u32x4 __attribute__((ext_vector_type(4)));
constexpr int BM = 256, BK = 64, HALF = 128, HTB = HALF * BK * 2  , STAGE_BYTES = 8 * HTB, NXCD = 8, WGM = 8;

__host__ __device__ __forceinline__ int lds_byte(int r, int c) { const int st = (r >> 4) * 2 + (c >> 5), rr = r & 15, cc = c & 31, ob = rr * 64 + cc * 2; return st * 1024 + (ob ^ (((ob >> 9) & 1) << 5)); }
__host__ __device__ __forceinline__ void stage_rc(int b, int& R, int& C) { const int st = b / 1024, sb = b % 1024, swz = sb ^ (((sb >> 9) & 1) << 5); R = (st >> 1) * 16 + swz / 64; C = (st & 1) * 32 + (swz % 64) / 2; }
__host__ __device__ __forceinline__ int perm32(int rho) { const int n = rho >> 4, i = rho & 15; return 8 * (i >> 2) + 4 * n + (i & 3); }

struct Unit { int pm, pn; };
struct Gemm { const bf16_t* A; const bf16_t* Bt; int M, N, K, pad; };

struct StaticOrder {
    int nM, nN, nwg, G, c;
    __host__ __device__ void init(int M, int N, int G_, int c_) { nM = M / BM; nN = N / BM; nwg = nM * nN; G = G_; c = c_; }
    __host__ __device__ bool next(int i, Unit& u) const {
        const long L = (long)i * G + c; if (L >= nwg) return false;
        int wgid = (int)L; { const int q = nwg / NXCD, r = nwg % NXCD, xcd = wgid % NXCD, off = wgid / NXCD; wgid = (xcd < r ? xcd * (q + 1) : r * (q + 1) + (xcd - r) * q) + off; }
        const int nig = WGM * nN, gid = wgid / nig, fm = gid * WGM, gsz = (nM - fm) < WGM ? (nM - fm) : WGM;
        u.pm = fm + ((wgid % nig) % gsz); u.pn = (wgid % nig) / gsz; return true;
    }
    __device__ __forceinline__ void a_ready(const Unit&) const {}
    __device__ __forceinline__ void done(const Unit&) const {}
};


__device__ __forceinline__ unsigned cvt_pk_bf16(float lo, float hi) { unsigned r; asm volatile("v_cvt_pk_bf16_f32 %0, %1, %2" : "=v"(r) : "v"(lo), "v"(hi)); return r; }
__device__ __forceinline__ float fast_sigmoid(float x) { return __builtin_amdgcn_rcpf(1.0f + __builtin_amdgcn_exp2f(-1.4426950408889634f * x)); }
__device__ __forceinline__ float gelu_tanh(float x) { const float y = 1.5957691216057308f * (x + 0.044715f * x * x * x); return x * fast_sigmoid(y); }
__device__ __forceinline__ float silu_f(float x) { return x * fast_sigmoid(x); }

struct EpiF32 {
    static constexpr bool PERM = false, AFTER_DRAIN = false;
    float* C; int ldc; int pad;
    __device__ __forceinline__ void operator()(const f32x4 (&acc)[2][2][4][2], const Unit& u, int wr, int wc, int fr, int fq) const {
        const int row0 = u.pm * BM + wr * 64 + fr, col0 = u.pn * BM + wc * 32 + 4 * fq;
#pragma unroll
        for (int ai = 0; ai < 2; ++ai)
#pragma unroll
            for (int m = 0; m < 4; ++m) { float* rowp = C + (size_t)(row0 + ai * HALF + m * 16) * ldc + col0;
#pragma unroll
                for (int bj = 0; bj < 2; ++bj)
#pragma unroll
                    for (int n = 0; n < 2; ++n) *(f32x4*)(rowp + bj * HALF + n * 16) = acc[ai][bj][m][n]; }
    }
};
struct EpiProj {
    static constexpr bool PERM = true, AFTER_DRAIN = false;
    bf16_t* O; int ldc; int ngelu;
    __device__ __forceinline__ void operator()(const f32x4 (&acc)[2][2][4][2], const Unit& u, int wr, int wc, int fr, int fq) const {
        const int row0 = u.pm * BM + wr * 64 + fr, col0 = u.pn * BM + wc * 32 + 8 * fq;
        const bool act = u.pn < ngelu;
#pragma unroll
        for (int ai = 0; ai < 2; ++ai)
#pragma unroll
            for (int m = 0; m < 4; ++m) { bf16_t* rowp = O + (size_t)(row0 + ai * HALF + m * 16) * ldc + col0;
#pragma unroll
                for (int bj = 0; bj < 2; ++bj) { f32x4 v0 = acc[ai][bj][m][0], v1 = acc[ai][bj][m][1];
                    if (act) {
#pragma unroll
                        for (int j = 0; j < 4; ++j) { v0[j] = gelu_tanh(v0[j]); v1[j] = gelu_tanh(v1[j]); } }
                    u32x4 w; w.x = cvt_pk_bf16(v0[0], v0[1]); w.y = cvt_pk_bf16(v0[2], v0[3]); w.z = cvt_pk_bf16(v1[0], v1[1]); w.w = cvt_pk_bf16(v1[2], v1[3]);
                    *(u32x4*)(rowp + bj * HALF) = w; } }
    }
};
struct EpiSwiglu {
    static constexpr bool PERM = true, AFTER_DRAIN = false;
    bf16_t* O; int ldc; int pad;
    __device__ __forceinline__ void operator()(const f32x4 (&acc)[2][2][4][2], const Unit& u, int wr, int wc, int fr, int fq) const {
        const int row0 = u.pm * BM + wr * 64 + fr, col0 = u.pn * HALF + wc * 32 + 8 * fq;
#pragma unroll
        for (int ai = 0; ai < 2; ++ai)
#pragma unroll
            for (int m = 0; m < 4; ++m) { bf16_t* rowp = O + (size_t)(row0 + ai * HALF + m * 16) * ldc + col0;
                f32x4 h0, h1;
#pragma unroll
                for (int j = 0; j < 4; ++j) { h0[j] = silu_f(acc[ai][0][m][0][j]) * acc[ai][1][m][0][j]; h1[j] = silu_f(acc[ai][0][m][1][j]) * acc[ai][1][m][1][j]; }
                u32x4 w; w.x = cvt_pk_bf16(h0[0], h0[1]); w.y = cvt_pk_bf16(h0[2], h0[3]); w.z = cvt_pk_bf16(h1[0], h1[1]); w.w = cvt_pk_bf16(h1[2], h1[3]);
                *(u32x4*)rowp = w; }
    }
};

template <class Epi, class Sched, bool ALIGN_EPI = false, bool SP2 = false>
__device__ __forceinline__ void gemm_phase(PG8_LAS unsigned char* lds, const Gemm g, const Sched& S, const Epi& E) {
    int tid_o = threadIdx.x; asm volatile("" : "+v"(tid_o));
    const int tid = tid_o, wid = __builtin_amdgcn_readfirstlane(tid >> 6), lane = tid & 63, wr = wid >> 2, wc = wid & 3, fr = lane & 15, fq = lane >> 4;
    const int K = g.K, nt = K / BK;
    unsigned voffA[2], voffB[2];
#pragma unroll
    for (int i = 0; i < 2; ++i) { int R, C; stage_rc(tid * 16 + i * 8192, R, C); const int Rb = Epi::PERM ? ((R & ~31) + perm32(R & 31)) : R;
        voffA[i] = (unsigned)(R * K + C) * 2u; voffB[i] = (unsigned)(Rb * K + C) * 2u; }
    const size_t kstep = (size_t)(BK * 2);
    const size_t hstep = (size_t)HALF * K * 2;
    const size_t tstep = 2 * hstep;
    const unsigned ldsw = (unsigned)wid * 1024u;
    const int aoff = lds_byte(wr * 64 + fr, fq * 8), boff = lds_byte(wc * 32 + fr, fq * 8);
#define PG8_SA(b, h) (((b) * 2 + (h)) * HTB)
#define PG8_SB(b, h) ((4 + (b) * 2 + (h)) * HTB)
#define PG8_STAGE(bufoff, gbase, voff) do { _Pragma("unroll") for (int _i = 0; _i < 2; ++_i) \
        __builtin_amdgcn_global_load_lds((const unsigned*)((const char*)(gbase) + (voff)[_i]), (PG8_LAS unsigned*)(lds + (bufoff) + ldsw + _i * 8192), 16, 0, 0); } while (0)
#define PG8_LDA(dst, b, h) do { _Pragma("unroll") for (int m = 0; m < 4; ++m) _Pragma("unroll") for (int k = 0; k < 2; ++k) dst[m][k] = *(const PG8_LAS bf16x8*)(lds + PG8_SA(b, h) + aoff + m * 2048 + k * 1024); } while (0)
#define PG8_LDB(dst, b, h) do { _Pragma("unroll") for (int n = 0; n < 2; ++n) _Pragma("unroll") for (int k = 0; k < 2; ++k) dst[n][k] = *(const PG8_LAS bf16x8*)(lds + PG8_SB(b, h) + boff + n * 2048 + k * 1024); } while (0)
#define PG8_MMA(ai, bj, At, Bt) do { __builtin_amdgcn_s_setprio(1); _Pragma("unroll") for (int m = 0; m < 4; ++m) _Pragma("unroll") for (int n = 0; n < 2; ++n) _Pragma("unroll") for (int k = 0; k < 2; ++k) \
        acc[ai][bj][m][n] = __builtin_amdgcn_mfma_f32_16x16x32_bf16(Bt[n][k], At[m][k], acc[ai][bj][m][n], 0, 0, 0); __builtin_amdgcn_s_setprio(0); } while (0)
#define PG8_WAIT_V(n) asm volatile("s_waitcnt vmcnt(" #n ")" ::: "memory")
#define PG8_WAIT_L(n) asm volatile("s_waitcnt lgkmcnt(" #n ")" ::: "memory")
#define PG8_BAR __builtin_amdgcn_s_barrier()
#define PG8_SCHED __builtin_amdgcn_sched_barrier(0)
    Unit cur, nxt; int ui = 0;
    if (!S.next(0, cur)) return;
    f32x4 acc[2][2][4][2];
#pragma unroll
    for (int a = 0; a < 2; ++a)
#pragma unroll
        for (int b = 0; b < 2; ++b)
#pragma unroll
            for (int m = 0; m < 4; ++m)
#pragma unroll
                for (int n = 0; n < 2; ++n) acc[a][b][m][n] = (f32x4){0.f, 0.f, 0.f, 0.f};
    bf16x8 At[4][2], B0[2][2], B1[2][2];
    const char* cA = (const char*)g.A + (size_t)cur.pm * tstep; const char* cB = (const char*)g.Bt + (size_t)cur.pn * tstep;
    S.a_ready(cur);
    if constexpr (SP2) {
        PG8_STAGE(PG8_SB(0, 0), cB, voffB); PG8_STAGE(PG8_SB(0, 1), cB + hstep, voffB); PG8_STAGE(PG8_SA(0, 0), cA, voffA); PG8_STAGE(PG8_SA(0, 1), cA + hstep, voffA);
        if (wr == 1) PG8_BAR;
        PG8_WAIT_V(2); PG8_BAR;
        PG8_STAGE(PG8_SB(1, 0), cB + kstep, voffB); PG8_STAGE(PG8_SA(1, 0), cA + kstep, voffA); PG8_STAGE(PG8_SB(1, 1), cB + hstep + kstep, voffB);
        PG8_WAIT_V(6); PG8_BAR;
    } else {
        PG8_STAGE(PG8_SB(0, 0), cB, voffB); PG8_STAGE(PG8_SA(0, 0), cA, voffA); PG8_STAGE(PG8_SB(0, 1), cB + hstep, voffB); PG8_STAGE(PG8_SA(0, 1), cA + hstep, voffA);
        if (wr == 1) PG8_BAR;
        PG8_WAIT_V(4); PG8_BAR;
        PG8_STAGE(PG8_SB(1, 0), cB + kstep, voffB); PG8_STAGE(PG8_SA(1, 0), cA + kstep, voffA); PG8_STAGE(PG8_SB(1, 1), cB + hstep + kstep, voffB);
        PG8_WAIT_V(6); PG8_BAR;
    }
    for (;;) {
        const bool has_next = S.next(ui + 1, nxt);
        const char* nA = has_next ? (const char*)g.A + (size_t)nxt.pm * tstep : cA; const char* nB = has_next ? (const char*)g.Bt + (size_t)nxt.pn * tstep : cB;
        for (int t = 0; t < nt; t += 2) {
            const bool last = (t == nt - 2);
            const char* a1 = cA + (size_t)(t + 1) * kstep;
            const char* a2 = last ? nA : cA + (size_t)(t + 2) * kstep; const char* b2 = last ? nB : cB + (size_t)(t + 2) * kstep;
            const char* a3 = a2 + kstep; const char* b3 = b2 + kstep;
            if (last && has_next) S.a_ready(nxt);
            if constexpr (SP2) {
            PG8_LDB(B0, 0, 0); PG8_LDB(B1, 0, 1); PG8_SCHED; PG8_LDA(At, 0, 0); PG8_STAGE(PG8_SA(1, 1), a1 + hstep, voffA);
            PG8_WAIT_V(8); PG8_WAIT_L(0); PG8_BAR; PG8_MMA(0, 0, At, B0); PG8_MMA(0, 1, At, B1); PG8_BAR; PG8_SCHED;
            PG8_LDA(At, 0, 1); PG8_STAGE(PG8_SB(0, 0), b2, voffB); PG8_STAGE(PG8_SB(0, 1), b2 + hstep, voffB); PG8_STAGE(PG8_SA(0, 0), a2, voffA);
            PG8_WAIT_V(8); PG8_WAIT_L(0); PG8_BAR; PG8_MMA(1, 0, At, B0); PG8_MMA(1, 1, At, B1); PG8_BAR; PG8_SCHED;
            PG8_LDB(B0, 1, 0); PG8_LDB(B1, 1, 1); PG8_SCHED; PG8_LDA(At, 1, 0); PG8_STAGE(PG8_SA(0, 1), a2 + hstep, voffA);
            PG8_WAIT_V(8); PG8_WAIT_L(0); PG8_BAR; PG8_MMA(0, 0, At, B0); PG8_MMA(0, 1, At, B1); PG8_BAR; PG8_SCHED;
            PG8_LDA(At, 1, 1); PG8_STAGE(PG8_SB(1, 0), b3, voffB); PG8_STAGE(PG8_SB(1, 1), b3 + hstep, voffB); PG8_STAGE(PG8_SA(1, 0), a3, voffA);
            PG8_WAIT_V(8); PG8_WAIT_L(0); PG8_BAR; PG8_MMA(1, 0, At, B0); PG8_MMA(1, 1, At, B1); PG8_BAR; PG8_SCHED;
            } else {
            PG8_LDB(B0, 0, 0); PG8_SCHED; PG8_LDA(At, 0, 0); PG8_STAGE(PG8_SA(1, 1), a1 + hstep, voffA);
            PG8_WAIT_L(8); PG8_BAR; PG8_WAIT_L(0); PG8_MMA(0, 0, At, B0); PG8_BAR; PG8_SCHED;
            PG8_LDB(B1, 0, 1); PG8_STAGE(PG8_SB(0, 0), b2, voffB);
            PG8_BAR; PG8_WAIT_L(0); PG8_MMA(0, 1, At, B1); PG8_BAR;
            PG8_LDA(At, 0, 1); PG8_STAGE(PG8_SA(0, 0), a2, voffA);
            PG8_BAR; PG8_WAIT_L(0); PG8_MMA(1, 0, At, B0); PG8_BAR; PG8_SCHED;
            PG8_STAGE(PG8_SB(0, 1), b2 + hstep, voffB);
            PG8_WAIT_V(6); PG8_BAR; PG8_MMA(1, 1, At, B1); PG8_BAR;
            PG8_LDB(B0, 1, 0); PG8_SCHED; PG8_LDA(At, 1, 0); PG8_STAGE(PG8_SA(0, 1), a2 + hstep, voffA);
            PG8_WAIT_L(8); PG8_BAR; PG8_WAIT_L(0); PG8_MMA(0, 0, At, B0); PG8_BAR; PG8_SCHED;
            PG8_LDB(B1, 1, 1); PG8_STAGE(PG8_SB(1, 0), b3, voffB);
            PG8_BAR; PG8_WAIT_L(0); PG8_MMA(0, 1, At, B1); PG8_BAR;
            PG8_LDA(At, 1, 1); PG8_STAGE(PG8_SA(1, 0), a3, voffA);
            PG8_BAR; PG8_WAIT_L(0); PG8_MMA(1, 0, At, B0); PG8_BAR; PG8_SCHED;
            PG8_STAGE(PG8_SB(1, 1), b3 + hstep, voffB);
            PG8_WAIT_V(6); PG8_BAR; PG8_MMA(1, 1, At, B1); PG8_BAR;
            }
        }
        if constexpr (ALIGN_EPI) { if (wr == 0) PG8_BAR; }
        if constexpr (!Epi::AFTER_DRAIN) { E(acc, cur, wr, wc, fr, fq); S.done(cur); }
        if (!has_next) break;
#pragma unroll
        for (int a = 0; a < 2; ++a)
#pragma unroll
            for (int b = 0; b < 2; ++b)
#pragma unroll
                for (int m = 0; m < 4; ++m)
#pragma unroll
                    for (int n = 0; n < 2; ++n) acc[a][b][m][n] = (f32x4){0.f, 0.f, 0.f, 0.f};
        cur = nxt; cA = nA; cB = nB; ++ui;
        if constexpr (ALIGN_EPI) { if (wr == 1) PG8_BAR; }
    }
    PG8_WAIT_V(0);
    if constexpr (!ALIGN_EPI) { if (wr == 0) PG8_BAR; }
    PG8_BAR;
    if constexpr (Epi::AFTER_DRAIN) { E.fused(acc, cur, wr, wc, fr, fq, lds, wid, lane); S.done(cur); }
#undef PG8_SA
#undef PG8_SB
#undef PG8_STAGE
#undef PG8_LDA
#undef PG8_LDB
#undef PG8_MMA
#undef PG8_WAIT_V
#undef PG8_WAIT_L
#undef PG8_BAR
#undef PG8_SCHED
}
}
#define XB_TMO      128
#define XB_XCNT(j)  (256  + 64 * (j))
#define XB_XSUB(j)  (1280 + 64 * (j))
#define XB_XGEN(j)  (2304 + 64 * (j))
#define XB_TOP      3328
#define XB_TOPGEN   3392
#define XCD_BAR_WORDS 3456
#define XB_SPIN_CAP (1u << 18)
#define LAS __attribute__((address_space(3)))

__device__ __forceinline__ unsigned xb_ld(unsigned* p)              { return __hip_atomic_load(p, __ATOMIC_RELAXED, __HIP_MEMORY_SCOPE_AGENT); }
__device__ __forceinline__ unsigned xb_add(unsigned* p, unsigned v) { return __hip_atomic_fetch_add(p, v, __ATOMIC_RELAXED, __HIP_MEMORY_SCOPE_AGENT); }
__device__ __forceinline__ unsigned xb_xcc_id() { return (unsigned)__builtin_amdgcn_s_getreg((3 << 11) | 20) & 0xFu; }
#define XB_SPIN(cond, bar) do { unsigned _sp = 0; while (cond) { __builtin_amdgcn_s_sleep(1); \
    if ((++_sp & 255u) == 0u) { if (xb_ld(&(bar)[XB_TMO])) break; if (_sp > XB_SPIN_CAP) { atomicAdd(&(bar)[XB_TMO], 1u); break; } } } } while (0)

struct XcdBarrier {
    unsigned* bar; unsigned x;
    volatile LAS unsigned* st;
};

__device__ __forceinline__ XcdBarrier xcd_barrier_post(unsigned* bar, volatile LAS unsigned* st) {
    XcdBarrier b; b.bar = bar; b.x = xb_xcc_id(); b.st = st;
    if (threadIdx.x == 0) (void)xb_add(&bar[XB_XCNT(b.x)], 1u);
    return b;
}
__device__ __forceinline__ void xcd_barrier_complete(unsigned* bar, unsigned x, unsigned& nloc, unsigned& nx) {
    const unsigned G = gridDim.x * gridDim.y * gridDim.z;
    unsigned sum, cnt, mine, sp = 0u;
    for (;;) {
        sum = 0u; cnt = 0u; mine = 0u;
#pragma unroll
        for (unsigned j = 0; j < 16; ++j) { const unsigned c = xb_ld(&bar[XB_XCNT(j)]); sum += c; cnt += (c > 0u) ? 1u : 0u; mine = (j == x) ? c : mine; }
        if (sum == G) break;
        __builtin_amdgcn_s_sleep(1);
        if ((++sp & 255u) == 0u) { if (xb_ld(&bar[XB_TMO])) break; if (sp > XB_SPIN_CAP) { atomicAdd(&bar[XB_TMO], 1u); break; } }
    }
    nloc = mine > 0u ? mine : 1u; nx = cnt > 0u ? cnt : 1u;
}

__device__ __forceinline__ void xcd_barrier(const XcdBarrier& b) {
    asm volatile("s_waitcnt vmcnt(0)" ::: "memory");
    __syncthreads();
    if (threadIdx.x == 0) {
        unsigned* bar = b.bar;
        __builtin_amdgcn_s_waitcnt(0);
        unsigned nloc = b.st[0], nx = b.st[1];
        if (nloc == 0u) { xcd_barrier_complete(bar, b.x, nloc, nx); b.st[0] = nloc; b.st[1] = nx; }
        const unsigned old = xb_add(&bar[XB_XSUB(b.x)], 1u);
        const unsigned gen = old / nloc;
        if (old + 1u == (gen + 1u) * nloc) {
            __builtin_amdgcn_fence(__ATOMIC_RELEASE, "agent");
            asm volatile("s_waitcnt vmcnt(0)" ::: "memory");
            const unsigned og = xb_add(&bar[XB_TOP], 1u);
            const unsigned tg = og / nx;
            if (og + 1u == (tg + 1u) * nx) xb_add(&bar[XB_TOPGEN], 1u);
            else XB_SPIN(xb_ld(&bar[XB_TOPGEN]) == tg, bar);
            __builtin_amdgcn_fence(__ATOMIC_ACQUIRE, "agent");
            xb_add(&bar[XB_XGEN(b.x)], 1u);
            asm volatile("s_waitcnt vmcnt(0)" ::: "memory");
        } else {
            XB_SPIN(xb_ld(&bar[XB_XGEN(b.x)]) == gen, bar);
            __builtin_amdgcn_fence(__ATOMIC_ACQUIRE, "agent");
            asm volatile("s_waitcnt vmcnt(0)" ::: "memory");
        }
    }
    __syncthreads();
}

typedef unsigned short bf16;
typedef float f32x4 __attribute__((ext_vector_type(4)));
typedef unsigned u32x4 __attribute__((ext_vector_type(4)));
typedef unsigned u32x2 __attribute__((ext_vector_type(2)));
constexpr int D = 2048, NB = 4, SEQ = 4096, NL = 4, CTX = 256, CH = 128;
constexpr int MX = NB * SEQ, MC = NB * CTX, M = MX + MC;
constexpr int PIN = 5152, NP = 5376, FF = 5632, NMOD = 6 * D;
constexpr int C_U = 0, C_V = 1024, C_Q = 2048, C_K = 2560, C_VV = 3072, C_G = 4096, C_DF = 5120, C_DB = 5136;
constexpr int NCHUNK = M / CH;
constexpr float EPS = 1e-6f;
constexpr size_t MiB = 1u << 20;
constexpr size_t WS_CTL = 0, WS_MOD = 1 * MiB, ZERO_BYTES = 2 * MiB, WS_WIN = 2 * MiB, WS_WOUT = WS_WIN + 84 * MiB, WS_WFI = WS_WOUT + 32 * MiB, WS_WFO = WS_WFI + 176 * MiB,
                 WS_X = WS_WFO + 88 * MiB, WS_H = WS_X + 136 * MiB, WS_P = WS_H + 68 * MiB, WS_CAT = WS_P + 179 * MiB, WS_Y = WS_CAT + 68 * MiB, WS_HID = WS_Y + 136 * MiB,
                 WS_DS = WS_HID + 187 * MiB, WS_SP = WS_DS + 136 * MiB, WS_DEC = WS_SP + 68 * MiB, WS_WSB = WS_DEC + 1 * MiB, WS_END = WS_WSB + 1 * MiB;
static_assert((size_t)NL * NP * D * 2 <= 84 * MiB && (size_t)NL * 2 * FF * D * 2 <= 176 * MiB && (size_t)NL * D * FF * 2 <= 88 * MiB && (size_t)M * NP * 2 <= 179 * MiB && (size_t)M * FF * 2 <= 187 * MiB, "ws map");
constexpr int CW_BAR = 4096;
constexpr int LDS_BYTES = 163840, MISC_OFF = LDS_BYTES - 256;

__device__ __forceinline__ float bf2f(bf16 b) { return __uint_as_float(((unsigned)b) << 16); }
__device__ __forceinline__ unsigned f2bf(float f) { unsigned u = __float_as_uint(f); return (u + 0x7fffu + ((u >> 16) & 1u)) >> 16; }
__device__ __forceinline__ unsigned pk2(float lo, float hi) { return f2bf(lo) | (f2bf(hi) << 16); }
__device__ __forceinline__ float wave_sum(float v) {
#pragma unroll
    for (int o = 1; o < 64; o <<= 1) v += __shfl_xor(v, o);
    return v;
}
__device__ __forceinline__ float sigmoid_acc(float x) { return 1.0f / (1.0f + __expf(-x)); }
__device__ __forceinline__ float silu_acc(float x) { return x * sigmoid_acc(x); }
__device__ __forceinline__ float log_sigmoid(float z) { return fminf(z, 0.f) - log1pf(__expf(-fabsf(z))); }
__device__ __forceinline__ int mod_row(int row) { return row < MX ? row / SEQ : NB; }
#define LDS_WAIT() asm volatile("s_waitcnt lgkmcnt(0)" ::: "memory")


__device__ __forceinline__ int map_col(int mode, int r) {
    if (mode == 0) return r;
    if (mode == 1) return r < PIN ? r : -1;
    const int pn = r >> 8, rr = r & 255; return rr < 128 ? pn * 128 + rr : FF + pn * 128 + (rr - 128);
}
__device__ __forceinline__ void transpose_item(const float* W, int K, int Nsrc, bf16* T, int n0, int c0, int k0, LAS float* scr, int lane) {
    if (c0 >= 0) {
#pragma unroll 8
        for (int i = 0; i < 32; ++i) { const int kk = 2 * i + (lane >> 5); scr[kk * 33 + (lane & 31)] = W[(size_t)(k0 + kk) * Nsrc + c0 + (lane & 31)]; }
    } else {
#pragma unroll 8
        for (int i = 0; i < 32; ++i) { const int kk = 2 * i + (lane >> 5); scr[kk * 33 + (lane & 31)] = 0.f; }
    }
    LDS_WAIT(); asm volatile("" ::: "memory");
    const int c = lane & 7;
#pragma unroll
    for (int j = 0; j < 4; ++j) { const int n = (lane >> 3) + 8 * j; const LAS float* s = scr + (8 * c) * 33 + n;
        u32x4 o; o.x = pk2(s[0 * 33], s[1 * 33]); o.y = pk2(s[2 * 33], s[3 * 33]); o.z = pk2(s[4 * 33], s[5 * 33]); o.w = pk2(s[6 * 33], s[7 * 33]);
        *(u32x4*)(T + (size_t)(n0 + n) * K + k0 + 8 * c) = o; }
    LDS_WAIT(); asm volatile("" ::: "memory");
}
__device__ __forceinline__ void conv_matrix(const float* W, bf16* T, int K, int Nsrc, int Ndst, int mode, int& it0, int gw, int ngw, LAS float* scr, int lane) {
    const int nblk = Ndst / 32, per_layer = (K / 64) * nblk, total = NL * per_layer;
    int first = ((gw - it0) % ngw + ngw) % ngw;
    for (int it = first; it < total; it += ngw) {
        const int l = it / per_layer, r = it % per_layer, kb = r / nblk, nb = r % nblk;
        transpose_item(W + (size_t)l * K * Nsrc, K, Nsrc, T + (size_t)l * Ndst * K, 32 * nb, map_col(mode, 32 * nb), 64 * kb, scr, lane);
    }
    it0 += total;
}
struct RowArgs { const float* xin_x; const float* xin_c; const float* Y; float* X; float* out; bf16* H; const float* modA; const float* modB; const float* gA; const float* gB; int mode; int write_h; int to_out; int pad; };
__device__ __forceinline__ void row_pass(const RowArgs& a, int row, int lane) {
    const int mr = mod_row(row);
    const float* xsrc = (a.mode == 2 || a.xin_x == nullptr) ? a.X + (size_t)row * D : (row < MX ? a.xin_x + (size_t)row * D : a.xin_c + (size_t)(row - MX) * D);
    f32x4 x[8];
#pragma unroll
    for (int j = 0; j < 8; ++j) x[j] = *(const f32x4*)(xsrc + 4 * lane + 256 * j);
    if (a.mode != 0) {
        const float* yr = a.Y + (size_t)row * D; const float* mg = a.modA + (size_t)mr * NMOD + (a.mode == 1 ? 2 : 5) * D;
        f32x4 y[8]; float ss = 0.f;
#pragma unroll
        for (int j = 0; j < 8; ++j) { y[j] = *(const f32x4*)(yr + 4 * lane + 256 * j); ss += (y[j][0] * y[j][0] + y[j][1] * y[j][1]) + (y[j][2] * y[j][2] + y[j][3] * y[j][3]); }
        const float rstd = rsqrtf(wave_sum(ss) * (1.f / D) + EPS);
#pragma unroll
        for (int j = 0; j < 8; ++j) { const f32x4 g = *(const f32x4*)(a.gA + 4 * lane + 256 * j), mm = *(const f32x4*)(mg + 4 * lane + 256 * j); x[j] = x[j] + mm * (y[j] * rstd * g); }
        float* dst = (a.to_out && row < MX) ? a.out + (size_t)row * D : a.X + (size_t)row * D;
        if (!(a.to_out && row >= MX)) {
#pragma unroll
            for (int j = 0; j < 8; ++j) *(f32x4*)(dst + 4 * lane + 256 * j) = x[j]; }
    }
    if (a.write_h) {
        float ss = 0.f;
#pragma unroll
        for (int j = 0; j < 8; ++j) ss += (x[j][0] * x[j][0] + x[j][1] * x[j][1]) + (x[j][2] * x[j][2] + x[j][3] * x[j][3]);
        const float rstd = rsqrtf(wave_sum(ss) * (1.f / D) + EPS);
        const float* msh = (a.mode == 1 ? a.modA + (size_t)mr * NMOD + 3 * D : a.modB + (size_t)mr * NMOD);
        const float* msc = msh + D;
        bf16* hr = a.H + (size_t)row * D;
#pragma unroll
        for (int j = 0; j < 8; ++j) { const f32x4 g = *(const f32x4*)(a.gB + 4 * lane + 256 * j), sh = *(const f32x4*)(msh + 4 * lane + 256 * j), sc = *(const f32x4*)(msc + 4 * lane + 256 * j);
            const f32x4 h = (x[j] * rstd * g) * (sc + 1.0f) + sh; u32x2 w; w.x = pk2(h[0], h[1]); w.y = pk2(h[2], h[3]); *(u32x2*)(hr + 4 * lane + 256 * j) = w; }
    }
}

__device__ __forceinline__ void gmlp_unit_simple(const bf16* P, bf16* CAT, const float* ln_g, const float* ln_b, const float* ws, const float* bs, int cid, int h, LAS float* vln, int tid) {
    { const int j = tid >> 2, qd = tid & 3; const bf16* vp = P + (size_t)(cid * CH + j) * NP + C_V + h * 128 + qd * 32;
      float v[32]; float s = 0.f;
#pragma unroll
      for (int i = 0; i < 4; ++i) { const u32x4 w = *(const u32x4*)(vp + 8 * i);
#pragma unroll
          for (int e = 0; e < 4; ++e) { v[8 * i + 2 * e] = __uint_as_float(w[e] << 16); v[8 * i + 2 * e + 1] = __uint_as_float(w[e] & 0xffff0000u); } }
#pragma unroll
      for (int i = 0; i < 32; ++i) s += v[i];
      s += __shfl_xor(s, 1); s += __shfl_xor(s, 2); const float mu = s * (1.f / 128.f); float q = 0.f;
#pragma unroll
      for (int i = 0; i < 32; ++i) { v[i] -= mu; q += v[i] * v[i]; }
      q += __shfl_xor(q, 1); q += __shfl_xor(q, 2); const float rstd = rsqrtf(q * (1.f / 128.f) + EPS);
#pragma unroll
      for (int i = 0; i < 32; ++i) { const int d = qd * 32 + i; vln[j * CH + d] = v[i] * rstd * ln_g[h * 128 + d] + ln_b[h * 128 + d]; } }
    __syncthreads();
    const int d = tid & 127, ig = __builtin_amdgcn_readfirstlane(tid >> 7);
    for (int ii = 0; ii < 32; ++ii) { const int i = ig * 32 + ii; const float* wr = ws + ((size_t)h * CH + i) * CH; float acc = 0.f;
#pragma unroll 16
        for (int j = 0; j < CH; ++j) acc += wr[j] * vln[j * CH + d];
        const size_t row = (size_t)cid * CH + i; const float u = bf2f(P[row * NP + C_U + h * 128 + d]);
        CAT[row * D + h * 128 + d] = (bf16)f2bf(u * (acc + bs[h * CH + i])); }
    __syncthreads();
}


typedef short bf16x8 __attribute__((ext_vector_type(8)));
typedef short s16x4 __attribute__((ext_vector_type(4)));
typedef short v4i16_t __attribute__((ext_vector_type(4)));
constexpr int PQ = 288, PV = 544;
constexpr int L_QT = 0, L_KT = 36864, L_ST = 0, L_V = 73728, L_DF = 143360, L_TOT = 151552;
__device__ __forceinline__ s16x4 tr_read(const LAS unsigned char* p) { return __builtin_bit_cast(s16x4, __builtin_amdgcn_ds_read_tr16_b64_v4i16((LAS v4i16_t*)p)); }
__device__ __forceinline__ bf16x8 cat8(s16x4 lo, s16x4 hi) { return (bf16x8){lo[0], lo[1], lo[2], lo[3], hi[0], hi[1], hi[2], hi[3]}; }
__device__ __forceinline__ float logsig_fast(float z) { return fminf(z, 0.f) - __logf(1.0f + __expf(-fabsf(z))); }
__device__ __forceinline__ f32x4 mfma16(bf16x8 a, bf16x8 b, f32x4 c) { return __builtin_amdgcn_mfma_f32_16x16x32_bf16(a, b, c, 0, 0, 0); }

__device__ __forceinline__ void load_v_tile(const bf16* P, int cid, int h, LAS unsigned char* V, int tid) {
#pragma unroll
    for (int i = 0; i < 8; ++i) { const int idx = tid + 512 * i, row = idx >> 5, ch = idx & 31;
        const u32x4 w = *(const u32x4*)(P + (size_t)(cid * CH + row) * NP + C_VV + h * 256 + ch * 8); *(LAS u32x4*)(V + row * PV + ch * 16) = w; }
}
template <int MODE> __device__ __forceinline__ void gla_prep(const bf16* P, const float* wd2, const float* bd, float* dec_out, int cid, int h, int dir, LAS unsigned char* lds, int tid) {
    LAS float* DF = (LAS float*)(lds + L_DF); LAS float* TOT = (LAS float*)(lds + L_TOT);
    LAS bf16* QT = (LAS bf16*)(lds + L_QT); LAS bf16* KT = (LAS bf16*)(lds + L_KT);
    asm volatile("" : "+v"(tid));
    const int d = tid & 127, seg = tid >> 7;
    { const int j = tid >> 2, r0 = (tid & 3) * 4; const u32x2 w = *(const u32x2*)(P + (size_t)(cid * CH + j) * NP + (dir ? C_DB : C_DF) + r0);
      const f32x4 f = {__uint_as_float(w.x << 16), __uint_as_float(w.x & 0xffff0000u), __uint_as_float(w.y << 16), __uint_as_float(w.y & 0xffff0000u)}; *(LAS f32x4*)(DF + j * 16 + r0) = f; }
    float wd[16];
#pragma unroll
    for (int r = 0; r < 16; ++r) wd[r] = wd2[r * 512 + h * 128 + d];
    const float bdv = bd[h * 128 + d];
    __syncthreads();
    float bl[32]; float run = 0.f;
#pragma unroll
    for (int jj = 0; jj < 32; ++jj) { const int pos = 32 * seg + jj, j = dir ? 127 - pos : pos; const LAS f32x4* dfp = (const LAS f32x4*)(DF + j * 16);
        const f32x4 a = dfp[0], b = dfp[1], c = dfp[2], e = dfp[3];
        float z = bdv;
        z += a[0] * wd[0]; z += a[1] * wd[1]; z += a[2] * wd[2]; z += a[3] * wd[3]; z += b[0] * wd[4]; z += b[1] * wd[5]; z += b[2] * wd[6]; z += b[3] * wd[7];
        z += c[0] * wd[8]; z += c[1] * wd[9]; z += c[2] * wd[10]; z += c[3] * wd[11]; z += e[0] * wd[12]; z += e[1] * wd[13]; z += e[2] * wd[14]; z += e[3] * wd[15];
        run += logsig_fast(z) * (1.f / 16.f); bl[jj] = run; }
    TOT[seg * 128 + d] = run;
    __syncthreads();
    float off = 0.f, tot = 0.f;
#pragma unroll
    for (int s = 0; s < 4; ++s) { const float t = TOT[s * 128 + d]; tot += t; off += (s < seg) ? t : 0.f; }
    if (MODE == 0) { if (seg == 0) dec_out[d] = __expf(tot); }
#pragma unroll
    for (int j8 = 0; j8 < 4; ++j8) {
        float kv[8], qv[8];
#pragma unroll
        for (int t = 0; t < 8; ++t) { const int pos = 32 * seg + 8 * j8 + t, j = dir ? 127 - pos : pos; const bf16* pr = P + (size_t)(cid * CH + j) * NP + h * 128 + d;
            kv[t] = bf2f(pr[C_K]); qv[t] = (MODE == 1) ? bf2f(pr[C_Q]) : 0.f; }
#pragma unroll
        for (int t = 0; t < 8; ++t) { const int jj = 8 * j8 + t, pos = 32 * seg + jj, j = dir ? 127 - pos : pos; const float b = bl[jj] + off;
            if (MODE == 0) { KT[j * (PQ / 2) + d] = (bf16)f2bf(kv[t] * __expf(tot - b)); }
            else { QT[j * (PQ / 2) + d] = (bf16)f2bf(qv[t] * 0.08838834764831845f * __expf(b)); KT[j * (PQ / 2) + d] = (bf16)f2bf(kv[t] * __expf(-b)); } }
        asm volatile("" ::: "memory");
    }
}
__device__ __forceinline__ void gla_g1_unit(const bf16* P, const float* wd2, const float* bd, float* DS, float* DEC, int cid, int h, int dir, LAS unsigned char* lds, int tid, int lane, int wave) {
    const int unit = (cid * 4 + h) * 2 + dir;
    asm volatile("" : "+v"(tid));
    load_v_tile(P, cid, h, lds + L_V, tid);
    gla_prep<0>(P, wd2, bd, DEC + (size_t)unit * 128, cid, h, dir, lds, tid);
    __syncthreads();
    int t2 = tid; asm volatile("" : "+v"(t2)); (void)lane;
    const int wdb = wave >> 1, we = wave & 1, g = (t2 >> 4) & 3, li = t2 & 15, q = li >> 2, p = li & 3;
    f32x4 acc[2][8];
#pragma unroll
    for (int dt = 0; dt < 2; ++dt)
#pragma unroll
        for (int et = 0; et < 8; ++et) acc[dt][et] = (f32x4){0.f, 0.f, 0.f, 0.f};
    const LAS unsigned char* KT = lds + L_KT; const LAS unsigned char* V = lds + L_V;
#pragma unroll
    for (int ks = 0; ks < 4; ++ks) { const int row = 32 * ks + 8 * g + q;
        bf16x8 X[2];
#pragma unroll
        for (int dt = 0; dt < 2; ++dt) X[dt] = cat8(tr_read(KT + row * PQ + (32 * wdb + 16 * dt + 4 * p) * 2), tr_read(KT + (row + 4) * PQ + (32 * wdb + 16 * dt + 4 * p) * 2));
#pragma unroll
        for (int et = 0; et < 8; ++et) { const bf16x8 Y = cat8(tr_read(V + row * PV + (128 * we + 16 * et + 4 * p) * 2), tr_read(V + (row + 4) * PV + (128 * we + 16 * et + 4 * p) * 2));
            acc[0][et] = mfma16(X[0], Y, acc[0][et]); acc[1][et] = mfma16(X[1], Y, acc[1][et]); } }
#pragma unroll
    for (int dt = 0; dt < 2; ++dt)
#pragma unroll
        for (int et = 0; et < 8; ++et) { const int e = 128 * we + 16 * et + li, d0 = 32 * wdb + 16 * dt + 4 * g; *(f32x4*)(DS + ((size_t)unit * 256 + e) * 128 + d0) = acc[dt][et]; }
    __syncthreads();
}
__device__ __forceinline__ int gla_chain_cid(int s, int b, int dir) { return dir ? (s < 2 ? 128 + 2 * b + (1 - s) : 32 * b + 31 - (s - 2)) : (s < 2 ? 128 + 2 * b + s : 32 * b + (s - 2)); }
__device__ __forceinline__ void gla_g2_item(const float* DS, const float* DEC, bf16* SP, int item) {
    const int chain = item >> 13, ed = item & 8191, b = chain >> 3, h = (chain >> 1) & 3, dir = chain & 1, e = ed >> 5, d0 = (ed & 31) * 4;
    f32x4 S = {0.f, 0.f, 0.f, 0.f};
#pragma unroll 2
    for (int s = 0; s < 34; ++s) { const int cid = gla_chain_cid(s, b, dir), unit = (cid * 4 + h) * 2 + dir; const size_t off = ((size_t)unit * 256 + e) * 128 + d0;
        const f32x4 dec = *(const f32x4*)(DEC + (size_t)unit * 128 + d0), ds = *(const f32x4*)(DS + off);
        u32x2 w; w.x = pk2(S[0], S[1]); w.y = pk2(S[2], S[3]); *(u32x2*)(SP + off) = w;
        S = dec * S + ds; }
}
__device__ __forceinline__ void gla_g3_unit(const bf16* P, const float* wd2f, const float* bdf, const float* wd2b, const float* bdb, const bf16* SP, const float* out_g, bf16* CAT,
                                            int cid, int h, LAS unsigned char* lds, int tid, int lane, int wave) {
    asm volatile("" : "+v"(tid));
    load_v_tile(P, cid, h, lds + L_V, tid);
    const int w = wave; (void)lane;
    const LAS unsigned char* QT = lds + L_QT; const LAS unsigned char* KT = lds + L_KT; LAS unsigned char* ST = lds + L_ST; const LAS unsigned char* V = lds + L_V;
    f32x4 o[16];
#pragma unroll
    for (int et = 0; et < 16; ++et) o[et] = (f32x4){0.f, 0.f, 0.f, 0.f};
#pragma unroll
    for (int dir = 0; dir < 2; ++dir) {
        const int unit = (cid * 4 + h) * 2 + dir;
        gla_prep<1>(P, dir ? wd2b : wd2f, dir ? bdb : bdf, nullptr, cid, h, dir, lds, tid);
        __syncthreads();
        int t2 = tid; asm volatile("" : "+v"(t2));
        const int g = (t2 >> 4) & 3, li = t2 & 15, q = li >> 2, p = li & 3;
        u32x4 sp[8];
#pragma unroll
        for (int i = 0; i < 8; ++i) sp[i] = *(const u32x4*)(SP + (size_t)unit * 32768 + (size_t)(tid + 512 * i) * 8);
        bf16x8 Yq[4];
#pragma unroll
        for (int ks = 0; ks < 4; ++ks) Yq[ks] = *(const LAS bf16x8*)(QT + (16 * w + li) * PQ + (32 * ks + 8 * g) * 2);
        bf16x8 Pf[4];
#pragma unroll
        for (int kp = 0; kp < 4; ++kp) {
            f32x4 s0 = {0.f, 0.f, 0.f, 0.f}, s1 = {0.f, 0.f, 0.f, 0.f};
            const int t0 = 2 * kp, t1 = 2 * kp + 1;
            const bool a0 = dir ? (t0 >= w) : (t0 <= w), a1 = dir ? (t1 >= w) : (t1 <= w);
            if (a0) {
#pragma unroll
                for (int ks = 0; ks < 4; ++ks) s0 = mfma16(*(const LAS bf16x8*)(KT + (16 * t0 + li) * PQ + (32 * ks + 8 * g) * 2), Yq[ks], s0); }
            if (a1) {
#pragma unroll
                for (int ks = 0; ks < 4; ++ks) s1 = mfma16(*(const LAS bf16x8*)(KT + (16 * t1 + li) * PQ + (32 * ks + 8 * g) * 2), Yq[ks], s1); }
            if (t0 == w) {
#pragma unroll
                for (int r = 0; r < 4; ++r) { const bool keep = dir ? (4 * g + r >= li) : (4 * g + r <= li); s0[r] = keep ? s0[r] : 0.f; } }
            if (t1 == w) {
#pragma unroll
                for (int r = 0; r < 4; ++r) { const bool keep = dir ? (4 * g + r >= li) : (4 * g + r <= li); s1[r] = keep ? s1[r] : 0.f; } }
            u32x4 pw; pw.x = pg8::cvt_pk_bf16(s0[0], s0[1]); pw.y = pg8::cvt_pk_bf16(s0[2], s0[3]); pw.z = pg8::cvt_pk_bf16(s1[0], s1[1]); pw.w = pg8::cvt_pk_bf16(s1[2], s1[3]);
            Pf[kp] = __builtin_bit_cast(bf16x8, pw);
        }
#pragma unroll
        for (int kp = 0; kp < 4; ++kp) {
            const bool act = dir ? (2 * kp + 1 >= w) : (2 * kp <= w);
            if (act) {
#pragma unroll
                for (int et = 0; et < 16; ++et) { const bf16x8 Xv = cat8(tr_read(V + (32 * kp + 4 * g + q) * PV + (16 * et + 4 * p) * 2), tr_read(V + (32 * kp + 16 + 4 * g + q) * PV + (16 * et + 4 * p) * 2));
                    o[et] = mfma16(Xv, Pf[kp], o[et]); } }
        }
        __syncthreads();
#pragma unroll
        for (int i = 0; i < 8; ++i) { const int idx = tid + 512 * i; *(LAS u32x4*)(ST + (idx >> 4) * PQ + (idx & 15) * 16) = sp[i]; }
        __syncthreads();
#pragma unroll
        for (int et = 0; et < 16; ++et)
#pragma unroll
            for (int ks = 0; ks < 4; ++ks) o[et] = mfma16(*(const LAS bf16x8*)(ST + (16 * et + li) * PQ + (32 * ks + 8 * g) * 2), Yq[ks], o[et]);
        __syncthreads();
    }
    int t3 = tid; asm volatile("" : "+v"(t3));
    const int g = (t3 >> 4) & 3, li = t3 & 15;
    float ss = 0.f;
#pragma unroll
    for (int et = 0; et < 16; ++et) ss += (o[et][0] * o[et][0] + o[et][1] * o[et][1]) + (o[et][2] * o[et][2] + o[et][3] * o[et][3]);
    ss += __shfl_xor(ss, 16); ss += __shfl_xor(ss, 32);
    const float rstd = rsqrtf(ss * (1.f / 256.f) + EPS);
    const size_t row = (size_t)cid * CH + 16 * w + li;
#pragma unroll
    for (int et = 0; et < 16; ++et) { const int e0 = h * 256 + 16 * et + 4 * g; const f32x4 gg = *(const f32x4*)(out_g + e0); const u32x2 gw = *(const u32x2*)(P + row * NP + C_G + e0);
        const float g0 = __uint_as_float(gw.x << 16), g1 = __uint_as_float(gw.x & 0xffff0000u), g2 = __uint_as_float(gw.y << 16), g3 = __uint_as_float(gw.y & 0xffff0000u);
        u32x2 ow; ow.x = pk2(o[et][0] * rstd * gg[0] * silu_acc(g0), o[et][1] * rstd * gg[1] * silu_acc(g1)); ow.y = pk2(o[et][2] * rstd * gg[2] * silu_acc(g2), o[et][3] * rstd * gg[3] * silu_acc(g3));
        *(u32x2*)(CAT + row * D + 1024 + e0) = ow; }
}

__device__ __forceinline__ void gmlp_unit_fast(const bf16* P, bf16* CAT, const float* ln_g, const float* ln_b, const bf16* WSB, const float* bs, int cid, int h, LAS unsigned char* lds, int tid, int wave) {
    asm volatile("" : "+v"(tid));
    LAS unsigned char* VL = lds;
    { const int j = tid >> 2, qd = tid & 3; const bf16* vp = P + (size_t)(cid * CH + j) * NP + C_V + h * 128 + qd * 32;
      float v[32]; float s = 0.f;
#pragma unroll
      for (int i = 0; i < 4; ++i) { const u32x4 w = *(const u32x4*)(vp + 8 * i);
#pragma unroll
          for (int e = 0; e < 4; ++e) { v[8 * i + 2 * e] = __uint_as_float(w[e] << 16); v[8 * i + 2 * e + 1] = __uint_as_float(w[e] & 0xffff0000u); } }
#pragma unroll
      for (int i = 0; i < 32; ++i) s += v[i];
      s += __shfl_xor(s, 1); s += __shfl_xor(s, 2); const float mu = s * (1.f / 128.f); float q = 0.f;
#pragma unroll
      for (int i = 0; i < 32; ++i) { v[i] -= mu; q += v[i] * v[i]; }
      q += __shfl_xor(q, 1); q += __shfl_xor(q, 2); const float rstd = rsqrtf(q * (1.f / 128.f) + EPS);
      const float* gp = ln_g + h * 128 + qd * 32; const float* bp = ln_b + h * 128 + qd * 32;
#pragma unroll
      for (int i = 0; i < 4; ++i) { const f32x4 g0 = *(const f32x4*)(gp + 8 * i), g1 = *(const f32x4*)(gp + 8 * i + 4), b0 = *(const f32x4*)(bp + 8 * i), b1 = *(const f32x4*)(bp + 8 * i + 4);
          u32x4 o; o.x = pk2(v[8 * i + 0] * rstd * g0[0] + b0[0], v[8 * i + 1] * rstd * g0[1] + b0[1]); o.y = pk2(v[8 * i + 2] * rstd * g0[2] + b0[2], v[8 * i + 3] * rstd * g0[3] + b0[3]);
          o.z = pk2(v[8 * i + 4] * rstd * g1[0] + b1[0], v[8 * i + 5] * rstd * g1[1] + b1[1]); o.w = pk2(v[8 * i + 6] * rstd * g1[2] + b1[2], v[8 * i + 7] * rstd * g1[3] + b1[3]);
          *(LAS u32x4*)(VL + j * PQ + (qd * 32 + 8 * i) * 2) = o; } }
    __syncthreads();
    int t2 = tid; asm volatile("" : "+v"(t2));
    const int g = (t2 >> 4) & 3, li = t2 & 15, q = li >> 2, p = li & 3, w = wave;
    bf16x8 Yw[4];
#pragma unroll
    for (int ks = 0; ks < 4; ++ks) Yw[ks] = *(const bf16x8*)(WSB + ((size_t)(h * CH + 16 * w + li)) * CH + 32 * ks + 8 * g);
    f32x4 acc[8];
#pragma unroll
    for (int dt = 0; dt < 8; ++dt) acc[dt] = (f32x4){0.f, 0.f, 0.f, 0.f};
#pragma unroll
    for (int ks = 0; ks < 4; ++ks)
#pragma unroll
        for (int dt = 0; dt < 8; ++dt) { const bf16x8 X = cat8(tr_read(VL + (32 * ks + 8 * g + q) * PQ + (16 * dt + 4 * p) * 2), tr_read(VL + (32 * ks + 8 * g + q + 4) * PQ + (16 * dt + 4 * p) * 2));
            acc[dt] = mfma16(X, Yw[ks], acc[dt]); }
    const size_t row = (size_t)cid * CH + 16 * w + li; const float bsv = bs[h * CH + 16 * w + li];
#pragma unroll
    for (int dt = 0; dt < 8; ++dt) { const int c0 = h * 128 + 16 * dt + 4 * g; const u32x2 uw = *(const u32x2*)(P + row * NP + C_U + c0);
        const float u0 = __uint_as_float(uw.x << 16), u1 = __uint_as_float(uw.x & 0xffff0000u), u2 = __uint_as_float(uw.y << 16), u3 = __uint_as_float(uw.y & 0xffff0000u);
        u32x2 ow; ow.x = pk2(u0 * (acc[dt][0] + bsv), u1 * (acc[dt][1] + bsv)); ow.y = pk2(u2 * (acc[dt][2] + bsv), u3 * (acc[dt][3] + bsv));
        *(u32x2*)(CAT + row * D + c0) = ow; }
    __syncthreads();
}

constexpr int NPH = 2 + 9 * NL;
struct Args { const float* in[23]; float* out; unsigned char* ws; int ph_lo, ph_hi, li, pad; };

#define IN(k) (lo <= (k) && (k) < hi)
#define PHASE_IDS() int tid = tid0; asm volatile("" : "+v"(tid)); const int lane = tid & 63, wave = __builtin_amdgcn_readfirstlane(tid >> 6), gw = bid * 8 + wave, ngw = G * 8; (void)lane; (void)gw; (void)ngw
#define SEAM(k) do { if (IN(k) && IN((k) + 1)) xcd_barrier(bar); } while (0)
template <int l> __device__ __forceinline__ void run_layer(const Args& a, LAS unsigned char* lds, const XcdBarrier& bar, int tid0, int G, int bid, int lo, int hi) {
    unsigned char* ws = a.ws;
    const float* x = a.in[0]; const float* ctx = a.in[2];
    const float* g_pre_mix = a.in[6]; const float* g_post_mix = a.in[7]; const float* g_pre_ffn = a.in[8]; const float* g_post_ffn = a.in[9];
    const float* ln_g = a.in[11]; const float* ln_b = a.in[12]; const float* gws = a.in[13]; const float* gbs = a.in[14];
    const float* wd2f = a.in[15]; const float* bdf = a.in[16]; const float* wd2b = a.in[17]; const float* bdb = a.in[18];
    const float* out_g = a.in[19];
    float* MOD = (float*)(ws + WS_MOD); bf16* WIN = (bf16*)(ws + WS_WIN); bf16* WOUT = (bf16*)(ws + WS_WOUT); bf16* WFI = (bf16*)(ws + WS_WFI); bf16* WFO = (bf16*)(ws + WS_WFO);
    float* X = (float*)(ws + WS_X); bf16* H = (bf16*)(ws + WS_H); bf16* P = (bf16*)(ws + WS_P); bf16* CAT = (bf16*)(ws + WS_CAT); float* Y = (float*)(ws + WS_Y); bf16* HID = (bf16*)(ws + WS_HID);
    float* DS = (float*)(ws + WS_DS); bf16* SP = (bf16*)(ws + WS_SP); float* DEC = (float*)(ws + WS_DEC); bf16* WSB = (bf16*)(ws + WS_WSB);
        const int pb = 2 + 9 * l;
        const float* modl = MOD + (size_t)l * 5 * NMOD;
        if (IN(pb + 0)) { pg8::Gemm g{H, WIN + (size_t)l * NP * D, M, NP, D}; pg8::StaticOrder S; S.init(M, NP, G, bid); pg8::EpiProj E{P, NP, 8};
            pg8::gemm_phase<pg8::EpiProj, pg8::StaticOrder, true, true>(lds, g, S, E); }
        SEAM(pb + 0);
        if (IN(pb + 1)) { PHASE_IDS();
            for (int u = bid; u < NCHUNK * 8; u += G)
                gmlp_unit_fast(P, CAT, ln_g + l * 1024, ln_b + l * 1024, WSB + (size_t)l * 8 * CH * CH, gbs + l * 8 * CH, u >> 3, u & 7, lds, tid, wave);
            for (int u = bid; u < NCHUNK * 8; u += G) { const int dir = u & 1, h = (u >> 1) & 3, cid = u >> 3;
                gla_g1_unit(P, (dir ? wd2b : wd2f) + l * 16 * 512, (dir ? bdb : bdf) + l * 512, DS, DEC, cid, h, dir, lds, tid, lane, wave); }
        }
        SEAM(pb + 1);
        if (IN(pb + 2)) { PHASE_IDS();
            for (int it = bid * 512 + tid; it < 32 * 8192; it += G * 512) gla_g2_item(DS, DEC, SP, it);
        }
        SEAM(pb + 2);
        if (IN(pb + 3)) { PHASE_IDS();
            for (int u = bid; u < NCHUNK * 4; u += G)
                gla_g3_unit(P, wd2f + l * 16 * 512, bdf + l * 512, wd2b + l * 16 * 512, bdb + l * 512, SP, out_g + l * 1024, CAT, u >> 2, u & 3, lds, tid, lane, wave);
        }
        SEAM(pb + 3);
        if (IN(pb + 4)) { pg8::Gemm g{CAT, WOUT + (size_t)l * D * D, M, D, D}; pg8::StaticOrder S; S.init(M, D, G, bid); pg8::EpiF32 E{Y, D};
            pg8::gemm_phase<pg8::EpiF32, pg8::StaticOrder, true, true>(lds, g, S, E); }
        SEAM(pb + 4);
        if (IN(pb + 5)) { PHASE_IDS();
            RowArgs r{}; r.xin_x = l == 0 ? x : nullptr; r.xin_c = l == 0 ? ctx : nullptr; r.Y = Y; r.X = X; r.H = H; r.modA = modl; r.gA = g_post_mix + l * D; r.gB = g_pre_ffn + l * D; r.mode = 1; r.write_h = 1;
            for (int row = gw; row < M; row += ngw) row_pass(r, row, lane);
        }
        SEAM(pb + 5);
        if (IN(pb + 6)) { pg8::Gemm g{H, WFI + (size_t)l * 2 * FF * D, M, 2 * FF, D}; pg8::StaticOrder S; S.init(M, 2 * FF, G, bid); pg8::EpiSwiglu E{HID, FF};
            pg8::gemm_phase<pg8::EpiSwiglu, pg8::StaticOrder, true, true>(lds, g, S, E); }
        SEAM(pb + 6);
        if (IN(pb + 7)) { pg8::Gemm g{HID, WFO + (size_t)l * D * FF, M, D, FF}; pg8::StaticOrder S; S.init(M, D, G, bid); pg8::EpiF32 E{Y, D};
            pg8::gemm_phase<pg8::EpiF32, pg8::StaticOrder, true, true>(lds, g, S, E); }
        SEAM(pb + 7);
        if (IN(pb + 8)) { PHASE_IDS();
            RowArgs r{}; r.Y = Y; r.X = X; r.out = a.out; r.H = H; r.modA = modl; r.modB = modl + 5 * NMOD; r.gA = g_post_ffn + l * D; r.gB = g_pre_mix + (l + 1 < NL ? l + 1 : l) * D; r.mode = 2; r.write_h = (l + 1 < NL); r.to_out = (l + 1 == NL);
            for (int row = gw; row < M; row += ngw) row_pass(r, row, lane);
        }
        SEAM(pb + 8);
}
__global__ void __launch_bounds__(512, 2) mega(Args a) {
    extern __shared__ __attribute__((aligned(16))) unsigned char lds_raw[];
    LAS unsigned char* lds = (LAS unsigned char*)lds_raw;
    const int tid0 = threadIdx.x;
    const int G = gridDim.x, bid = blockIdx.x;
    volatile LAS unsigned* MISC = (volatile LAS unsigned*)(lds + MISC_OFF);
    if (tid0 < 32) MISC[tid0] = 0u;
    __syncthreads();
    unsigned char* ws = a.ws;
    const int lo = a.ph_lo, hi = a.ph_hi;
    XcdBarrier bar; bar.bar = (unsigned*)(ws + WS_CTL) + CW_BAR + a.li * XCD_BAR_WORDS; bar.x = 0; bar.st = nullptr;
    if (hi - lo > 1) bar = xcd_barrier_post((unsigned*)(ws + WS_CTL) + CW_BAR + a.li * XCD_BAR_WORDS, MISC + 8);
    const float* x = a.in[0]; const float* c = a.in[1]; const float* ctx = a.in[2]; const float* cctx = a.in[3];
    const float* w_mod = a.in[4]; const float* b_mod = a.in[5];
    const float* g_pre_mix = a.in[6]; const float* g_post_mix = a.in[7]; const float* g_pre_ffn = a.in[8]; const float* g_post_ffn = a.in[9];
    const float* w_in = a.in[10]; const float* ln_g = a.in[11]; const float* ln_b = a.in[12]; const float* gws = a.in[13]; const float* gbs = a.in[14];
    const float* wd2f = a.in[15]; const float* bdf = a.in[16]; const float* wd2b = a.in[17]; const float* bdb = a.in[18];
    const float* out_g = a.in[19]; const float* w_out = a.in[20]; const float* w_fi = a.in[21]; const float* w_fo = a.in[22];
    float* MOD = (float*)(ws + WS_MOD); bf16* WIN = (bf16*)(ws + WS_WIN); bf16* WOUT = (bf16*)(ws + WS_WOUT); bf16* WFI = (bf16*)(ws + WS_WFI); bf16* WFO = (bf16*)(ws + WS_WFO);
    float* X = (float*)(ws + WS_X); bf16* H = (bf16*)(ws + WS_H); bf16* P = (bf16*)(ws + WS_P); bf16* CAT = (bf16*)(ws + WS_CAT); float* Y = (float*)(ws + WS_Y); bf16* HID = (bf16*)(ws + WS_HID);
    float* DS = (float*)(ws + WS_DS); bf16* SP = (bf16*)(ws + WS_SP); float* DEC = (float*)(ws + WS_DEC); bf16* WSB = (bf16*)(ws + WS_WSB);

    if (IN(0)) { PHASE_IDS();
        LAS float* act = (LAS float*)(lds + 8 * 8448);
        for (int i = tid; i < 5 * D; i += 512) { const int r = i / D, k = i % D; const float v = r < NB ? c[r * D + k] : cctx[k]; act[i] = silu_acc(v); }
        __syncthreads();
        for (int item = wave * G + bid; item < NL * (NMOD / 32); item += ngw) {
            const int cg = item % (NMOD / 32), l = item / (NMOD / 32), kq = lane >> 3;
            const int j = cg * 32 + 4 * (lane & 7);
            const float* w = w_mod + ((size_t)l * D + kq) * NMOD + j;
            f32x4 a0 = {0.f, 0.f, 0.f, 0.f}, a1 = a0, a2 = a0, a3 = a0, a4 = a0;
#pragma unroll 8
            for (int i = 0; i < D / 8; ++i) { const f32x4 xv = *(const f32x4*)(w + (size_t)(8 * i) * NMOD); const int k = 8 * i + kq;
                a0 += xv * act[0 * D + k]; a1 += xv * act[1 * D + k]; a2 += xv * act[2 * D + k]; a3 += xv * act[3 * D + k]; a4 += xv * act[4 * D + k]; }
#pragma unroll
            for (int t = 0; t < 4; ++t) {
#pragma unroll
                for (int o = 8; o < 64; o <<= 1) { a0[t] += __shfl_xor(a0[t], o); a1[t] += __shfl_xor(a1[t], o); a2[t] += __shfl_xor(a2[t], o); a3[t] += __shfl_xor(a3[t], o); a4[t] += __shfl_xor(a4[t], o); } }
            if (kq == 0) { const f32x4 bb = *(const f32x4*)(b_mod + (size_t)l * NMOD + j); float* o = MOD + (size_t)l * 5 * NMOD + j;
                *(f32x4*)(o) = a0 + bb; *(f32x4*)(o + NMOD) = a1 + bb; *(f32x4*)(o + 2 * NMOD) = a2 + bb; *(f32x4*)(o + 3 * NMOD) = a3 + bb; *(f32x4*)(o + 4 * NMOD) = a4 + bb; }
        }
        for (int it = bid * 512 + tid; it < NL * 8 * CH * CH / 8; it += G * 512) { const f32x4 a0 = *(const f32x4*)(gws + (size_t)it * 8), a1 = *(const f32x4*)(gws + (size_t)it * 8 + 4);
            u32x4 o; o.x = pk2(a0[0], a0[1]); o.y = pk2(a0[2], a0[3]); o.z = pk2(a1[0], a1[1]); o.w = pk2(a1[2], a1[3]); *(u32x4*)(WSB + (size_t)it * 8) = o; }
        LAS float* scr = (LAS float*)(lds + wave * 8448);
        int it0 = 0;
        conv_matrix(w_in, WIN, D, PIN, NP, 1, it0, gw, ngw, scr, lane);
        conv_matrix(w_out, WOUT, D, D, D, 0, it0, gw, ngw, scr, lane);
        conv_matrix(w_fi, WFI, D, 2 * FF, 2 * FF, 2, it0, gw, ngw, scr, lane);
        conv_matrix(w_fo, WFO, FF, D, D, 0, it0, gw, ngw, scr, lane);
    }
    SEAM(0);
    if (IN(1)) { PHASE_IDS();
        RowArgs r{}; r.xin_x = x; r.xin_c = ctx; r.X = X; r.H = H; r.modB = MOD; r.gB = g_pre_mix; r.mode = 0; r.write_h = 1;
        for (int row = gw; row < M; row += ngw) row_pass(r, row, lane);
    }
    SEAM(1);
    run_layer<0>(a, lds, bar, tid0, G, bid, lo, hi);
    run_layer<1>(a, lds, bar, tid0, G, bid, lo, hi);
    run_layer<2>(a, lds, bar, tid0, G, bid, lo, hi);
    run_layer<3>(a, lds, bar, tid0, G, bid, lo, hi);
#undef IN
#undef SEAM
}

#ifndef MK_SPLIT
#define MK_SPLIT 0
#endif
extern "C" void kernel_launch(void* const* d_in, const int* in_sizes, int n_in, void* d_out, int out_size, void* d_ws, size_t ws_size, hipStream_t stream) {
    static int grid = 0;
    if (grid == 0) {
        if (n_in != 23 || ws_size < WS_END || out_size != MX * D) { fprintf(stderr, "kernel_launch: unexpected shapes (n_in %d, ws %zu, out %d)\n", n_in, ws_size, out_size); grid = -1; return; }
        int dev = 0, cus = 0, per_cu = 0;
        if (hipGetDevice(&dev) != hipSuccess || hipDeviceGetAttribute(&cus, hipDeviceAttributeMultiprocessorCount, dev) != hipSuccess) { grid = -1; return; }
        if (hipFuncSetAttribute((const void*)mega, hipFuncAttributeMaxDynamicSharedMemorySize, LDS_BYTES) != hipSuccess) { fprintf(stderr, "kernel_launch: hipFuncSetAttribute failed\n"); grid = -1; return; }
        if (hipOccupancyMaxActiveBlocksPerMultiprocessor(&per_cu, (const void*)mega, 512, LDS_BYTES) != hipSuccess || per_cu < 1) { fprintf(stderr, "kernel_launch: occupancy query says %d\n", per_cu); }
        (void)hipGetLastError();
        grid = cus;
    }
    if (grid < 0) return;
    (void)hipMemsetAsync((char*)d_ws + WS_CTL, 0, ZERO_BYTES, stream);
    Args a{};
    for (int i = 0; i < 23; ++i) a.in[i] = (const float*)d_in[i];
    a.out = (float*)d_out; a.ws = (unsigned char*)d_ws;
#if MK_SPLIT
    for (int p = 0; p < NPH; ++p) { a.ph_lo = p; a.ph_hi = p + 1; a.li = 0; hipLaunchKernelGGL(mega, dim3(grid), dim3(512), LDS_BYTES, stream, a); }
#else
    a.ph_lo = 0; a.ph_hi = NPH; a.li = 0;
    hipLaunchKernelGGL(mega, dim3(grid), dim3(512), LDS_BYTES, stream, a);
#endif
}
```

```cpp
#include <hip/hip_runtime.h>
#include <cstdio>
#include <cstdint>
namespace pg8 {
#define PG8_LAS __attribute__((address_space(3)))
typedef unsigned short bf16_t;
typedef short bf16x8 __attribute__((ext_vector_type(8)));
typedef float f32x4 __attribute__((ext_vector_type(4)));
typedef unsigned u32x4 __attribute__((ext_vector_type(4)));
constexpr int BM = 256, BK = 64, HALF = 128, HTB = HALF * BK * 2  , STAGE_BYTES = 8 * HTB, NXCD = 8, WGM = 8;

__host__ __device__ __forceinline__ int lds_byte(int r, int c) { const int st = (r >> 4) * 2 + (c >> 5), rr = r & 15, cc = c & 31, ob = rr * 64 + cc * 2; return st * 1024 + (ob ^ (((ob >> 9) & 1) << 5)); }
__host__ __device__ __forceinline__ void stage_rc(int b, int& R, int& C) { const int st = b / 1024, sb = b % 1024, swz = sb ^ (((sb >> 9) & 1) << 5); R = (st >> 1) * 16 + swz / 64; C = (st & 1) * 32 + (swz % 64) / 2; }
__host__ __device__ __forceinline__ int perm32(int rho) { const int n = rho >> 4, i = rho & 15; return 8 * (i >> 2) + 4 * n + (i & 3); }

struct Unit { int pm, pn; };
struct Gemm { const bf16_t* A; const bf16_t* Bt; int M, N, K, pad; };

struct StaticOrder {
    int nM, nN, nwg, G, c;
    __host__ __device__ void init(int M, int N, int G_, int c_) { nM = M / BM; nN = N / BM; nwg = nM * nN; G = G_; c = c_; }
    __host__ __device__ bool next(int i, Unit& u) const {
        const long L = (long)i * G + c; if (L >= nwg) return false;
        int wgid = (int)L; { const int q = nwg / NXCD, r = nwg % NXCD, xcd = wgid % NXCD, off = wgid / NXCD; wgid = (xcd < r ? xcd * (q + 1) : r * (q + 1) + (xcd - r) * q) + off; }
        const int nig = WGM * nN, gid = wgid / nig, fm = gid * WGM, gsz = (nM - fm) < WGM ? (nM - fm) : WGM;
        u.pm = fm + ((wgid % nig) % gsz); u.pn = (wgid % nig) / gsz; return true;
    }
    __device__ __forceinline__ void a_ready(const Unit&) const {}
    __device__ __forceinline__ void done(const Unit&) const {}
};


__device__ __forceinline__ unsigned cvt_pk_bf16(float lo, float hi) { unsigned r; asm volatile("v_cvt_pk_bf16_f32 %0, %1, %2" : "=v"(r) : "v"(lo), "v"(hi)); return r; }
__device__ __forceinline__ float fast_sigmoid(float x) { return __builtin_amdgcn_rcpf(1.0f + __builtin_amdgcn_exp2f(-1.4426950408889634f * x)); }
__device__ __forceinline__ float gelu_tanh(float x) { const float y = 1.5957691216057308f * (x + 0.044715f * x * x * x); return x * fast_sigmoid(y); }
__device__ __forceinline__ float silu_f(float x) { return x * fast_sigmoid(x); }

struct EpiF32 {
    static constexpr bool PERM = false, AFTER_DRAIN = false;
    float* C; int ldc; int pad;
    __device__ __forceinline__ void operator()(const f32x4 (&acc)[2][2][4][2], const Unit& u, int wr, int wc, int fr, int fq) const {
        const int row0 = u.pm * BM + wr * 64 + fr, col0 = u.pn * BM + wc * 32 + 4 * fq;
#pragma unroll
        for (int ai = 0; ai < 2; ++ai)
#pragma unroll
            for (int m = 0; m < 4; ++m) { float* rowp = C + (size_t)(row0 + ai * HALF + m * 16) * ldc + col0;
#pragma unroll
                for (int bj = 0; bj < 2; ++bj)
#pragma unroll
                    for (int n = 0; n < 2; ++n) *(f32x4*)(rowp + bj * HALF + n * 16) = acc[ai][bj][m][n]; }
    }
};
struct EpiProj {
    static constexpr bool PERM = true, AFTER_DRAIN = false;
    bf16_t* O; int ldc; int ngelu;
    __device__ __forceinline__ void operator()(const f32x4 (&acc)[2][2][4][2], const Unit& u, int wr, int wc, int fr, int fq) const {
        const int row0 = u.pm * BM + wr * 64 + fr, col0 = u.pn * BM + wc * 32 + 8 * fq;
        const bool act = u.pn < ngelu;
#pragma unroll
        for (int ai = 0; ai < 2; ++ai)
#pragma unroll
            for (int m = 0; m < 4; ++m) { bf16_t* rowp = O + (size_t)(row0 + ai * HALF + m * 16) * ldc + col0;
#pragma unroll
                for (int bj = 0; bj < 2; ++bj) { f32x4 v0 = acc[ai][bj][m][0], v1 = acc[ai][bj][m][1];
                    if (act) {
#pragma unroll
                        for (int j = 0; j < 4; ++j) { v0[j] = gelu_tanh(v0[j]); v1[j] = gelu_tanh(v1[j]); } }
                    u32x4 w; w.x = cvt_pk_bf16(v0[0], v0[1]); w.y = cvt_pk_bf16(v0[2], v0[3]); w.z = cvt_pk_bf16(v1[0], v1[1]); w.w = cvt_pk_bf16(v1[2], v1[3]);
                    *(u32x4*)(rowp + bj * HALF) = w; } }
    }
};
struct EpiSwiglu {
    static constexpr bool PERM = true, AFTER_DRAIN = false;
    bf16_t* O; int ldc; int pad;
    __device__ __forceinline__ void operator()(const f32x4 (&acc)[2][2][4][2], const Unit& u, int wr, int wc, int fr, int fq) const {
        const int row0 = u.pm * BM + wr * 64 + fr, col0 = u.pn * HALF + wc * 32 + 8 * fq;
#pragma unroll
        for (int ai = 0; ai < 2; ++ai)
#pragma unroll
            for (int m = 0; m < 4; ++m) { bf16_t* rowp = O + (size_t)(row0 + ai * HALF + m * 16) * ldc + col0;
                f32x4 h0, h1;
#pragma unroll
                for (int j = 0; j < 4; ++j) { h0[j] = silu_f(acc[ai][0][m][0][j]) * acc[ai][1][m][0][j]; h1[j] = silu_f(acc[ai][0][m][1][j]) * acc[ai][1][m][1][j]; }
                u32x4 w; w.x = cvt_pk_bf16(h0[0], h0[1]); w.y = cvt_pk_bf16(h0[2], h0[3]); w.z = cvt_pk_bf16(h1[0], h1[1]); w.w = cvt_pk_bf16(h1[2], h1[3]);
                *(u32x4*)rowp = w; }
    }
};

template <class Epi, class Sched, bool ALIGN_EPI = false, bool SP2 = false>
__device__ __forceinline__ void gemm_phase(PG8_LAS unsigned char* lds, const Gemm g, const Sched& S, const Epi& E) {
    int tid_o = threadIdx.x; asm volatile("" : "+v"(tid_o));
    const int tid = tid_o, wid = __builtin_amdgcn_readfirstlane(tid >> 6), lane = tid & 63, wr = wid >> 2, wc = wid & 3, fr = lane & 15, fq = lane >> 4;
    const int K = g.K, nt = K / BK;
    unsigned voffA[2], voffB[2];
#pragma unroll
    for (int i = 0; i < 2; ++i) { int R, C; stage_rc(tid * 16 + i * 8192, R, C); const int Rb = Epi::PERM ? ((R & ~31) + perm32(R & 31)) : R;
        voffA[i] = (unsigned)(R * K + C) * 2u; voffB[i] = (unsigned)(Rb * K + C) * 2u; }
    const size_t kstep = (size_t)(BK * 2);
    const size_t hstep = (size_t)HALF * K * 2;
    const size_t tstep = 2 * hstep;
    const unsigned ldsw = (unsigned)wid * 1024u;
    const int aoff = lds_byte(wr * 64 + fr, fq * 8), boff = lds_byte(wc * 32 + fr, fq * 8);
#define PG8_SA(b, h) (((b) * 2 + (h)) * HTB)
#define PG8_SB(b, h) ((4 + (b) * 2 + (h)) * HTB)
#define PG8_STAGE(bufoff, gbase, voff) do { _Pragma("unroll") for (int _i = 0; _i < 2; ++_i) \
        __builtin_amdgcn_global_load_lds((const unsigned*)((const char*)(gbase) + (voff)[_i]), (PG8_LAS unsigned*)(lds + (bufoff) + ldsw + _i * 8192), 16, 0, 0); } while (0)
#define PG8_LDA(dst, b, h) do { _Pragma("unroll") for (int m = 0; m < 4; ++m) _Pragma("unroll") for (int k = 0; k < 2; ++k) dst[m][k] = *(const PG8_LAS bf16x8*)(lds + PG8_SA(b, h) + aoff + m * 2048 + k * 1024); } while (0)
#define PG8_LDB(dst, b, h) do { _Pragma("unroll") for (int n = 0; n < 2; ++n) _Pragma("unroll") for (int k = 0; k < 2; ++k) dst[n][k] = *(const PG8_LAS bf16x8*)(lds + PG8_SB(b, h) + boff + n * 2048 + k * 1024); } while (0)
#define PG8_MMA(ai, bj, At, Bt) do { __builtin_amdgcn_s_setprio(1); _Pragma("unroll") for (int m = 0; m < 4; ++m) _Pragma("unroll") for (int n = 0; n < 2; ++n) _Pragma("unroll") for (int k = 0; k < 2; ++k) \
        acc[ai][bj][m][n] = __builtin_amdgcn_mfma_f32_16x16x32_bf16(Bt[n][k], At[m][k], acc[ai][bj][m][n], 0, 0, 0); __builtin_amdgcn_s_setprio(0); } while (0)
#define PG8_WAIT_V(n) asm volatile("s_waitcnt vmcnt(" #n ")" ::: "memory")
#define PG8_WAIT_L(n) asm volatile("s_waitcnt lgkmcnt(" #n ")" ::: "memory")
#define PG8_BAR __builtin_amdgcn_s_barrier()
#define PG8_SCHED __builtin_amdgcn_sched_barrier(0)
    Unit cur, nxt; int ui = 0;
    if (!S.next(0, cur)) return;
    f32x4 acc[2][2][4][2];
#pragma unroll
    for (int a = 0; a < 2; ++a)
#pragma unroll
        for (int b = 0; b < 2; ++b)
#pragma unroll
            for (int m = 0; m < 4; ++m)
#pragma unroll
                for (int n = 0; n < 2; ++n) acc[a][b][m][n] = (f32x4){0.f, 0.f, 0.f, 0.f};
    bf16x8 At[4][2], B0[2][2], B1[2][2];
    const char* cA = (const char*)g.A + (size_t)cur.pm * tstep; const char* cB = (const char*)g.Bt + (size_t)cur.pn * tstep;
    S.a_ready(cur);
    if constexpr (SP2) {
        PG8_STAGE(PG8_SB(0, 0), cB, voffB); PG8_STAGE(PG8_SB(0, 1), cB + hstep, voffB); PG8_STAGE(PG8_SA(0, 0), cA, voffA); PG8_STAGE(PG8_SA(0, 1), cA + hstep, voffA);
        if (wr == 1) PG8_BAR;
        PG8_WAIT_V(2); PG8_BAR;
        PG8_STAGE(PG8_SB(1, 0), cB + kstep, voffB); PG8_STAGE(PG8_SA(1, 0), cA + kstep, voffA); PG8_STAGE(PG8_SB(1, 1), cB + hstep + kstep, voffB);
        PG8_WAIT_V(6); PG8_BAR;
    } else {
        PG8_STAGE(PG8_SB(0, 0), cB, voffB); PG8_STAGE(PG8_SA(0, 0), cA, voffA); PG8_STAGE(PG8_SB(0, 1), cB + hstep, voffB); PG8_STAGE(PG8_SA(0, 1), cA + hstep, voffA);
        if (wr == 1) PG8_BAR;
        PG8_WAIT_V(4); PG8_BAR;
        PG8_STAGE(PG8_SB(1, 0), cB + kstep, voffB); PG8_STAGE(PG8_SA(1, 0), cA + kstep, voffA); PG8_STAGE(PG8_SB(1, 1), cB + hstep + kstep, voffB);
        PG8_WAIT_V(6); PG8_BAR;
    }
    for (;;) {
        const bool has_next = S.next(ui + 1, nxt);
        const char* nA = has_next ? (const char*)g.A + (size_t)nxt.pm * tstep : cA; const char* nB = has_next ? (const char*)g.Bt + (size_t)nxt.pn * tstep : cB;
        for (int t = 0; t < nt; t += 2) {
            const bool last = (t == nt - 2);
            const char* a1 = cA + (size_t)(t + 1) * kstep;
            const char* a2 = last ? nA : cA + (size_t)(t + 2) * kstep; const char* b2 = last ? nB : cB + (size_t)(t + 2) * kstep;
            const char* a3 = a2 + kstep; const char* b3 = b2 + kstep;
            if (last && has_next) S.a_ready(nxt);
            if constexpr (SP2) {
            PG8_LDB(B0, 0, 0); PG8_LDB(B1, 0, 1); PG8_SCHED; PG8_LDA(At, 0, 0); PG8_STAGE(PG8_SA(1, 1), a1 + hstep, voffA);
            PG8_WAIT_V(8); PG8_WAIT_L(0); PG8_BAR; PG8_MMA(0, 0, At, B0); PG8_MMA(0, 1, At, B1); PG8_BAR; PG8_SCHED;
            PG8_LDA(At, 0, 1); PG8_STAGE(PG8_SB(0, 0), b2, voffB); PG8_STAGE(PG8_SB(0, 1), b2 + hstep, voffB); PG8_STAGE(PG8_SA(0, 0), a2, voffA);
            PG8_WAIT_V(8); PG8_WAIT_L(0); PG8_BAR; PG8_MMA(1, 0, At, B0); PG8_MMA(1, 1, At, B1); PG8_BAR; PG8_SCHED;
            PG8_LDB(B0, 1, 0); PG8_LDB(B1, 1, 1); PG8_SCHED; PG8_LDA(At, 1, 0); PG8_STAGE(PG8_SA(0, 1), a2 + hstep, voffA);
            PG8_WAIT_V(8); PG8_WAIT_L(0); PG8_BAR; PG8_MMA(0, 0, At, B0); PG8_MMA(0, 1, At, B1); PG8_BAR; PG8_SCHED;
            PG8_LDA(At, 1, 1); PG8_STAGE(PG8_SB(1, 0), b3, voffB); PG8_STAGE(PG8_SB(1, 1), b3 + hstep, voffB); PG8_STAGE(PG8_SA(1, 0), a3, voffA);
            PG8_WAIT_V(8); PG8_WAIT_L(0); PG8_BAR; PG8_MMA(1, 0, At, B0); PG8_MMA(1, 1, At, B1); PG8_BAR; PG8_SCHED;
            } else {
            PG8_LDB(B0, 0, 0); PG8_SCHED; PG8_LDA(At, 0, 0); PG8_STAGE(PG8_SA(1, 1), a1 + hstep, voffA);
            PG8_WAIT_L(8); PG8_BAR; PG8_WAIT_L(0); PG8_MMA(0, 0, At, B0); PG8_BAR; PG8_SCHED;
            PG8_LDB(B1, 0, 1); PG8_STAGE(PG8_SB(0, 0), b2, voffB);
            PG8_BAR; PG8_WAIT_L(0); PG8_MMA(0, 1, At, B1); PG8_BAR;
            PG8_LDA(At, 0, 1); PG8_STAGE(PG8_SA(0, 0), a2, voffA);
            PG8_BAR; PG8_WAIT_L(0); PG8_MMA(1, 0, At, B0); PG8_BAR; PG8_SCHED;
            PG8_STAGE(PG8_SB(0, 1), b2 + hstep, voffB);
            PG8_WAIT_V(6); PG8_BAR; PG8_MMA(1, 1, At, B1); PG8_BAR;
            PG8_LDB(B0, 1, 0); PG8_SCHED; PG8_LDA(At, 1, 0); PG8_STAGE(PG8_SA(0, 1), a2 + hstep, voffA);
            PG8_WAIT_L(8); PG8_BAR; PG8_WAIT_L(0); PG8_MMA(0, 0, At, B0); PG8_BAR; PG8_SCHED;
            PG8_LDB(B1, 1, 1); PG8_STAGE(PG8_SB(1, 0), b3, voffB);
            PG8_BAR; PG8_WAIT_L(0); PG8_MMA(0, 1, At, B1); PG8_BAR;
            PG8_LDA(At, 1, 1); PG8_STAGE(PG8_SA(1, 0), a3, voffA);
            PG8_BAR; PG8_WAIT_L(0); PG8_MMA(1, 0, At, B0); PG8_BAR; PG8_SCHED;
            PG8_STAGE(PG8_SB(1, 1), b3 + hstep, voffB);
            PG8_WAIT_V(6); PG8_BAR; PG8_MMA(1, 1, At, B1); PG8_BAR;
            }
        }
        if constexpr (ALIGN_EPI) { if (wr == 0) PG8_BAR; }
        if constexpr (!Epi::AFTER_DRAIN) { E(acc, cur, wr, wc, fr, fq); S.done(cur); }
        if (!has_next) break;
#pragma unroll
        for (int a = 0; a < 2; ++a)
#pragma unroll
            for (int b = 0; b < 2; ++b)
#pragma unroll
                for (int m = 0; m < 4; ++m)
#pragma unroll
                    for (int n = 0; n < 2; ++n) acc[a][b][m][n] = (f32x4){0.f, 0.f, 0.f, 0.f};
        cur = nxt; cA = nA; cB = nB; ++ui;
        if constexpr (ALIGN_EPI) { if (wr == 1) PG8_BAR; }
    }
    PG8_WAIT_V(0);
    if constexpr (!ALIGN_EPI) { if (wr == 0) PG8_BAR; }
    PG8_BAR;
    if constexpr (Epi::AFTER_DRAIN) { E.fused(acc, cur, wr, wc, fr, fq, lds, wid, lane); S.done(cur); }
#undef PG8_SA
#undef PG8_SB
#undef PG8_STAGE
#undef PG8_LDA
#undef PG8_LDB
#undef PG8_MMA
#undef PG8_WAIT_V
#undef PG8_WAIT_L
#undef PG8_BAR
#undef PG8_SCHED
}
}
#define XB_TMO      128
#define XB_XCNT(j)  (256  + 64 * (j))
#define XB_XSUB(j)  (1280 + 64 * (j))
#define XB_XGEN(j)  (2304 + 64 * (j))
#define XB_TOP      3328
#define XB_TOPGEN   3392
#define XCD_BAR_WORDS 3456
#define XB_SPIN_CAP (1u << 18)
#define LAS __attribute__((address_space(3)))

__device__ __forceinline__ unsigned xb_ld(unsigned* p)              { return __hip_atomic_load(p, __ATOMIC_RELAXED, __HIP_MEMORY_SCOPE_AGENT); }
__device__ __forceinline__ unsigned xb_add(unsigned* p, unsigned v) { return __hip_atomic_fetch_add(p, v, __ATOMIC_RELAXED, __HIP_MEMORY_SCOPE_AGENT); }
__device__ __forceinline__ unsigned xb_xcc_id() { return (unsigned)__builtin_amdgcn_s_getreg((3 << 11) | 20) & 0xFu; }
#define XB_SPIN(cond, bar) do { unsigned _sp = 0; while (cond) { __builtin_amdgcn_s_sleep(1); \
    if ((++_sp & 255u) == 0u) { if (xb_ld(&(bar)[XB_TMO])) break; if (_sp > XB_SPIN_CAP) { atomicAdd(&(bar)[XB_TMO], 1u); break; } } } } while (0)

struct XcdBarrier {
    unsigned* bar; unsigned x;
    volatile LAS unsigned* st;
};

__device__ __forceinline__ XcdBarrier xcd_barrier_post(unsigned* bar, volatile LAS unsigned* st) {
    XcdBarrier b; b.bar = bar; b.x = xb_xcc_id(); b.st = st;
    if (threadIdx.x == 0) (void)xb_add(&bar[XB_XCNT(b.x)], 1u);
    return b;
}
__device__ __forceinline__ void xcd_barrier_complete(unsigned* bar, unsigned x, unsigned& nloc, unsigned& nx) {
    const unsigned G = gridDim.x * gridDim.y * gridDim.z;
    unsigned sum, cnt, mine, sp = 0u;
    for (;;) {
        sum = 0u; cnt = 0u; mine = 0u;
#pragma unroll
        for (unsigned j = 0; j < 16; ++j) { const unsigned c = xb_ld(&bar[XB_XCNT(j)]); sum += c; cnt += (c > 0u) ? 1u : 0u; mine = (j == x) ? c : mine; }
        if (sum == G) break;
        __builtin_amdgcn_s_sleep(1);
        if ((++sp & 255u) == 0u) { if (xb_ld(&bar[XB_TMO])) break; if (sp > XB_SPIN_CAP) { atomicAdd(&bar[XB_TMO], 1u); break; } }
    }
    nloc = mine > 0u ? mine : 1u; nx = cnt > 0u ? cnt : 1u;
}

__device__ __forceinline__ void xcd_barrier(const XcdBarrier& b) {
    asm volatile("s_waitcnt vmcnt(0)" ::: "memory");
    __syncthreads();
    if (threadIdx.x == 0) {
        unsigned* bar = b.bar;
        __builtin_amdgcn_s_waitcnt(0);
        unsigned nloc = b.st[0], nx = b.st[1];
        if (nloc == 0u) { xcd_barrier_complete(bar, b.x, nloc, nx); b.st[0] = nloc; b.st[1] = nx; }
        const unsigned old = xb_add(&bar[XB_XSUB(b.x)], 1u);
        const unsigned gen = old / nloc;
        if (old + 1u == (gen + 1u) * nloc) {
            __builtin_amdgcn_fence(__ATOMIC_RELEASE, "agent");
            asm volatile("s_waitcnt vmcnt(0)" ::: "memory");
            const unsigned og = xb_add(&bar[XB_TOP], 1u);
            const unsigned tg = og / nx;
            if (og + 1u == (tg + 1u) * nx) xb_add(&bar[XB_TOPGEN], 1u);
            else XB_SPIN(xb_ld(&bar[XB_TOPGEN]) == tg, bar);
            __builtin_amdgcn_fence(__ATOMIC_ACQUIRE, "agent");
            xb_add(&bar[XB_XGEN(b.x)], 1u);
            asm volatile("s_waitcnt vmcnt(0)" ::: "memory");
        } else {
            XB_SPIN(xb_ld(&bar[XB_XGEN(b.x)]) == gen, bar);
            __builtin_amdgcn_fence(__ATOMIC_ACQUIRE, "agent");
            asm volatile("s_waitcnt vmcnt(0)" ::: "memory");
        }
    }
    __syncthreads();
}

typedef unsigned short bf16;
typedef float f32x4 __attribute__((ext_vector_type(4)));
typedef unsigned u32x4 __attribute__((ext_vector_type(4)));
typedef unsigned u32x2 __attribute__((ext_vector_type(2)));
constexpr int D = 2048, NB = 4, SEQ = 4096, NL = 4, CTX = 256, CH = 128;
constexpr int MX = NB * SEQ, MC = NB * CTX, M = MX + MC;
constexpr int PIN = 5152, NP = 5376, FF = 5632, NMOD = 6 * D;
constexpr int C_U = 0, C_V = 1024, C_Q = 2048, C_K = 2560, C_VV = 3072, C_G = 4096, C_DF = 5120, C_DB = 5136;
constexpr int NCHUNK = M / CH;
constexpr float EPS = 1e-6f;
constexpr size_t MiB = 1u << 20;
constexpr size_t WS_CTL = 0, WS_MOD = 1 * MiB, ZERO_BYTES = 2 * MiB, WS_WIN = 2 * MiB, WS_WOUT = WS_WIN + 84 * MiB, WS_WFI = WS_WOUT + 32 * MiB, WS_WFO = WS_WFI + 176 * MiB,
                 WS_X = WS_WFO + 88 * MiB, WS_H = WS_X + 136 * MiB, WS_P = WS_H + 68 * MiB, WS_CAT = WS_P + 179 * MiB, WS_Y = WS_CAT + 68 * MiB, WS_HID = WS_Y + 136 * MiB,
                 WS_DS = WS_HID + 187 * MiB, WS_SP = WS_DS + 136 * MiB, WS_DEC = WS_SP + 68 * MiB, WS_WSB = WS_DEC + 1 * MiB, WS_QK = WS_WSB + 1 * MiB, WS_END = WS_QK + 68 * MiB;
static_assert((size_t)NL * NP * D * 2 <= 84 * MiB && (size_t)NL * 2 * FF * D * 2 <= 176 * MiB && (size_t)NL * D * FF * 2 <= 88 * MiB && (size_t)M * NP * 2 <= 179 * MiB && (size_t)M * FF * 2 <= 187 * MiB, "ws map");
constexpr int CW_BAR = 4096;
constexpr int LDS_BYTES = 163840, MISC_OFF = LDS_BYTES - 256;

__device__ __forceinline__ float bf2f(bf16 b) { return __uint_as_float(((unsigned)b) << 16); }
__device__ __forceinline__ unsigned f2bf(float f) { unsigned u = __float_as_uint(f); return (u + 0x7fffu + ((u >> 16) & 1u)) >> 16; }
__device__ __forceinline__ unsigned pk2(float lo, float hi) { return f2bf(lo) | (f2bf(hi) << 16); }
__device__ __forceinline__ float wave_sum(float v) {
#pragma unroll
    for (int o = 1; o < 64; o <<= 1) v += __shfl_xor(v, o);
    return v;
}
__device__ __forceinline__ float sigmoid_acc(float x) { return 1.0f / (1.0f + __expf(-x)); }
__device__ __forceinline__ float silu_acc(float x) { return x * sigmoid_acc(x); }
__device__ __forceinline__ float log_sigmoid(float z) { return fminf(z, 0.f) - log1pf(__expf(-fabsf(z))); }
__device__ __forceinline__ int mod_row(int row) { return row < MX ? row / SEQ : NB; }
#define LDS_WAIT() asm volatile("s_waitcnt lgkmcnt(0)" ::: "memory")


__device__ __forceinline__ int map_col(int mode, int r) {
    if (mode == 0) return r;
    if (mode == 1) return r < PIN ? r : -1;
    const int pn = r >> 8, rr = r & 255; return rr < 128 ? pn * 128 + rr : FF + pn * 128 + (rr - 128);
}
__device__ __forceinline__ void transpose_item(const float* W, int K, int Nsrc, bf16* T, int n0, int c0, int k0, LAS float* scr, int lane) {
    if (c0 >= 0) {
#pragma unroll 8
        for (int i = 0; i < 32; ++i) { const int kk = 2 * i + (lane >> 5); scr[kk * 33 + (lane & 31)] = W[(size_t)(k0 + kk) * Nsrc + c0 + (lane & 31)]; }
    } else {
#pragma unroll 8
        for (int i = 0; i < 32; ++i) { const int kk = 2 * i + (lane >> 5); scr[kk * 33 + (lane & 31)] = 0.f; }
    }
    LDS_WAIT(); asm volatile("" ::: "memory");
    const int c = lane & 7;
#pragma unroll
    for (int j = 0; j < 4; ++j) { const int n = (lane >> 3) + 8 * j; const LAS float* s = scr + (8 * c) * 33 + n;
        u32x4 o; o.x = pk2(s[0 * 33], s[1 * 33]); o.y = pk2(s[2 * 33], s[3 * 33]); o.z = pk2(s[4 * 33], s[5 * 33]); o.w = pk2(s[6 * 33], s[7 * 33]);
        *(u32x4*)(T + (size_t)(n0 + n) * K + k0 + 8 * c) = o; }
    LDS_WAIT(); asm volatile("" ::: "memory");
}
__device__ __forceinline__ void conv_matrix(const float* W, bf16* T, int K, int Nsrc, int Ndst, int mode, int& it0, int gw, int ngw, LAS float* scr, int lane) {
    const int nblk = Ndst / 32, per_layer = (K / 64) * nblk, total = NL * per_layer;
    int first = ((gw - it0) % ngw + ngw) % ngw;
    for (int it = first; it < total; it += ngw) {
        const int l = it / per_layer, r = it % per_layer, kb = r / nblk, nb = r % nblk;
        transpose_item(W + (size_t)l * K * Nsrc, K, Nsrc, T + (size_t)l * Ndst * K, 32 * nb, map_col(mode, 32 * nb), 64 * kb, scr, lane);
    }
    it0 += total;
}
struct RowArgs { const float* xin_x; const float* xin_c; const bf16* Y; float* X; float* out; bf16* H; const float* modA; const float* modB; const float* gA; const float* gB; int mode; int write_h; int to_out; int pad; };
__device__ __forceinline__ void row_pass(const RowArgs& a, int row, int lane) {
    const int mr = mod_row(row);
    const float* xsrc = (a.mode == 2 || a.xin_x == nullptr) ? a.X + (size_t)row * D : (row < MX ? a.xin_x + (size_t)row * D : a.xin_c + (size_t)(row - MX) * D);
    f32x4 x[8];
#pragma unroll
    for (int j = 0; j < 8; ++j) x[j] = *(const f32x4*)(xsrc + 4 * lane + 256 * j);
    if (a.mode != 0) {
        const bf16* yr = a.Y + (size_t)row * D; const float* mg = a.modA + (size_t)mr * NMOD + (a.mode == 1 ? 2 : 5) * D;
        f32x4 y[8]; float ss = 0.f;
#pragma unroll
        for (int j = 0; j < 8; ++j) { const u32x2 yw = *(const u32x2*)(yr + 4 * lane + 256 * j); y[j] = (f32x4){__uint_as_float(yw.x << 16), __uint_as_float(yw.x & 0xffff0000u), __uint_as_float(yw.y << 16), __uint_as_float(yw.y & 0xffff0000u)}; ss += (y[j][0] * y[j][0] + y[j][1] * y[j][1]) + (y[j][2] * y[j][2] + y[j][3] * y[j][3]); }
        const float rstd = rsqrtf(wave_sum(ss) * (1.f / D) + EPS);
#pragma unroll
        for (int j = 0; j < 8; ++j) { const f32x4 g = *(const f32x4*)(a.gA + 4 * lane + 256 * j), mm = *(const f32x4*)(mg + 4 * lane + 256 * j); x[j] = x[j] + mm * (y[j] * rstd * g); }
        float* dst = (a.to_out && row < MX) ? a.out + (size_t)row * D : a.X + (size_t)row * D;
        if (!(a.to_out && row >= MX)) {
#pragma unroll
            for (int j = 0; j < 8; ++j) *(f32x4*)(dst + 4 * lane + 256 * j) = x[j]; }
    }
    if (a.write_h) {
        float ss = 0.f;
#pragma unroll
        for (int j = 0; j < 8; ++j) ss += (x[j][0] * x[j][0] + x[j][1] * x[j][1]) + (x[j][2] * x[j][2] + x[j][3] * x[j][3]);
        const float rstd = rsqrtf(wave_sum(ss) * (1.f / D) + EPS);
        const float* msh = (a.mode == 1 ? a.modA + (size_t)mr * NMOD + 3 * D : a.modB + (size_t)mr * NMOD);
        const float* msc = msh + D;
        bf16* hr = a.H + (size_t)row * D;
#pragma unroll
        for (int j = 0; j < 8; ++j) { const f32x4 g = *(const f32x4*)(a.gB + 4 * lane + 256 * j), sh = *(const f32x4*)(msh + 4 * lane + 256 * j), sc = *(const f32x4*)(msc + 4 * lane + 256 * j);
            const f32x4 h = (x[j] * rstd * g) * (sc + 1.0f) + sh; u32x2 w; w.x = pk2(h[0], h[1]); w.y = pk2(h[2], h[3]); *(u32x2*)(hr + 4 * lane + 256 * j) = w; }
    }
}

__device__ __forceinline__ void gmlp_unit_simple(const bf16* P, bf16* CAT, const float* ln_g, const float* ln_b, const float* ws, const float* bs, int cid, int h, LAS float* vln, int tid) {
    { const int j = tid >> 2, qd = tid & 3; const bf16* vp = P + (size_t)(cid * CH + j) * NP + C_V + h * 128 + qd * 32;
      float v[32]; float s = 0.f;
#pragma unroll
      for (int i = 0; i < 4; ++i) { const u32x4 w = *(const u32x4*)(vp + 8 * i);
#pragma unroll
          for (int e = 0; e < 4; ++e) { v[8 * i + 2 * e] = __uint_as_float(w[e] << 16); v[8 * i + 2 * e + 1] = __uint_as_float(w[e] & 0xffff0000u); } }
#pragma unroll
      for (int i = 0; i < 32; ++i) s += v[i];
      s += __shfl_xor(s, 1); s += __shfl_xor(s, 2); const float mu = s * (1.f / 128.f); float q = 0.f;
#pragma unroll
      for (int i = 0; i < 32; ++i) { v[i] -= mu; q += v[i] * v[i]; }
      q += __shfl_xor(q, 1); q += __shfl_xor(q, 2); const float rstd = rsqrtf(q * (1.f / 128.f) + EPS);
#pragma unroll
      for (int i = 0; i < 32; ++i) { const int d = qd * 32 + i; vln[j * CH + d] = v[i] * rstd * ln_g[h * 128 + d] + ln_b[h * 128 + d]; } }
    __syncthreads();
    const int d = tid & 127, ig = __builtin_amdgcn_readfirstlane(tid >> 7);
    for (int ii = 0; ii < 32; ++ii) { const int i = ig * 32 + ii; const float* wr = ws + ((size_t)h * CH + i) * CH; float acc = 0.f;
#pragma unroll 16
        for (int j = 0; j < CH; ++j) acc += wr[j] * vln[j * CH + d];
        const size_t row = (size_t)cid * CH + i; const float u = bf2f(P[row * NP + C_U + h * 128 + d]);
        CAT[row * D + h * 128 + d] = (bf16)f2bf(u * (acc + bs[h * CH + i])); }
    __syncthreads();
}


typedef short bf16x8 __attribute__((ext_vector_type(8)));
typedef short s16x4 __attribute__((ext_vector_type(4)));
typedef short v4i16_t __attribute__((ext_vector_type(4)));
constexpr int PQ = 288, PV = 544;
constexpr int L_QT = 0, L_KT = 36864, L_ST = 0, L_V = 73728, L_DF = 143360, L_TOT = 151552;
__device__ __forceinline__ s16x4 tr_read(const LAS unsigned char* p) { return __builtin_bit_cast(s16x4, __builtin_amdgcn_ds_read_tr16_b64_v4i16((LAS v4i16_t*)p)); }
__device__ __forceinline__ bf16x8 cat8(s16x4 lo, s16x4 hi) { return (bf16x8){lo[0], lo[1], lo[2], lo[3], hi[0], hi[1], hi[2], hi[3]}; }
__device__ __forceinline__ float logsig_fast(float z) { return fminf(z, 0.f) - __logf(1.0f + __expf(-fabsf(z))); }
__device__ __forceinline__ f32x4 mfma16(bf16x8 a, bf16x8 b, f32x4 c) { return __builtin_amdgcn_mfma_f32_16x16x32_bf16(a, b, c, 0, 0, 0); }

__device__ __forceinline__ void v_tile_issue(const bf16* P, int cid, int h, u32x4 (&vr)[8], int tid) {
#pragma unroll
    for (int i = 0; i < 8; ++i) { const int idx = tid + 512 * i, row = idx >> 5, ch = idx & 31; vr[i] = *(const u32x4*)(P + (size_t)(cid * CH + row) * NP + C_VV + h * 256 + ch * 8); }
}
__device__ __forceinline__ void v_tile_park(const u32x4 (&vr)[8], LAS unsigned char* V, int tid) {
#pragma unroll
    for (int i = 0; i < 8; ++i) { const int idx = tid + 512 * i, row = idx >> 5, ch = idx & 31; *(LAS u32x4*)(V + row * PV + ch * 16) = vr[i]; }
}
__device__ __forceinline__ void gla_prep(const bf16* P, const float* wd2, const float* bd, float* dec_out, int cid, int h, int dir, LAS unsigned char* lds, int tid) {
    LAS float* DF = (LAS float*)(lds + L_DF); LAS float* TOT = (LAS float*)(lds + L_TOT);
    LAS bf16* QT = (LAS bf16*)(lds + L_QT); LAS bf16* KT = (LAS bf16*)(lds + L_KT);
    asm volatile("" : "+v"(tid));
    const int d = tid & 127, seg = tid >> 7;
    u32x4 rk[4], rq[4];
#pragma unroll
    for (int i = 0; i < 4; ++i) { const int idx = tid + 512 * i, row = idx >> 4, ch = idx & 15; const bf16* pr = P + (size_t)(cid * CH + row) * NP + h * 128 + ch * 8;
        rk[i] = *(const u32x4*)(pr + C_K); rq[i] = *(const u32x4*)(pr + C_Q); }
    { const int j = tid >> 2, r0 = (tid & 3) * 4; const u32x2 w = *(const u32x2*)(P + (size_t)(cid * CH + j) * NP + (dir ? C_DB : C_DF) + r0);
      const f32x4 f = {__uint_as_float(w.x << 16), __uint_as_float(w.x & 0xffff0000u), __uint_as_float(w.y << 16), __uint_as_float(w.y & 0xffff0000u)}; *(LAS f32x4*)(DF + j * 16 + r0) = f; }
    float wd[16];
#pragma unroll
    for (int r = 0; r < 16; ++r) wd[r] = wd2[r * 512 + h * 128 + d];
    const float bdv = bd[h * 128 + d];
    __syncthreads();
    float bl[32]; float run = 0.f;
#pragma unroll
    for (int jj = 0; jj < 32; ++jj) { const int pos = 32 * seg + jj, j = dir ? 127 - pos : pos; const LAS f32x4* dfp = (const LAS f32x4*)(DF + j * 16);
        const f32x4 a = dfp[0], b = dfp[1], c = dfp[2], e = dfp[3];
        float z = bdv;
        z += a[0] * wd[0]; z += a[1] * wd[1]; z += a[2] * wd[2]; z += a[3] * wd[3]; z += b[0] * wd[4]; z += b[1] * wd[5]; z += b[2] * wd[6]; z += b[3] * wd[7];
        z += c[0] * wd[8]; z += c[1] * wd[9]; z += c[2] * wd[10]; z += c[3] * wd[11]; z += e[0] * wd[12]; z += e[1] * wd[13]; z += e[2] * wd[14]; z += e[3] * wd[15];
        run += logsig_fast(z) * (1.f / 16.f); bl[jj] = run; }
    TOT[seg * 128 + d] = run;
#pragma unroll
    for (int i = 0; i < 4; ++i) { const int idx = tid + 512 * i, row = idx >> 4, ch = idx & 15;
        *(LAS u32x4*)((LAS unsigned char*)KT + row * PQ + ch * 16) = rk[i]; *(LAS u32x4*)((LAS unsigned char*)QT + row * PQ + ch * 16) = rq[i]; }
    __syncthreads();
    float off = 0.f, tot = 0.f;
#pragma unroll
    for (int s = 0; s < 4; ++s) { const float t = TOT[s * 128 + d]; tot += t; off += (s < seg) ? t : 0.f; }
    if (seg == 0) { const float dc = __expf(tot); dec_out[d] = dc; DF[d] = dc; }
#pragma unroll
    for (int jj = 0; jj < 32; ++jj) { const int pos = 32 * seg + jj, j = dir ? 127 - pos : pos; const float b = bl[jj] + off;
        const float k = bf2f(KT[j * (PQ / 2) + d]), q = bf2f(QT[j * (PQ / 2) + d]), eb = __expf(b);
        QT[j * (PQ / 2) + d] = (bf16)f2bf(q * 0.08838834764831845f * eb); KT[j * (PQ / 2) + d] = (bf16)f2bf(k * __builtin_amdgcn_rcpf(eb)); }
}
__device__ __forceinline__ void gla_g1_unit(const bf16* P, const float* wd2, const float* bd, bf16* DS, float* DEC, bf16* QKG, int cid, int h, int dir, LAS unsigned char* lds, int tid, int lane, int wave) {
    const int unit = (cid * 4 + h) * 2 + dir;
    asm volatile("" : "+v"(tid));
    u32x4 vr[8]; v_tile_issue(P, cid, h, vr, tid);
    gla_prep(P, wd2, bd, DEC + (size_t)unit * 128, cid, h, dir, lds, tid);
    v_tile_park(vr, lds + L_V, tid);
    __syncthreads();
    int t2 = tid; asm volatile("" : "+v"(t2)); (void)lane;
    const int wdb = wave >> 1, we = wave & 1, g = (t2 >> 4) & 3, li = t2 & 15, q = li >> 2, p = li & 3;
    const LAS unsigned char* QT = lds + L_QT; const LAS unsigned char* KT = lds + L_KT; const LAS unsigned char* V = lds + L_V;
    { bf16* dst = QKG + (size_t)unit * 32768;
#pragma unroll
      for (int i = 0; i < 4; ++i) { const int idx = t2 + 512 * i, row = idx >> 4, ch = idx & 15;
          *(u32x4*)(dst + row * 128 + ch * 8) = *(const LAS u32x4*)(QT + row * PQ + ch * 16); *(u32x4*)(dst + 16384 + row * 128 + ch * 8) = *(const LAS u32x4*)(KT + row * PQ + ch * 16); } }
    f32x4 acc[2][8];
#pragma unroll
    for (int dt = 0; dt < 2; ++dt)
#pragma unroll
        for (int et = 0; et < 8; ++et) acc[dt][et] = (f32x4){0.f, 0.f, 0.f, 0.f};
#pragma unroll
    for (int ks = 0; ks < 4; ++ks) { const int row = 32 * ks + 8 * g + q;
        bf16x8 X[2], Y[8];
#pragma unroll
        for (int dt = 0; dt < 2; ++dt) X[dt] = cat8(tr_read(KT + row * PQ + (32 * wdb + 16 * dt + 4 * p) * 2), tr_read(KT + (row + 4) * PQ + (32 * wdb + 16 * dt + 4 * p) * 2));
#pragma unroll
        for (int et = 0; et < 8; ++et) Y[et] = cat8(tr_read(V + row * PV + (128 * we + 16 * et + 4 * p) * 2), tr_read(V + (row + 4) * PV + (128 * we + 16 * et + 4 * p) * 2));
#pragma unroll
        for (int et = 0; et < 8; ++et) { acc[0][et] = mfma16(X[0], Y[et], acc[0][et]); acc[1][et] = mfma16(X[1], Y[et], acc[1][et]); } }
    const LAS float* DECL = (const LAS float*)(lds + L_DF);
#pragma unroll
    for (int dt = 0; dt < 2; ++dt) { const int d0 = 32 * wdb + 16 * dt + 4 * g; const f32x4 dc = *(const LAS f32x4*)(DECL + d0);
#pragma unroll
        for (int et = 0; et < 8; ++et) { const int e = 128 * we + 16 * et + li; const f32x4 v = acc[dt][et] * dc; u32x2 w; w.x = pg8::cvt_pk_bf16(v[0], v[1]); w.y = pg8::cvt_pk_bf16(v[2], v[3]); *(u32x2*)(DS + ((size_t)unit * 256 + e) * 128 + d0) = w; } }
    __syncthreads();
}
__device__ __forceinline__ int gla_chain_cid(int s, int b, int dir) { return dir ? (s < 2 ? 128 + 2 * b + (1 - s) : 32 * b + 31 - (s - 2)) : (s < 2 ? 128 + 2 * b + s : 32 * b + (s - 2)); }
__device__ __forceinline__ void gla_g2_item(const bf16* DS, const float* DEC, bf16* SP, int item) {
    const int chain = item >> 13, ed = item & 8191, b = chain >> 3, h = (chain >> 1) & 3, dir = chain & 1, e = ed >> 5, d0 = (ed & 31) * 4;
    f32x4 S = {0.f, 0.f, 0.f, 0.f};
#pragma unroll 2
    for (int s = 0; s < 34; ++s) { const int cid = gla_chain_cid(s, b, dir), unit = (cid * 4 + h) * 2 + dir; const size_t off = ((size_t)unit * 256 + e) * 128 + d0;
        const f32x4 dec = *(const f32x4*)(DEC + (size_t)unit * 128 + d0); const u32x2 dw = *(const u32x2*)(DS + off);
        const f32x4 ds = {__uint_as_float(dw.x << 16), __uint_as_float(dw.x & 0xffff0000u), __uint_as_float(dw.y << 16), __uint_as_float(dw.y & 0xffff0000u)};
        u32x2 w; w.x = pk2(S[0], S[1]); w.y = pk2(S[2], S[3]); *(u32x2*)(SP + off) = w;
        S = dec * S + ds; }
}
__device__ __forceinline__ void qk_issue(const bf16* QKG, int unit, u32x4 (&r)[8], int tid) {
#pragma unroll
    for (int i = 0; i < 8; ++i) r[i] = *(const u32x4*)(QKG + (size_t)unit * 32768 + (size_t)(tid + 512 * i) * 8);
}
__device__ __forceinline__ void qk_park(const u32x4 (&r)[8], LAS unsigned char* lds, int tid) {
#pragma unroll
    for (int i = 0; i < 8; ++i) { const int idx = tid + 512 * i; *(LAS u32x4*)(lds + L_QT + (idx >> 4) * PQ + (idx & 15) * 16) = r[i]; }
}
__device__ __forceinline__ void gla_g3_unit(const bf16* P, const bf16* QKG, const bf16* SP, const float* out_g, bf16* CAT, int cid, int h, LAS unsigned char* lds, int tid, int lane, int wave) {
    asm volatile("" : "+v"(tid));
    const int w = wave; (void)lane;
    const LAS unsigned char* QT = lds + L_QT; const LAS unsigned char* KT = lds + L_KT; LAS unsigned char* ST = lds + L_ST; const LAS unsigned char* V = lds + L_V;
    static_assert(L_KT == L_QT + 128 * PQ, "q~ and k~ tiles are adjacent");
    { u32x4 vr[8], qk[8]; v_tile_issue(P, cid, h, vr, tid); qk_issue(QKG, (cid * 4 + h) * 2, qk, tid); v_tile_park(vr, lds + L_V, tid); qk_park(qk, lds, tid); }
    __syncthreads();
    f32x4 o[16];
#pragma unroll
    for (int et = 0; et < 16; ++et) o[et] = (f32x4){0.f, 0.f, 0.f, 0.f};
    u32x4 qk1[8];
#pragma unroll
    for (int dir = 0; dir < 2; ++dir) {
        const int unit = (cid * 4 + h) * 2 + dir;
        int t2 = tid; asm volatile("" : "+v"(t2));
        const int g = (t2 >> 4) & 3, li = t2 & 15, q = li >> 2, p = li & 3;
        u32x4 sp[8];
#pragma unroll
        for (int i = 0; i < 8; ++i) sp[i] = *(const u32x4*)(SP + (size_t)unit * 32768 + (size_t)(tid + 512 * i) * 8);
        bf16x8 Yq[4];
#pragma unroll
        for (int ks = 0; ks < 4; ++ks) Yq[ks] = *(const LAS bf16x8*)(QT + (16 * w + li) * PQ + (32 * ks + 8 * g) * 2);
        bf16x8 Pf[4];
#pragma unroll
        for (int kp = 0; kp < 4; ++kp) {
            f32x4 s0 = {0.f, 0.f, 0.f, 0.f}, s1 = {0.f, 0.f, 0.f, 0.f};
            const int t0 = 2 * kp, t1 = 2 * kp + 1;
            const bool a0 = dir ? (t0 >= w) : (t0 <= w), a1 = dir ? (t1 >= w) : (t1 <= w);
            if (a0 && a1) {
                bf16x8 K0[4], K1[4];
#pragma unroll
                for (int ks = 0; ks < 4; ++ks) { K0[ks] = *(const LAS bf16x8*)(KT + (16 * t0 + li) * PQ + (32 * ks + 8 * g) * 2); K1[ks] = *(const LAS bf16x8*)(KT + (16 * t1 + li) * PQ + (32 * ks + 8 * g) * 2); }
#pragma unroll
                for (int ks = 0; ks < 4; ++ks) { s0 = mfma16(K0[ks], Yq[ks], s0); s1 = mfma16(K1[ks], Yq[ks], s1); }
            } else if (a0) {
                bf16x8 K0[4];
#pragma unroll
                for (int ks = 0; ks < 4; ++ks) K0[ks] = *(const LAS bf16x8*)(KT + (16 * t0 + li) * PQ + (32 * ks + 8 * g) * 2);
#pragma unroll
                for (int ks = 0; ks < 4; ++ks) s0 = mfma16(K0[ks], Yq[ks], s0);
            } else if (a1) {
                bf16x8 K1[4];
#pragma unroll
                for (int ks = 0; ks < 4; ++ks) K1[ks] = *(const LAS bf16x8*)(KT + (16 * t1 + li) * PQ + (32 * ks + 8 * g) * 2);
#pragma unroll
                for (int ks = 0; ks < 4; ++ks) s1 = mfma16(K1[ks], Yq[ks], s1);
            }
            if (t0 == w) {
#pragma unroll
                for (int r = 0; r < 4; ++r) { const bool keep = dir ? (4 * g + r >= li) : (4 * g + r <= li); s0[r] = keep ? s0[r] : 0.f; } }
            if (t1 == w) {
#pragma unroll
                for (int r = 0; r < 4; ++r) { const bool keep = dir ? (4 * g + r >= li) : (4 * g + r <= li); s1[r] = keep ? s1[r] : 0.f; } }
            u32x4 pw; pw.x = pg8::cvt_pk_bf16(s0[0], s0[1]); pw.y = pg8::cvt_pk_bf16(s0[2], s0[3]); pw.z = pg8::cvt_pk_bf16(s1[0], s1[1]); pw.w = pg8::cvt_pk_bf16(s1[2], s1[3]);
            Pf[kp] = __builtin_bit_cast(bf16x8, pw);
        }
#pragma unroll
        for (int kp = 0; kp < 4; ++kp) {
            const bool act = dir ? (2 * kp + 1 >= w) : (2 * kp <= w);
            if (act) {
#pragma unroll
                for (int hf = 0; hf < 2; ++hf) {
                    bf16x8 Xv[8];
#pragma unroll
                    for (int i = 0; i < 8; ++i) { const int et = 8 * hf + i; Xv[i] = cat8(tr_read(V + (32 * kp + 4 * g + q) * PV + (16 * et + 4 * p) * 2), tr_read(V + (32 * kp + 16 + 4 * g + q) * PV + (16 * et + 4 * p) * 2)); }
#pragma unroll
                    for (int i = 0; i < 8; ++i) o[8 * hf + i] = mfma16(Xv[i], Pf[kp], o[8 * hf + i]);
                }
            }
        }
        __syncthreads();
#pragma unroll
        for (int i = 0; i < 8; ++i) { const int idx = tid + 512 * i; *(LAS u32x4*)(ST + (idx >> 4) * PQ + (idx & 15) * 16) = sp[i]; }
        if (dir == 0) qk_issue(QKG, unit + 1, qk1, tid);
        __syncthreads();
#pragma unroll
        for (int ks = 0; ks < 4; ++ks)
#pragma unroll
            for (int hf = 0; hf < 2; ++hf) {
                bf16x8 Xs[8];
#pragma unroll
                for (int i = 0; i < 8; ++i) Xs[i] = *(const LAS bf16x8*)(ST + (16 * (8 * hf + i) + li) * PQ + (32 * ks + 8 * g) * 2);
#pragma unroll
                for (int i = 0; i < 8; ++i) o[8 * hf + i] = mfma16(Xs[i], Yq[ks], o[8 * hf + i]);
            }
        __syncthreads();
        if (dir == 0) { qk_park(qk1, lds, tid); __syncthreads(); }
    }
    int t3 = tid; asm volatile("" : "+v"(t3));
    const int g = (t3 >> 4) & 3, li = t3 & 15;
    float ss = 0.f;
#pragma unroll
    for (int et = 0; et < 16; ++et) ss += (o[et][0] * o[et][0] + o[et][1] * o[et][1]) + (o[et][2] * o[et][2] + o[et][3] * o[et][3]);
    ss += __shfl_xor(ss, 16); ss += __shfl_xor(ss, 32);
    const float rstd = rsqrtf(ss * (1.f / 256.f) + EPS);
    const size_t row = (size_t)cid * CH + 16 * w + li;
#pragma unroll
    for (int et = 0; et < 16; ++et) { const int e0 = h * 256 + 16 * et + 4 * g; const f32x4 gg = *(const f32x4*)(out_g + e0); const u32x2 gw = *(const u32x2*)(P + row * NP + C_G + e0);
        const float g0 = __uint_as_float(gw.x << 16), g1 = __uint_as_float(gw.x & 0xffff0000u), g2 = __uint_as_float(gw.y << 16), g3 = __uint_as_float(gw.y & 0xffff0000u);
        u32x2 ow; ow.x = pk2(o[et][0] * rstd * gg[0] * silu_acc(g0), o[et][1] * rstd * gg[1] * silu_acc(g1)); ow.y = pk2(o[et][2] * rstd * gg[2] * silu_acc(g2), o[et][3] * rstd * gg[3] * silu_acc(g3));
        *(u32x2*)(CAT + row * D + 1024 + e0) = ow; }
}

__device__ __forceinline__ void gmlp_unit_fast(const bf16* P, bf16* CAT, const float* ln_g, const float* ln_b, const bf16* WSB, const float* bs, int cid, int h, LAS unsigned char* lds, int tid, int wave) {
    asm volatile("" : "+v"(tid));
    LAS unsigned char* VL = lds;
    const int g = (tid >> 4) & 3, li = tid & 15, q = li >> 2, p = li & 3, w = wave;
    const size_t row = (size_t)cid * CH + 16 * w + li;
    bf16x8 Yw[4]; u32x2 uw[8];
#pragma unroll
    for (int ks = 0; ks < 4; ++ks) Yw[ks] = *(const bf16x8*)(WSB + ((size_t)(h * CH + 16 * w + li)) * CH + 32 * ks + 8 * g);
#pragma unroll
    for (int dt = 0; dt < 8; ++dt) uw[dt] = *(const u32x2*)(P + row * NP + C_U + h * 128 + 16 * dt + 4 * g);
    const float bsv = bs[h * CH + 16 * w + li];
    { const int j = tid >> 2, qd = tid & 3; const bf16* vp = P + (size_t)(cid * CH + j) * NP + C_V + h * 128 + qd * 32;
      float v[32]; float s = 0.f;
#pragma unroll
      for (int i = 0; i < 4; ++i) { const u32x4 w = *(const u32x4*)(vp + 8 * i);
#pragma unroll
          for (int e = 0; e < 4; ++e) { v[8 * i + 2 * e] = __uint_as_float(w[e] << 16); v[8 * i + 2 * e + 1] = __uint_as_float(w[e] & 0xffff0000u); } }
#pragma unroll
      for (int i = 0; i < 32; ++i) s += v[i];
      s += __shfl_xor(s, 1); s += __shfl_xor(s, 2); const float mu = s * (1.f / 128.f); float q = 0.f;
#pragma unroll
      for (int i = 0; i < 32; ++i) { v[i] -= mu; q += v[i] * v[i]; }
      q += __shfl_xor(q, 1); q += __shfl_xor(q, 2); const float rstd = rsqrtf(q * (1.f / 128.f) + EPS);
      const float* gp = ln_g + h * 128 + qd * 32; const float* bp = ln_b + h * 128 + qd * 32;
#pragma unroll
      for (int i = 0; i < 4; ++i) { const f32x4 g0 = *(const f32x4*)(gp + 8 * i), g1 = *(const f32x4*)(gp + 8 * i + 4), b0 = *(const f32x4*)(bp + 8 * i), b1 = *(const f32x4*)(bp + 8 * i + 4);
          u32x4 o; o.x = pk2(v[8 * i + 0] * rstd * g0[0] + b0[0], v[8 * i + 1] * rstd * g0[1] + b0[1]); o.y = pk2(v[8 * i + 2] * rstd * g0[2] + b0[2], v[8 * i + 3] * rstd * g0[3] + b0[3]);
          o.z = pk2(v[8 * i + 4] * rstd * g1[0] + b1[0], v[8 * i + 5] * rstd * g1[1] + b1[1]); o.w = pk2(v[8 * i + 6] * rstd * g1[2] + b1[2], v[8 * i + 7] * rstd * g1[3] + b1[3]);
          *(LAS u32x4*)(VL + j * PQ + (qd * 32 + 8 * i) * 2) = o; } }
    __syncthreads();
    f32x4 acc[8];
#pragma unroll
    for (int dt = 0; dt < 8; ++dt) acc[dt] = (f32x4){0.f, 0.f, 0.f, 0.f};
#pragma unroll
    for (int ks = 0; ks < 4; ++ks) {
        bf16x8 X[8];
#pragma unroll
        for (int dt = 0; dt < 8; ++dt) X[dt] = cat8(tr_read(VL + (32 * ks + 8 * g + q) * PQ + (16 * dt + 4 * p) * 2), tr_read(VL + (32 * ks + 8 * g + q + 4) * PQ + (16 * dt + 4 * p) * 2));
#pragma unroll
        for (int dt = 0; dt < 8; ++dt) acc[dt] = mfma16(X[dt], Yw[ks], acc[dt]);
    }
#pragma unroll
    for (int dt = 0; dt < 8; ++dt) { const int c0 = h * 128 + 16 * dt + 4 * g;
        const float u0 = __uint_as_float(uw[dt].x << 16), u1 = __uint_as_float(uw[dt].x & 0xffff0000u), u2 = __uint_as_float(uw[dt].y << 16), u3 = __uint_as_float(uw[dt].y & 0xffff0000u);
        u32x2 ow; ow.x = pk2(u0 * (acc[dt][0] + bsv), u1 * (acc[dt][1] + bsv)); ow.y = pk2(u2 * (acc[dt][2] + bsv), u3 * (acc[dt][3] + bsv));
        *(u32x2*)(CAT + row * D + c0) = ow; }
    __syncthreads();
}

constexpr int NPH = 2 + 9 * NL;
struct Args { const float* in[23]; float* out; unsigned char* ws; int ph_lo, ph_hi, li, pad; };

#ifndef DUP_MASK
#define DUP_MASK 0
#endif
#define REP(bit) for (int rep_ = 0; rep_ < (((DUP_MASK) >> (bit)) & 1) + 1; ++rep_)
#define IN(k) (lo <= (k) && (k) < hi)
#define PHASE_IDS() int tid = tid0; asm volatile("" : "+v"(tid)); const int lane = tid & 63, wave = __builtin_amdgcn_readfirstlane(tid >> 6), gw = bid * 8 + wave, ngw = G * 8; (void)lane; (void)gw; (void)ngw
#define SEAM(k) do { if (IN(k) && IN((k) + 1)) xcd_barrier(bar); } while (0)
template <int l> __device__ __forceinline__ void run_layer(const Args& a, LAS unsigned char* lds, const XcdBarrier& bar, int tid0, int G, int bid, int lo, int hi) {
    unsigned char* ws = a.ws;
    const float* x = a.in[0]; const float* ctx = a.in[2];
    const float* g_pre_mix = a.in[6]; const float* g_post_mix = a.in[7]; const float* g_pre_ffn = a.in[8]; const float* g_post_ffn = a.in[9];
    const float* ln_g = a.in[11]; const float* ln_b = a.in[12]; const float* gws = a.in[13]; const float* gbs = a.in[14];
    const float* wd2f = a.in[15]; const float* bdf = a.in[16]; const float* wd2b = a.in[17]; const float* bdb = a.in[18];
    const float* out_g = a.in[19];
    float* MOD = (float*)(ws + WS_MOD); bf16* WIN = (bf16*)(ws + WS_WIN); bf16* WOUT = (bf16*)(ws + WS_WOUT); bf16* WFI = (bf16*)(ws + WS_WFI); bf16* WFO = (bf16*)(ws + WS_WFO);
    float* X = (float*)(ws + WS_X); bf16* H = (bf16*)(ws + WS_H); bf16* P = (bf16*)(ws + WS_P); bf16* CAT = (bf16*)(ws + WS_CAT); bf16* Y = (bf16*)(ws + WS_Y); bf16* HID = (bf16*)(ws + WS_HID);
    bf16* DS = (bf16*)(ws + WS_DS); bf16* SP = (bf16*)(ws + WS_SP); float* DEC = (float*)(ws + WS_DEC); bf16* WSB = (bf16*)(ws + WS_WSB); bf16* QKG = (bf16*)(ws + WS_QK);
        const int pb = 2 + 9 * l;
        const float* modl = MOD + (size_t)l * 5 * NMOD;
        if (IN(pb + 0)) REP(1) { pg8::Gemm g{H, WIN + (size_t)l * NP * D, M, NP, D}; pg8::StaticOrder S; S.init(M, NP, G, bid); pg8::EpiProj E{P, NP, 8};
            pg8::gemm_phase<pg8::EpiProj, pg8::StaticOrder, true, true>(lds, g, S, E); }
        SEAM(pb + 0);
        if (IN(pb + 1)) REP(2) { PHASE_IDS();
            for (int u = bid; u < NCHUNK * 8; u += G)
                gmlp_unit_fast(P, CAT, ln_g + l * 1024, ln_b + l * 1024, WSB + (size_t)l * 8 * CH * CH, gbs + l * 8 * CH, u >> 3, u & 7, lds, tid, wave);
            for (int u = bid; u < NCHUNK * 8; u += G) { const int dir = u & 1, h = (u >> 1) & 3, cid = u >> 3;
                gla_g1_unit(P, (dir ? wd2b : wd2f) + l * 16 * 512, (dir ? bdb : bdf) + l * 512, DS, DEC, QKG, cid, h, dir, lds, tid, lane, wave); }
        }
        SEAM(pb + 1);
        if (IN(pb + 2)) REP(3) { PHASE_IDS();
            for (int it = bid * 512 + tid; it < 32 * 8192; it += G * 512) gla_g2_item(DS, DEC, SP, it);
        }
        SEAM(pb + 2);
        if (IN(pb + 3)) REP(4) { PHASE_IDS();
            for (int u = bid; u < NCHUNK * 4; u += G)
                gla_g3_unit(P, QKG, SP, out_g + l * 1024, CAT, u >> 2, u & 3, lds, tid, lane, wave);
        }
        SEAM(pb + 3);
        if (IN(pb + 4)) REP(5) { pg8::Gemm g{CAT, WOUT + (size_t)l * D * D, M, D, D}; pg8::StaticOrder S; S.init(M, D, G, bid); pg8::EpiProj E{Y, D, 0};
            pg8::gemm_phase<pg8::EpiProj, pg8::StaticOrder, true, true>(lds, g, S, E); }
        SEAM(pb + 4);
        if (IN(pb + 5)) { PHASE_IDS();
            RowArgs r{}; r.xin_x = l == 0 ? x : nullptr; r.xin_c = l == 0 ? ctx : nullptr; r.Y = Y; r.X = X; r.H = H; r.modA = modl; r.gA = g_post_mix + l * D; r.gB = g_pre_ffn + l * D; r.mode = 1; r.write_h = 1;
            for (int row = gw; row < M; row += ngw) row_pass(r, row, lane);
        }
        SEAM(pb + 5);
        if (IN(pb + 6)) REP(6) { pg8::Gemm g{H, WFI + (size_t)l * 2 * FF * D, M, 2 * FF, D}; pg8::StaticOrder S; S.init(M, 2 * FF, G, bid); pg8::EpiSwiglu E{HID, FF};
            pg8::gemm_phase<pg8::EpiSwiglu, pg8::StaticOrder, true, true>(lds, g, S, E); }
        SEAM(pb + 6);
        if (IN(pb + 7)) REP(7) { pg8::Gemm g{HID, WFO + (size_t)l * D * FF, M, D, FF}; pg8::StaticOrder S; S.init(M, D, G, bid); pg8::EpiProj E{Y, D, 0};
            pg8::gemm_phase<pg8::EpiProj, pg8::StaticOrder, true, true>(lds, g, S, E); }
        SEAM(pb + 7);
        if (IN(pb + 8)) { PHASE_IDS();
            RowArgs r{}; r.Y = Y; r.X = X; r.out = a.out; r.H = H; r.modA = modl; r.modB = modl + 5 * NMOD; r.gA = g_post_ffn + l * D; r.gB = g_pre_mix + (l + 1 < NL ? l + 1 : l) * D; r.mode = 2; r.write_h = (l + 1 < NL); r.to_out = (l + 1 == NL);
            for (int row = gw; row < M; row += ngw) row_pass(r, row, lane);
        }
        SEAM(pb + 8);
}
__global__ void __launch_bounds__(512, 2) mega(Args a) {
    extern __shared__ __attribute__((aligned(16))) unsigned char lds_raw[];
    LAS unsigned char* lds = (LAS unsigned char*)lds_raw;
    const int tid0 = threadIdx.x;
    const int G = gridDim.x, bid = blockIdx.x;
    volatile LAS unsigned* MISC = (volatile LAS unsigned*)(lds + MISC_OFF);
    if (tid0 < 32) MISC[tid0] = 0u;
    __syncthreads();
    unsigned char* ws = a.ws;
    const int lo = a.ph_lo, hi = a.ph_hi;
    XcdBarrier bar; bar.bar = (unsigned*)(ws + WS_CTL) + CW_BAR + a.li * XCD_BAR_WORDS; bar.x = 0; bar.st = nullptr;
    if (hi - lo > 1) bar = xcd_barrier_post((unsigned*)(ws + WS_CTL) + CW_BAR + a.li * XCD_BAR_WORDS, MISC + 8);
    const float* x = a.in[0]; const float* c = a.in[1]; const float* ctx = a.in[2]; const float* cctx = a.in[3];
    const float* w_mod = a.in[4]; const float* b_mod = a.in[5];
    const float* g_pre_mix = a.in[6]; const float* g_post_mix = a.in[7]; const float* g_pre_ffn = a.in[8]; const float* g_post_ffn = a.in[9];
    const float* w_in = a.in[10]; const float* ln_g = a.in[11]; const float* ln_b = a.in[12]; const float* gws = a.in[13]; const float* gbs = a.in[14];
    const float* wd2f = a.in[15]; const float* bdf = a.in[16]; const float* wd2b = a.in[17]; const float* bdb = a.in[18];
    const float* out_g = a.in[19]; const float* w_out = a.in[20]; const float* w_fi = a.in[21]; const float* w_fo = a.in[22];
    float* MOD = (float*)(ws + WS_MOD); bf16* WIN = (bf16*)(ws + WS_WIN); bf16* WOUT = (bf16*)(ws + WS_WOUT); bf16* WFI = (bf16*)(ws + WS_WFI); bf16* WFO = (bf16*)(ws + WS_WFO);
    float* X = (float*)(ws + WS_X); bf16* H = (bf16*)(ws + WS_H); bf16* P = (bf16*)(ws + WS_P); bf16* CAT = (bf16*)(ws + WS_CAT); bf16* Y = (bf16*)(ws + WS_Y); bf16* HID = (bf16*)(ws + WS_HID);
    bf16* DS = (bf16*)(ws + WS_DS); bf16* SP = (bf16*)(ws + WS_SP); float* DEC = (float*)(ws + WS_DEC); bf16* WSB = (bf16*)(ws + WS_WSB); bf16* QKG = (bf16*)(ws + WS_QK);

    if (IN(0)) REP(0) { PHASE_IDS();
        LAS float* act = (LAS float*)(lds + 8 * 8448);
        for (int i = tid; i < 5 * D; i += 512) { const int r = i / D, k = i % D; const float v = r < NB ? c[r * D + k] : cctx[k]; act[i] = silu_acc(v); }
        __syncthreads();
        for (int item = wave * G + bid; item < NL * (NMOD / 32); item += ngw) {
            const int cg = item % (NMOD / 32), l = item / (NMOD / 32), kq = lane >> 3;
            const int j = cg * 32 + 4 * (lane & 7);
            const float* w = w_mod + ((size_t)l * D + kq) * NMOD + j;
            f32x4 a0 = {0.f, 0.f, 0.f, 0.f}, a1 = a0, a2 = a0, a3 = a0, a4 = a0;
#pragma unroll 8
            for (int i = 0; i < D / 8; ++i) { const f32x4 xv = *(const f32x4*)(w + (size_t)(8 * i) * NMOD); const int k = 8 * i + kq;
                a0 += xv * act[0 * D + k]; a1 += xv * act[1 * D + k]; a2 += xv * act[2 * D + k]; a3 += xv * act[3 * D + k]; a4 += xv * act[4 * D + k]; }
#pragma unroll
            for (int t = 0; t < 4; ++t) {
#pragma unroll
                for (int o = 8; o < 64; o <<= 1) { a0[t] += __shfl_xor(a0[t], o); a1[t] += __shfl_xor(a1[t], o); a2[t] += __shfl_xor(a2[t], o); a3[t] += __shfl_xor(a3[t], o); a4[t] += __shfl_xor(a4[t], o); } }
            if (kq == 0) { const f32x4 bb = *(const f32x4*)(b_mod + (size_t)l * NMOD + j); float* o = MOD + (size_t)l * 5 * NMOD + j;
                *(f32x4*)(o) = a0 + bb; *(f32x4*)(o + NMOD) = a1 + bb; *(f32x4*)(o + 2 * NMOD) = a2 + bb; *(f32x4*)(o + 3 * NMOD) = a3 + bb; *(f32x4*)(o + 4 * NMOD) = a4 + bb; }
        }
        for (int it = bid * 512 + tid; it < NL * 8 * CH * CH / 8; it += G * 512) { const f32x4 a0 = *(const f32x4*)(gws + (size_t)it * 8), a1 = *(const f32x4*)(gws + (size_t)it * 8 + 4);
            u32x4 o; o.x = pk2(a0[0], a0[1]); o.y = pk2(a0[2], a0[3]); o.z = pk2(a1[0], a1[1]); o.w = pk2(a1[2], a1[3]); *(u32x4*)(WSB + (size_t)it * 8) = o; }
        LAS float* scr = (LAS float*)(lds + wave * 8448);
        int it0 = 0;
        conv_matrix(w_in, WIN, D, PIN, NP, 1, it0, gw, ngw, scr, lane);
        conv_matrix(w_out, WOUT, D, D, D, 0, it0, gw, ngw, scr, lane);
        conv_matrix(w_fi, WFI, D, 2 * FF, 2 * FF, 2, it0, gw, ngw, scr, lane);
        conv_matrix(w_fo, WFO, FF, D, D, 0, it0, gw, ngw, scr, lane);
    }
    SEAM(0);
    if (IN(1)) { PHASE_IDS();
        RowArgs r{}; r.xin_x = x; r.xin_c = ctx; r.X = X; r.H = H; r.modB = MOD; r.gB = g_pre_mix; r.mode = 0; r.write_h = 1;
        for (int row = gw; row < M; row += ngw) row_pass(r, row, lane);
    }
    SEAM(1);
    run_layer<0>(a, lds, bar, tid0, G, bid, lo, hi);
    run_layer<1>(a, lds, bar, tid0, G, bid, lo, hi);
    run_layer<2>(a, lds, bar, tid0, G, bid, lo, hi);
    run_layer<3>(a, lds, bar, tid0, G, bid, lo, hi);
#undef IN
#undef SEAM
}

#ifndef MK_SPLIT
#define MK_SPLIT 0
#endif
extern "C" void kernel_launch(void* const* d_in, const int* in_sizes, int n_in, void* d_out, int out_size, void* d_ws, size_t ws_size, hipStream_t stream) {
    static int grid = 0;
    if (grid == 0) {
        if (n_in != 23 || ws_size < WS_END || out_size != MX * D) { fprintf(stderr, "kernel_launch: unexpected shapes (n_in %d, ws %zu, out %d)\n", n_in, ws_size, out_size); grid = -1; return; }
        int dev = 0, cus = 0, per_cu = 0;
        if (hipGetDevice(&dev) != hipSuccess || hipDeviceGetAttribute(&cus, hipDeviceAttributeMultiprocessorCount, dev) != hipSuccess) { grid = -1; return; }
        if (hipFuncSetAttribute((const void*)mega, hipFuncAttributeMaxDynamicSharedMemorySize, LDS_BYTES) != hipSuccess) { fprintf(stderr, "kernel_launch: hipFuncSetAttribute failed\n"); grid = -1; return; }
        if (hipOccupancyMaxActiveBlocksPerMultiprocessor(&per_cu, (const void*)mega, 512, LDS_BYTES) != hipSuccess || per_cu < 1) { fprintf(stderr, "kernel_launch: occupancy query says %d\n", per_cu); }
        (void)hipGetLastError();
        grid = cus;
    }
    if (grid < 0) return;
    (void)hipMemsetAsync((char*)d_ws + WS_CTL, 0, ZERO_BYTES, stream);
    Args a{};
    for (int i = 0; i < 23; ++i) a.in[i] = (const float*)d_in[i];
    a.out = (float*)d_out; a.ws = (unsigned char*)d_ws;
#if MK_SPLIT
    for (int p = 0; p < NPH; ++p) { a.ph_lo = p; a.ph_hi = p + 1; a.li = 0; hipLaunchKernelGGL(mega, dim3(grid), dim3(512), LDS_BYTES, stream, a); }
#else
    a.ph_lo = 0; a.ph_hi = NPH; a.li = 0;
    hipLaunchKernelGGL(mega, dim3(grid), dim3(512), LDS_BYTES, stream, a);
#endif
}
```

```cpp
#include <hip/hip_runtime.h>
#include <cstdio>
#include <cstdint>
namespace pg8 {
#define PG8_LAS __attribute__((address_space(3)))
typedef unsigned short bf16_t;
typedef short bf16x8 __attribute__((ext_vector_type(8)));
typedef float f32x4 __attribute__((ext_vector_type(4)));
typedef unsigned u32x4 __attribute__((ext_vector_type(4)));
constexpr int BM = 256, BK = 64, HALF = 128, HTB = HALF * BK * 2  , STAGE_BYTES = 8 * HTB, NXCD = 8, WGM = 8;

__host__ __device__ __forceinline__ int lds_byte(int r, int c) { const int st = (r >> 4) * 2 + (c >> 5), rr = r & 15, cc = c & 31, ob = rr * 64 + cc * 2; return st * 1024 + (ob ^ (((ob >> 9) & 1) << 5)); }
__host__ __device__ __forceinline__ void stage_rc(int b, int& R, int& C) { const int st = b / 1024, sb = b % 1024, swz = sb ^ (((sb >> 9) & 1) << 5); R = (st >> 1) * 16 + swz / 64; C = (st & 1) * 32 + (swz % 64) / 2; }
__host__ __device__ __forceinline__ int perm32(int rho) { const int n = rho >> 4, i = rho & 15; return 8 * (i >> 2) + 4 * n + (i & 3); }

struct Unit { int pm, pn, koff, ks; };
struct Gemm { const bf16_t* A; const bf16_t* Bt; int M, N, K, ld; };

struct StaticOrder {
    int nM, nN, nwg, G, c;
    __host__ __device__ void init(int M, int N, int G_, int c_) { nM = M / BM; nN = N / BM; nwg = nM * nN; G = G_; c = c_; }
    __host__ __device__ bool next(int i, Unit& u) const {
        const long L = (long)i * G + c; if (L >= nwg) return false;
        int wgid = (int)L; { const int q = nwg / NXCD, r = nwg % NXCD, xcd = wgid % NXCD, off = wgid / NXCD; wgid = (xcd < r ? xcd * (q + 1) : r * (q + 1) + (xcd - r) * q) + off; }
        const int nig = WGM * nN, gid = wgid / nig, fm = gid * WGM, gsz = (nM - fm) < WGM ? (nM - fm) : WGM;
        u.pm = fm + ((wgid % nig) % gsz); u.pn = (wgid % nig) / gsz; u.koff = 0; u.ks = 0; return true;
    }
    __device__ __forceinline__ void a_ready(const Unit&) const {}
    __device__ __forceinline__ void done(const Unit&) const {}
    __device__ __forceinline__ int nt(int full) const { return full; }
};
struct SplitOrder {
    int nN, ntiles, c, kt0, ktn;
    __host__ __device__ void init(int nM, int nN_, int KT, int c_) { nN = nN_; ntiles = nM * nN_; c = c_; const int ks = c / ntiles, base = (KT / 8) & ~1, rem = KT - 8 * base, nbig = rem / 2;
        ktn = base + (ks >= 8 - nbig ? 2 : 0); kt0 = ks * base + (ks > 8 - nbig ? 2 * (ks - (8 - nbig)) : 0); }
    __host__ __device__ bool next(int i, Unit& u) const { if (i != 0 || c >= 8 * ntiles) return false; const int t = c % ntiles; u.pm = t / nN; u.pn = t % nN; u.ks = c / ntiles; u.koff = kt0 * BK * 2; return true; }
    __device__ __forceinline__ void a_ready(const Unit&) const {}
    __device__ __forceinline__ void done(const Unit&) const {}
    __device__ __forceinline__ int nt(int) const { return ktn; }
};


__device__ __forceinline__ unsigned cvt_pk_bf16(float lo, float hi) { unsigned r; asm volatile("v_cvt_pk_bf16_f32 %0, %1, %2" : "=v"(r) : "v"(lo), "v"(hi)); return r; }
__device__ __forceinline__ float fast_sigmoid(float x) { return __builtin_amdgcn_rcpf(1.0f + __builtin_amdgcn_exp2f(-1.4426950408889634f * x)); }
__device__ __forceinline__ float gelu_tanh(float x) { const float y = 1.5957691216057308f * (x + 0.044715f * x * x * x); return x * fast_sigmoid(y); }
__device__ __forceinline__ float silu_f(float x) { return x * fast_sigmoid(x); }

struct EpiF32 {
    static constexpr bool PERM = false, AFTER_DRAIN = false;
    float* C; int ldc; int pad;
    __device__ __forceinline__ void operator()(const f32x4 (&acc)[2][2][4][2], const Unit& u, int wr, int wc, int fr, int fq) const {
        const int row0 = u.pm * BM + wr * 64 + fr, col0 = u.pn * BM + wc * 32 + 4 * fq;
#pragma unroll
        for (int ai = 0; ai < 2; ++ai)
#pragma unroll
            for (int m = 0; m < 4; ++m) { float* rowp = C + (size_t)(row0 + ai * HALF + m * 16) * ldc + col0;
#pragma unroll
                for (int bj = 0; bj < 2; ++bj)
#pragma unroll
                    for (int n = 0; n < 2; ++n) *(f32x4*)(rowp + bj * HALF + n * 16) = acc[ai][bj][m][n]; }
    }
};
struct EpiPartF32 {
    static constexpr bool PERM = false, AFTER_DRAIN = false;
    float* C; int ldc; int pad; size_t split_stride;
    __device__ __forceinline__ void operator()(const f32x4 (&acc)[2][2][4][2], const Unit& u, int wr, int wc, int fr, int fq) const {
        const int row0 = u.pm * BM + wr * 64 + fr, col0 = u.pn * BM + wc * 32 + 4 * fq; float* base = C + (size_t)u.ks * split_stride;
#pragma unroll
        for (int ai = 0; ai < 2; ++ai)
#pragma unroll
            for (int m = 0; m < 4; ++m) { float* rowp = base + (size_t)(row0 + ai * HALF + m * 16) * ldc + col0;
#pragma unroll
                for (int bj = 0; bj < 2; ++bj)
#pragma unroll
                    for (int n = 0; n < 2; ++n) *(f32x4*)(rowp + bj * HALF + n * 16) = acc[ai][bj][m][n]; }
    }
};
struct EpiProj {
    static constexpr bool PERM = true, AFTER_DRAIN = false;
    bf16_t* O; int ldc; int ngelu;
    __device__ __forceinline__ void operator()(const f32x4 (&acc)[2][2][4][2], const Unit& u, int wr, int wc, int fr, int fq) const {
        const int row0 = u.pm * BM + wr * 64 + fr, col0 = u.pn * BM + wc * 32 + 8 * fq;
        const bool act = u.pn < ngelu;
#pragma unroll
        for (int ai = 0; ai < 2; ++ai)
#pragma unroll
            for (int m = 0; m < 4; ++m) { bf16_t* rowp = O + (size_t)(row0 + ai * HALF + m * 16) * ldc + col0;
#pragma unroll
                for (int bj = 0; bj < 2; ++bj) { f32x4 v0 = acc[ai][bj][m][0], v1 = acc[ai][bj][m][1];
                    if (act) {
#pragma unroll
                        for (int j = 0; j < 4; ++j) { v0[j] = gelu_tanh(v0[j]); v1[j] = gelu_tanh(v1[j]); } }
                    u32x4 w; w.x = cvt_pk_bf16(v0[0], v0[1]); w.y = cvt_pk_bf16(v0[2], v0[3]); w.z = cvt_pk_bf16(v1[0], v1[1]); w.w = cvt_pk_bf16(v1[2], v1[3]);
                    *(u32x4*)(rowp + bj * HALF) = w; } }
    }
};
struct EpiSwiglu {
    static constexpr bool PERM = true, AFTER_DRAIN = false;
    bf16_t* O; int ldc; int pad;
    __device__ __forceinline__ void operator()(const f32x4 (&acc)[2][2][4][2], const Unit& u, int wr, int wc, int fr, int fq) const {
        const int row0 = u.pm * BM + wr * 64 + fr, col0 = u.pn * HALF + wc * 32 + 8 * fq;
#pragma unroll
        for (int ai = 0; ai < 2; ++ai)
#pragma unroll
            for (int m = 0; m < 4; ++m) { bf16_t* rowp = O + (size_t)(row0 + ai * HALF + m * 16) * ldc + col0;
                f32x4 h0, h1;
#pragma unroll
                for (int j = 0; j < 4; ++j) { h0[j] = silu_f(acc[ai][0][m][0][j]) * acc[ai][1][m][0][j]; h1[j] = silu_f(acc[ai][0][m][1][j]) * acc[ai][1][m][1][j]; }
                u32x4 w; w.x = cvt_pk_bf16(h0[0], h0[1]); w.y = cvt_pk_bf16(h0[2], h0[3]); w.z = cvt_pk_bf16(h1[0], h1[1]); w.w = cvt_pk_bf16(h1[2], h1[3]);
                *(u32x4*)rowp = w; }
    }
};

template <class Epi, class Sched, bool ALIGN_EPI = false, bool SP2 = false>
__device__ __forceinline__ void gemm_phase(PG8_LAS unsigned char* lds, const Gemm g, const Sched& S, const Epi& E) {
    int tid_o = threadIdx.x; asm volatile("" : "+v"(tid_o));
    const int tid = tid_o, wid = __builtin_amdgcn_readfirstlane(tid >> 6), lane = tid & 63, wr = wid >> 2, wc = wid & 3, fr = lane & 15, fq = lane >> 4;
    const int K = g.ld, nt = S.nt(g.K / BK);
    unsigned voffA[2], voffB[2];
#pragma unroll
    for (int i = 0; i < 2; ++i) { int R, C; stage_rc(tid * 16 + i * 8192, R, C); const int Rb = Epi::PERM ? ((R & ~31) + perm32(R & 31)) : R;
        voffA[i] = (unsigned)(R * K + C) * 2u; voffB[i] = (unsigned)(Rb * K + C) * 2u; }
    const size_t kstep = (size_t)(BK * 2);
    const size_t hstep = (size_t)HALF * K * 2;
    const size_t tstep = 2 * hstep;
    const unsigned ldsw = (unsigned)wid * 1024u;
    const int aoff = lds_byte(wr * 64 + fr, fq * 8), boff = lds_byte(wc * 32 + fr, fq * 8);
#define PG8_SA(b, h) (((b) * 2 + (h)) * HTB)
#define PG8_SB(b, h) ((4 + (b) * 2 + (h)) * HTB)
#define PG8_STAGE(bufoff, gbase, voff) do { _Pragma("unroll") for (int _i = 0; _i < 2; ++_i) \
        __builtin_amdgcn_global_load_lds((const unsigned*)((const char*)(gbase) + (voff)[_i]), (PG8_LAS unsigned*)(lds + (bufoff) + ldsw + _i * 8192), 16, 0, 0); } while (0)
#define PG8_LDA(dst, b, h) do { _Pragma("unroll") for (int m = 0; m < 4; ++m) _Pragma("unroll") for (int k = 0; k < 2; ++k) dst[m][k] = *(const PG8_LAS bf16x8*)(lds + PG8_SA(b, h) + aoff + m * 2048 + k * 1024); } while (0)
#define PG8_LDB(dst, b, h) do { _Pragma("unroll") for (int n = 0; n < 2; ++n) _Pragma("unroll") for (int k = 0; k < 2; ++k) dst[n][k] = *(const PG8_LAS bf16x8*)(lds + PG8_SB(b, h) + boff + n * 2048 + k * 1024); } while (0)
#define PG8_MMA(ai, bj, At, Bt) do { __builtin_amdgcn_s_setprio(1); _Pragma("unroll") for (int m = 0; m < 4; ++m) _Pragma("unroll") for (int n = 0; n < 2; ++n) _Pragma("unroll") for (int k = 0; k < 2; ++k) \
        acc[ai][bj][m][n] = __builtin_amdgcn_mfma_f32_16x16x32_bf16(Bt[n][k], At[m][k], acc[ai][bj][m][n], 0, 0, 0); __builtin_amdgcn_s_setprio(0); } while (0)
#define PG8_WAIT_V(n) asm volatile("s_waitcnt vmcnt(" #n ")" ::: "memory")
#define PG8_WAIT_L(n) asm volatile("s_waitcnt lgkmcnt(" #n ")" ::: "memory")
#define PG8_BAR __builtin_amdgcn_s_barrier()
#define PG8_SCHED __builtin_amdgcn_sched_barrier(0)
    Unit cur, nxt; int ui = 0;
    if (!S.next(0, cur)) return;
    f32x4 acc[2][2][4][2];
#pragma unroll
    for (int a = 0; a < 2; ++a)
#pragma unroll
        for (int b = 0; b < 2; ++b)
#pragma unroll
            for (int m = 0; m < 4; ++m)
#pragma unroll
                for (int n = 0; n < 2; ++n) acc[a][b][m][n] = (f32x4){0.f, 0.f, 0.f, 0.f};
    bf16x8 At[4][2], B0[2][2], B1[2][2];
    const char* cA = (const char*)g.A + (size_t)cur.pm * tstep + cur.koff; const char* cB = (const char*)g.Bt + (size_t)cur.pn * tstep + cur.koff;
    S.a_ready(cur);
    if constexpr (SP2) {
        PG8_STAGE(PG8_SB(0, 0), cB, voffB); PG8_STAGE(PG8_SB(0, 1), cB + hstep, voffB); PG8_STAGE(PG8_SA(0, 0), cA, voffA); PG8_STAGE(PG8_SA(0, 1), cA + hstep, voffA);
        if (wr == 1) PG8_BAR;
        PG8_WAIT_V(2); PG8_BAR;
        PG8_STAGE(PG8_SB(1, 0), cB + kstep, voffB); PG8_STAGE(PG8_SA(1, 0), cA + kstep, voffA); PG8_STAGE(PG8_SB(1, 1), cB + hstep + kstep, voffB);
        PG8_WAIT_V(6); PG8_BAR;
    } else {
        PG8_STAGE(PG8_SB(0, 0), cB, voffB); PG8_STAGE(PG8_SA(0, 0), cA, voffA); PG8_STAGE(PG8_SB(0, 1), cB + hstep, voffB); PG8_STAGE(PG8_SA(0, 1), cA + hstep, voffA);
        if (wr == 1) PG8_BAR;
        PG8_WAIT_V(4); PG8_BAR;
        PG8_STAGE(PG8_SB(1, 0), cB + kstep, voffB); PG8_STAGE(PG8_SA(1, 0), cA + kstep, voffA); PG8_STAGE(PG8_SB(1, 1), cB + hstep + kstep, voffB);
        PG8_WAIT_V(6); PG8_BAR;
    }
    for (;;) {
        const bool has_next = S.next(ui + 1, nxt);
        const char* nA = has_next ? (const char*)g.A + (size_t)nxt.pm * tstep + nxt.koff : cA; const char* nB = has_next ? (const char*)g.Bt + (size_t)nxt.pn * tstep + nxt.koff : cB;
        for (int t = 0; t < nt; t += 2) {
            const bool last = (t == nt - 2);
            const char* a1 = cA + (size_t)(t + 1) * kstep;
            const char* a2 = last ? nA : cA + (size_t)(t + 2) * kstep; const char* b2 = last ? nB : cB + (size_t)(t + 2) * kstep;
            const char* a3 = a2 + kstep; const char* b3 = b2 + kstep;
            if (last && has_next) S.a_ready(nxt);
            if constexpr (SP2) {
            PG8_LDB(B0, 0, 0); PG8_LDB(B1, 0, 1); PG8_SCHED; PG8_LDA(At, 0, 0); PG8_STAGE(PG8_SA(1, 1), a1 + hstep, voffA);
            PG8_WAIT_V(8); PG8_WAIT_L(0); PG8_BAR; PG8_MMA(0, 0, At, B0); PG8_MMA(0, 1, At, B1); PG8_BAR; PG8_SCHED;
            PG8_LDA(At, 0, 1); PG8_STAGE(PG8_SB(0, 0), b2, voffB); PG8_STAGE(PG8_SB(0, 1), b2 + hstep, voffB); PG8_STAGE(PG8_SA(0, 0), a2, voffA);
            PG8_WAIT_V(8); PG8_WAIT_L(0); PG8_BAR; PG8_MMA(1, 0, At, B0); PG8_MMA(1, 1, At, B1); PG8_BAR; PG8_SCHED;
            PG8_LDB(B0, 1, 0); PG8_LDB(B1, 1, 1); PG8_SCHED; PG8_LDA(At, 1, 0); PG8_STAGE(PG8_SA(0, 1), a2 + hstep, voffA);
            PG8_WAIT_V(8); PG8_WAIT_L(0); PG8_BAR; PG8_MMA(0, 0, At, B0); PG8_MMA(0, 1, At, B1); PG8_BAR; PG8_SCHED;
            PG8_LDA(At, 1, 1); PG8_STAGE(PG8_SB(1, 0), b3, voffB); PG8_STAGE(PG8_SB(1, 1), b3 + hstep, voffB); PG8_STAGE(PG8_SA(1, 0), a3, voffA);
            PG8_WAIT_V(8); PG8_WAIT_L(0); PG8_BAR; PG8_MMA(1, 0, At, B0); PG8_MMA(1, 1, At, B1); PG8_BAR; PG8_SCHED;
            } else {
            PG8_LDB(B0, 0, 0); PG8_SCHED; PG8_LDA(At, 0, 0); PG8_STAGE(PG8_SA(1, 1), a1 + hstep, voffA);
            PG8_WAIT_L(8); PG8_BAR; PG8_WAIT_L(0); PG8_MMA(0, 0, At, B0); PG8_BAR; PG8_SCHED;
            PG8_LDB(B1, 0, 1); PG8_STAGE(PG8_SB(0, 0), b2, voffB);
            PG8_BAR; PG8_WAIT_L(0); PG8_MMA(0, 1, At, B1); PG8_BAR;
            PG8_LDA(At, 0, 1); PG8_STAGE(PG8_SA(0, 0), a2, voffA);
            PG8_BAR; PG8_WAIT_L(0); PG8_MMA(1, 0, At, B0); PG8_BAR; PG8_SCHED;
            PG8_STAGE(PG8_SB(0, 1), b2 + hstep, voffB);
            PG8_WAIT_V(6); PG8_BAR; PG8_MMA(1, 1, At, B1); PG8_BAR;
            PG8_LDB(B0, 1, 0); PG8_SCHED; PG8_LDA(At, 1, 0); PG8_STAGE(PG8_SA(0, 1), a2 + hstep, voffA);
            PG8_WAIT_L(8); PG8_BAR; PG8_WAIT_L(0); PG8_MMA(0, 0, At, B0); PG8_BAR; PG8_SCHED;
            PG8_LDB(B1, 1, 1); PG8_STAGE(PG8_SB(1, 0), b3, voffB);
            PG8_BAR; PG8_WAIT_L(0); PG8_MMA(0, 1, At, B1); PG8_BAR;
            PG8_LDA(At, 1, 1); PG8_STAGE(PG8_SA(1, 0), a3, voffA);
            PG8_BAR; PG8_WAIT_L(0); PG8_MMA(1, 0, At, B0); PG8_BAR; PG8_SCHED;
            PG8_STAGE(PG8_SB(1, 1), b3 + hstep, voffB);
            PG8_WAIT_V(6); PG8_BAR; PG8_MMA(1, 1, At, B1); PG8_BAR;
            }
        }
        if constexpr (ALIGN_EPI) { if (wr == 0) PG8_BAR; }
        if constexpr (!Epi::AFTER_DRAIN) { E(acc, cur, wr, wc, fr, fq); S.done(cur); }
        if (!has_next) break;
#pragma unroll
        for (int a = 0; a < 2; ++a)
#pragma unroll
            for (int b = 0; b < 2; ++b)
#pragma unroll
                for (int m = 0; m < 4; ++m)
#pragma unroll
                    for (int n = 0; n < 2; ++n) acc[a][b][m][n] = (f32x4){0.f, 0.f, 0.f, 0.f};
        cur = nxt; cA = nA; cB = nB; ++ui;
        if constexpr (ALIGN_EPI) { if (wr == 1) PG8_BAR; }
    }
    PG8_WAIT_V(0);
    if constexpr (!ALIGN_EPI) { if (wr == 0) PG8_BAR; }
    PG8_BAR;
    if constexpr (Epi::AFTER_DRAIN) { E.fused(acc, cur, wr, wc, fr, fq, lds, wid, lane); S.done(cur); }
#undef PG8_SA
#undef PG8_SB
#undef PG8_STAGE
#undef PG8_LDA
#undef PG8_LDB
#undef PG8_MMA
#undef PG8_WAIT_V
#undef PG8_WAIT_L
#undef PG8_BAR
#undef PG8_SCHED
}
}
#define XB_TMO      128
#define XB_XCNT(j)  (256  + 64 * (j))
#define XB_XSUB(j)  (1280 + 64 * (j))
#define XB_XGEN(j)  (2304 + 64 * (j))
#define XB_TOP      3328
#define XB_TOPGEN   3392
#define XCD_BAR_WORDS 3456
#define XB_SPIN_CAP (1u << 18)
#define LAS __attribute__((address_space(3)))

__device__ __forceinline__ unsigned xb_ld(unsigned* p)              { return __hip_atomic_load(p, __ATOMIC_RELAXED, __HIP_MEMORY_SCOPE_AGENT); }
__device__ __forceinline__ unsigned xb_add(unsigned* p, unsigned v) { return __hip_atomic_fetch_add(p, v, __ATOMIC_RELAXED, __HIP_MEMORY_SCOPE_AGENT); }
__device__ __forceinline__ unsigned xb_xcc_id() { return (unsigned)__builtin_amdgcn_s_getreg((3 << 11) | 20) & 0xFu; }
#define XB_SPIN(cond, bar) do { unsigned _sp = 0; while (cond) { __builtin_amdgcn_s_sleep(1); \
    if ((++_sp & 255u) == 0u) { if (xb_ld(&(bar)[XB_TMO])) break; if (_sp > XB_SPIN_CAP) { atomicAdd(&(bar)[XB_TMO], 1u); break; } } } } while (0)

struct XcdBarrier {
    unsigned* bar; unsigned x;
    volatile LAS unsigned* st;
};

__device__ __forceinline__ XcdBarrier xcd_barrier_post(unsigned* bar, volatile LAS unsigned* st) {
    XcdBarrier b; b.bar = bar; b.x = xb_xcc_id(); b.st = st;
    if (threadIdx.x == 0) (void)xb_add(&bar[XB_XCNT(b.x)], 1u);
    return b;
}
__device__ __forceinline__ void xcd_barrier_complete(unsigned* bar, unsigned x, unsigned& nloc, unsigned& nx) {
    const unsigned G = gridDim.x * gridDim.y * gridDim.z;
    unsigned sum, cnt, mine, sp = 0u;
    for (;;) {
        sum = 0u; cnt = 0u; mine = 0u;
#pragma unroll
        for (unsigned j = 0; j < 16; ++j) { const unsigned c = xb_ld(&bar[XB_XCNT(j)]); sum += c; cnt += (c > 0u) ? 1u : 0u; mine = (j == x) ? c : mine; }
        if (sum == G) break;
        __builtin_amdgcn_s_sleep(1);
        if ((++sp & 255u) == 0u) { if (xb_ld(&bar[XB_TMO])) break; if (sp > XB_SPIN_CAP) { atomicAdd(&bar[XB_TMO], 1u); break; } }
    }
    nloc = mine > 0u ? mine : 1u; nx = cnt > 0u ? cnt : 1u;
}

__device__ __forceinline__ void xcd_barrier(const XcdBarrier& b) {
    asm volatile("s_waitcnt vmcnt(0)" ::: "memory");
    __syncthreads();
    if (threadIdx.x == 0) {
        unsigned* bar = b.bar;
        __builtin_amdgcn_s_waitcnt(0);
        unsigned nloc = b.st[0], nx = b.st[1];
        if (nloc == 0u) { xcd_barrier_complete(bar, b.x, nloc, nx); b.st[0] = nloc; b.st[1] = nx; }
        const unsigned old = xb_add(&bar[XB_XSUB(b.x)], 1u);
        const unsigned gen = old / nloc;
        if (old + 1u == (gen + 1u) * nloc) {
            __builtin_amdgcn_fence(__ATOMIC_RELEASE, "agent");
            asm volatile("s_waitcnt vmcnt(0)" ::: "memory");
            const unsigned og = xb_add(&bar[XB_TOP], 1u);
            const unsigned tg = og / nx;
            if (og + 1u == (tg + 1u) * nx) xb_add(&bar[XB_TOPGEN], 1u);
            else XB_SPIN(xb_ld(&bar[XB_TOPGEN]) == tg, bar);
            __builtin_amdgcn_fence(__ATOMIC_ACQUIRE, "agent");
            xb_add(&bar[XB_XGEN(b.x)], 1u);
            asm volatile("s_waitcnt vmcnt(0)" ::: "memory");
        } else {
            XB_SPIN(xb_ld(&bar[XB_XGEN(b.x)]) == gen, bar);
            __builtin_amdgcn_fence(__ATOMIC_ACQUIRE, "agent");
            asm volatile("s_waitcnt vmcnt(0)" ::: "memory");
        }
    }
    __syncthreads();
}

typedef unsigned short bf16;
typedef float f32x4 __attribute__((ext_vector_type(4)));
typedef unsigned u32x4 __attribute__((ext_vector_type(4)));
typedef unsigned u32x2 __attribute__((ext_vector_type(2)));
constexpr int D = 2048, NB = 4, SEQ = 4096, NL = 4, CTX = 256, CH = 128;
constexpr int MX = NB * SEQ, MC = NB * CTX, M = MX + MC;
constexpr int PIN = 5152, NP = 5376, FF = 5632, NMOD = 6 * D;
constexpr int C_U = 0, C_V = 1024, C_Q = 2048, C_K = 2560, C_VV = 3072, C_G = 4096, C_DF = 5120, C_DB = 5136;
constexpr int NCHUNK = M / CH;
constexpr float EPS = 1e-6f;
constexpr size_t MiB = 1u << 20;
constexpr size_t WS_CTL = 0, WS_MOD = 1 * MiB, ZERO_BYTES = 2 * MiB, WS_WIN = 2 * MiB, WS_WOUT = WS_WIN + 84 * MiB, WS_WFI = WS_WOUT + 32 * MiB, WS_WFO = WS_WFI + 176 * MiB,
                 WS_X = WS_WFO + 88 * MiB, WS_H = WS_X + 136 * MiB, WS_P = WS_H + 68 * MiB, WS_CAT = WS_P + 179 * MiB, WS_Y = WS_CAT + 68 * MiB, WS_HID = WS_Y + 136 * MiB,
                 WS_DS = WS_HID + 187 * MiB, WS_SP = WS_DS + 136 * MiB, WS_DEC = WS_SP + 68 * MiB, WS_WSB = WS_DEC + 1 * MiB, WS_QK = WS_WSB + 1 * MiB, WS_YP = WS_QK + 68 * MiB, WS_END = WS_YP + 64 * MiB;
static_assert((size_t)NL * NP * D * 2 <= 84 * MiB && (size_t)NL * 2 * FF * D * 2 <= 176 * MiB && (size_t)NL * D * FF * 2 <= 88 * MiB && (size_t)M * NP * 2 <= 179 * MiB && (size_t)M * FF * 2 <= 187 * MiB, "ws map");
constexpr int CW_BAR = 4096;
constexpr int LDS_BYTES = 163840, MISC_OFF = LDS_BYTES - 256;

__device__ __forceinline__ float bf2f(bf16 b) { return __uint_as_float(((unsigned)b) << 16); }
__device__ __forceinline__ unsigned f2bf(float f) { unsigned u = __float_as_uint(f); return (u + 0x7fffu + ((u >> 16) & 1u)) >> 16; }
__device__ __forceinline__ unsigned pk2(float lo, float hi) { return f2bf(lo) | (f2bf(hi) << 16); }
__device__ __forceinline__ float wave_sum(float v) {
#pragma unroll
    for (int o = 1; o < 64; o <<= 1) v += __shfl_xor(v, o);
    return v;
}
__device__ __forceinline__ float sigmoid_acc(float x) { return 1.0f / (1.0f + __expf(-x)); }
__device__ __forceinline__ float silu_acc(float x) { return x * sigmoid_acc(x); }
__device__ __forceinline__ float log_sigmoid(float z) { return fminf(z, 0.f) - log1pf(__expf(-fabsf(z))); }
__device__ __forceinline__ int mod_row(int row) { return row < MX ? row / SEQ : NB; }
#define LDS_WAIT() asm volatile("s_waitcnt lgkmcnt(0)" ::: "memory")


__device__ __forceinline__ int map_col(int mode, int r) {
    if (mode == 0) return r;
    if (mode == 1) return r < PIN ? r : -1;
    const int pn = r >> 8, rr = r & 255; return rr < 128 ? pn * 128 + rr : FF + pn * 128 + (rr - 128);
}
__device__ __forceinline__ void transpose_item(const float* W, int K, int Nsrc, bf16* T, int n0, int c0, int k0, LAS float* scr, int lane) {
    if (c0 >= 0) {
#pragma unroll 8
        for (int i = 0; i < 32; ++i) { const int kk = 2 * i + (lane >> 5); scr[kk * 33 + (lane & 31)] = __builtin_nontemporal_load(W + (size_t)(k0 + kk) * Nsrc + c0 + (lane & 31)); }
    } else {
#pragma unroll 8
        for (int i = 0; i < 32; ++i) { const int kk = 2 * i + (lane >> 5); scr[kk * 33 + (lane & 31)] = 0.f; }
    }
    LDS_WAIT(); asm volatile("" ::: "memory");
    const int c = lane & 7;
#pragma unroll
    for (int j = 0; j < 4; ++j) { const int n = (lane >> 3) + 8 * j; const LAS float* s = scr + (8 * c) * 33 + n;
        u32x4 o; o.x = pk2(s[0 * 33], s[1 * 33]); o.y = pk2(s[2 * 33], s[3 * 33]); o.z = pk2(s[4 * 33], s[5 * 33]); o.w = pk2(s[6 * 33], s[7 * 33]);
        __builtin_nontemporal_store(o, (u32x4*)(T + (size_t)(n0 + n) * K + k0 + 8 * c)); }
    LDS_WAIT(); asm volatile("" ::: "memory");
}
__device__ __forceinline__ void conv_matrix(const float* W, bf16* T, int K, int Nsrc, int Ndst, int mode, int& it0, int gw, int ngw, LAS float* scr, int lane) {
    const int nblk = Ndst / 32, per_layer = (K / 64) * nblk, total = NL * per_layer;
    int first = ((gw - it0) % ngw + ngw) % ngw;
    for (int it = first; it < total; it += ngw) {
        const int l = it / per_layer, r = it % per_layer, kb = r / nblk, nb = r % nblk;
        transpose_item(W + (size_t)l * K * Nsrc, K, Nsrc, T + (size_t)l * Ndst * K, 32 * nb, map_col(mode, 32 * nb), 64 * kb, scr, lane);
    }
    it0 += total;
}
struct RowArgs { const float* xin_x; const float* xin_c; const float* YP; const bf16* Y; float* X; float* out; bf16* H; const float* modA; const float* modB; const float* gA; const float* gB; int mode; int write_h; int to_out; int pad; };
__device__ __forceinline__ void row_vectors(const RowArgs& a, LAS float* VEC, int tid) {
    for (int i = tid; i < 5 * (D / 4); i += 512) { const int r = i / (D / 4), c = (i % (D / 4)) * 4;
        if (a.mode != 0) { const f32x4 m = *(const f32x4*)(a.modA + (size_t)r * NMOD + (a.mode == 1 ? 2 : 5) * D + c), g = *(const f32x4*)(a.gA + c); *(LAS f32x4*)(VEC + (r * 3 + 0) * D + c) = m * g; }
        if (a.write_h) { const float* msh = (a.mode == 1 ? a.modA + (size_t)r * NMOD + 3 * D : a.modB + (size_t)r * NMOD);
            const f32x4 sh = *(const f32x4*)(msh + c), sc = *(const f32x4*)(msh + D + c), g = *(const f32x4*)(a.gB + c);
            *(LAS f32x4*)(VEC + (r * 3 + 1) * D + c) = g * (sc + 1.0f); *(LAS f32x4*)(VEC + (r * 3 + 2) * D + c) = sh; } }
}
__device__ __forceinline__ const float* row_xsrc(const RowArgs& a, int row) {
    return (a.mode == 2 || a.xin_x == nullptr) ? a.X + (size_t)row * D : (row < MX ? a.xin_x + (size_t)row * D : a.xin_c + (size_t)(row - MX) * D);
}
__device__ __forceinline__ void row_finish(const RowArgs& a, int row, int lane, f32x4 (&x)[8], const f32x4 (&y)[8], const LAS float* VEC) {
    const LAS float* V0 = VEC + (mod_row(row) * 3) * D + 4 * lane;
    if (a.mode != 0) {
        float ss = 0.f;
#pragma unroll
        for (int j = 0; j < 8; ++j) ss += (y[j][0] * y[j][0] + y[j][1] * y[j][1]) + (y[j][2] * y[j][2] + y[j][3] * y[j][3]);
        const float rstd = rsqrtf(wave_sum(ss) * (1.f / D) + EPS);
#pragma unroll
        for (int j = 0; j < 8; ++j) { const f32x4 mg = *(const LAS f32x4*)(V0 + 256 * j); x[j] = x[j] + mg * (y[j] * rstd); }
        float* dst = (a.to_out && row < MX) ? a.out + (size_t)row * D : a.X + (size_t)row * D;
        if (!(a.to_out && row >= MX)) {
#pragma unroll
            for (int j = 0; j < 8; ++j) __builtin_nontemporal_store(x[j], (f32x4*)(dst + 4 * lane + 256 * j)); }
    }
    if (a.write_h) {
        float ss = 0.f;
#pragma unroll
        for (int j = 0; j < 8; ++j) ss += (x[j][0] * x[j][0] + x[j][1] * x[j][1]) + (x[j][2] * x[j][2] + x[j][3] * x[j][3]);
        const float rstd = rsqrtf(wave_sum(ss) * (1.f / D) + EPS);
        bf16* hr = a.H + (size_t)row * D;
#pragma unroll
        for (int j = 0; j < 8; ++j) { const f32x4 gs = *(const LAS f32x4*)(V0 + D + 256 * j), sh = *(const LAS f32x4*)(V0 + 2 * D + 256 * j);
            const f32x4 h = (x[j] * rstd) * gs + sh; u32x2 w; w.x = pk2(h[0], h[1]); w.y = pk2(h[2], h[3]); *(u32x2*)(hr + 4 * lane + 256 * j) = w; }
    }
}
__device__ __forceinline__ void row_pass(const RowArgs& a, int row, int lane, const LAS float* VEC) {
    const float* xsrc = row_xsrc(a, row);
    f32x4 x[8], y[8];
#pragma unroll
    for (int j = 0; j < 8; ++j) x[j] = __builtin_nontemporal_load((const f32x4*)(xsrc + 4 * lane + 256 * j));
    if (a.mode != 0) {
        if (a.YP != nullptr && row >= MX) {
            const float* yp = a.YP + (size_t)(row - MX) * D + 4 * lane;
#pragma unroll
            for (int j = 0; j < 8; ++j) { f32x4 s = *(const f32x4*)(yp + 256 * j);
#pragma unroll 1
                for (int k = 1; k < 8; ++k) s += *(const f32x4*)(yp + (size_t)k * MC * D + 256 * j);
                y[j] = s; }
        } else {
            const bf16* yr = a.Y + (size_t)row * D;
#pragma unroll
            for (int j = 0; j < 8; ++j) { const u32x2 yw = *(const u32x2*)(yr + 4 * lane + 256 * j); y[j] = (f32x4){__uint_as_float(yw.x << 16), __uint_as_float(yw.x & 0xffff0000u), __uint_as_float(yw.y << 16), __uint_as_float(yw.y & 0xffff0000u)}; }
        }
    } else {
#pragma unroll
        for (int j = 0; j < 8; ++j) y[j] = (f32x4){0.f, 0.f, 0.f, 0.f};
    }
    row_finish(a, row, lane, x, y, VEC);
}
__device__ __forceinline__ void row_pass2(const RowArgs& a, int r0, int r1, int lane, const LAS float* VEC) {
    const float* xs0 = row_xsrc(a, r0); const float* xs1 = row_xsrc(a, r1);
    f32x4 x0[8], x1[8]; u32x2 w0[8], w1[8];
#pragma unroll
    for (int j = 0; j < 8; ++j) { x0[j] = __builtin_nontemporal_load((const f32x4*)(xs0 + 4 * lane + 256 * j)); x1[j] = __builtin_nontemporal_load((const f32x4*)(xs1 + 4 * lane + 256 * j)); }
    if (a.mode != 0) {
#pragma unroll
        for (int j = 0; j < 8; ++j) { w0[j] = __builtin_nontemporal_load((const u32x2*)(a.Y + (size_t)r0 * D + 4 * lane + 256 * j)); w1[j] = __builtin_nontemporal_load((const u32x2*)(a.Y + (size_t)r1 * D + 4 * lane + 256 * j)); }
    } else {
#pragma unroll
        for (int j = 0; j < 8; ++j) { w0[j] = (u32x2){0u, 0u}; w1[j] = (u32x2){0u, 0u}; }
    }
    { f32x4 y[8];
#pragma unroll
      for (int j = 0; j < 8; ++j) y[j] = (f32x4){__uint_as_float(w0[j].x << 16), __uint_as_float(w0[j].x & 0xffff0000u), __uint_as_float(w0[j].y << 16), __uint_as_float(w0[j].y & 0xffff0000u)};
      row_finish(a, r0, lane, x0, y, VEC); }
    { f32x4 y[8];
#pragma unroll
      for (int j = 0; j < 8; ++j) y[j] = (f32x4){__uint_as_float(w1[j].x << 16), __uint_as_float(w1[j].x & 0xffff0000u), __uint_as_float(w1[j].y << 16), __uint_as_float(w1[j].y & 0xffff0000u)};
      row_finish(a, r1, lane, x1, y, VEC); }
}
__device__ __forceinline__ void row_phase(const RowArgs& a, int nrows, LAS unsigned char* lds, int tid, int lane, int gw, int ngw) {
    LAS float* VEC = (LAS float*)lds;
    row_vectors(a, VEC, tid);
    __syncthreads();
    for (int r0 = gw; r0 < nrows; r0 += 2 * ngw) { const int r1 = r0 + ngw;
        if (r1 < MX) row_pass2(a, r0, r1, lane, VEC);
        else { row_pass(a, r0, lane, VEC); if (r1 < nrows) row_pass(a, r1, lane, VEC); } }
    __syncthreads();
}

__device__ __forceinline__ void gmlp_unit_simple(const bf16* P, bf16* CAT, const float* ln_g, const float* ln_b, const float* ws, const float* bs, int cid, int h, LAS float* vln, int tid) {
    { const int j = tid >> 2, qd = tid & 3; const bf16* vp = P + (size_t)(cid * CH + j) * NP + C_V + h * 128 + qd * 32;
      float v[32]; float s = 0.f;
#pragma unroll
      for (int i = 0; i < 4; ++i) { const u32x4 w = *(const u32x4*)(vp + 8 * i);
#pragma unroll
          for (int e = 0; e < 4; ++e) { v[8 * i + 2 * e] = __uint_as_float(w[e] << 16); v[8 * i + 2 * e + 1] = __uint_as_float(w[e] & 0xffff0000u); } }
#pragma unroll
      for (int i = 0; i < 32; ++i) s += v[i];
      s += __shfl_xor(s, 1); s += __shfl_xor(s, 2); const float mu = s * (1.f / 128.f); float q = 0.f;
#pragma unroll
      for (int i = 0; i < 32; ++i) { v[i] -= mu; q += v[i] * v[i]; }
      q += __shfl_xor(q, 1); q += __shfl_xor(q, 2); const float rstd = rsqrtf(q * (1.f / 128.f) + EPS);
#pragma unroll
      for (int i = 0; i < 32; ++i) { const int d = qd * 32 + i; vln[j * CH + d] = v[i] * rstd * ln_g[h * 128 + d] + ln_b[h * 128 + d]; } }
    __syncthreads();
    const int d = tid & 127, ig = __builtin_amdgcn_readfirstlane(tid >> 7);
    for (int ii = 0; ii < 32; ++ii) { const int i = ig * 32 + ii; const float* wr = ws + ((size_t)h * CH + i) * CH; float acc = 0.f;
#pragma unroll 16
        for (int j = 0; j < CH; ++j) acc += wr[j] * vln[j * CH + d];
        const size_t row = (size_t)cid * CH + i; const float u = bf2f(P[row * NP + C_U + h * 128 + d]);
        CAT[row * D + h * 128 + d] = (bf16)f2bf(u * (acc + bs[h * CH + i])); }
    __syncthreads();
}


typedef short bf16x8 __attribute__((ext_vector_type(8)));
typedef short s16x4 __attribute__((ext_vector_type(4)));
typedef short v4i16_t __attribute__((ext_vector_type(4)));
constexpr int PQ = 288, PV = 544;
constexpr int L_QT = 0, L_KT = 36864, L_ST = 0, L_V = 73728, L_DF = 143360, L_TOT = 151552;
__device__ __forceinline__ s16x4 tr_read(const LAS unsigned char* p) { return __builtin_bit_cast(s16x4, __builtin_amdgcn_ds_read_tr16_b64_v4i16((LAS v4i16_t*)p)); }
__device__ __forceinline__ bf16x8 cat8(s16x4 lo, s16x4 hi) { return (bf16x8){lo[0], lo[1], lo[2], lo[3], hi[0], hi[1], hi[2], hi[3]}; }
__device__ __forceinline__ float logsig_fast(float z) { return fminf(z, 0.f) - __logf(1.0f + __expf(-fabsf(z))); }
__device__ __forceinline__ f32x4 mfma16(bf16x8 a, bf16x8 b, f32x4 c) { return __builtin_amdgcn_mfma_f32_16x16x32_bf16(a, b, c, 0, 0, 0); }

__device__ __forceinline__ void v_tile_issue(const bf16* P, int cid, int h, u32x4 (&vr)[8], int tid) {
#pragma unroll
    for (int i = 0; i < 8; ++i) { const int idx = tid + 512 * i, row = idx >> 5, ch = idx & 31; vr[i] = *(const u32x4*)(P + (size_t)(cid * CH + row) * NP + C_VV + h * 256 + ch * 8); }
}
__device__ __forceinline__ void v_tile_park(const u32x4 (&vr)[8], LAS unsigned char* V, int tid) {
#pragma unroll
    for (int i = 0; i < 8; ++i) { const int idx = tid + 512 * i, row = idx >> 5, ch = idx & 31; *(LAS u32x4*)(V + row * PV + ch * 16) = vr[i]; }
}
__device__ __forceinline__ void gla_prep(const bf16* P, const float* wd2, const float* bd, float* dec_out, int cid, int h, int dir, LAS unsigned char* lds, int tid) {
    LAS float* DF = (LAS float*)(lds + L_DF); LAS float* TOT = (LAS float*)(lds + L_TOT);
    LAS bf16* QT = (LAS bf16*)(lds + L_QT); LAS bf16* KT = (LAS bf16*)(lds + L_KT);
    asm volatile("" : "+v"(tid));
    const int d = tid & 127, seg = tid >> 7;
    u32x4 rk[4], rq[4];
#pragma unroll
    for (int i = 0; i < 4; ++i) { const int idx = tid + 512 * i, row = idx >> 4, ch = idx & 15; const bf16* pr = P + (size_t)(cid * CH + row) * NP + h * 128 + ch * 8;
        rk[i] = *(const u32x4*)(pr + C_K); rq[i] = *(const u32x4*)(pr + C_Q); }
    { const int j = tid >> 2, r0 = (tid & 3) * 4; const u32x2 w = *(const u32x2*)(P + (size_t)(cid * CH + j) * NP + (dir ? C_DB : C_DF) + r0);
      const f32x4 f = {__uint_as_float(w.x << 16), __uint_as_float(w.x & 0xffff0000u), __uint_as_float(w.y << 16), __uint_as_float(w.y & 0xffff0000u)}; *(LAS f32x4*)(DF + j * 16 + r0) = f; }
    float wd[16];
#pragma unroll
    for (int r = 0; r < 16; ++r) wd[r] = wd2[r * 512 + h * 128 + d];
    const float bdv = bd[h * 128 + d];
    __syncthreads();
    float bl[32]; float run = 0.f;
#pragma unroll
    for (int jj = 0; jj < 32; ++jj) { const int pos = 32 * seg + jj, j = dir ? 127 - pos : pos; const LAS f32x4* dfp = (const LAS f32x4*)(DF + j * 16);
        const f32x4 a = dfp[0], b = dfp[1], c = dfp[2], e = dfp[3];
        float z = bdv;
        z += a[0] * wd[0]; z += a[1] * wd[1]; z += a[2] * wd[2]; z += a[3] * wd[3]; z += b[0] * wd[4]; z += b[1] * wd[5]; z += b[2] * wd[6]; z += b[3] * wd[7];
        z += c[0] * wd[8]; z += c[1] * wd[9]; z += c[2] * wd[10]; z += c[3] * wd[11]; z += e[0] * wd[12]; z += e[1] * wd[13]; z += e[2] * wd[14]; z += e[3] * wd[15];
        run += logsig_fast(z) * (1.f / 16.f); bl[jj] = run; }
    TOT[seg * 128 + d] = run;
#pragma unroll
    for (int i = 0; i < 4; ++i) { const int idx = tid + 512 * i, row = idx >> 4, ch = idx & 15;
        *(LAS u32x4*)((LAS unsigned char*)KT + row * PQ + ch * 16) = rk[i]; *(LAS u32x4*)((LAS unsigned char*)QT + row * PQ + ch * 16) = rq[i]; }
    __syncthreads();
    float off = 0.f, tot = 0.f;
#pragma unroll
    for (int s = 0; s < 4; ++s) { const float t = TOT[s * 128 + d]; tot += t; off += (s < seg) ? t : 0.f; }
    if (seg == 0) { const float dc = __expf(tot); dec_out[d] = dc; DF[d] = dc; }
#pragma unroll
    for (int jj = 0; jj < 32; ++jj) { const int pos = 32 * seg + jj, j = dir ? 127 - pos : pos; const float b = bl[jj] + off;
        const float k = bf2f(KT[j * (PQ / 2) + d]), q = bf2f(QT[j * (PQ / 2) + d]), eb = __expf(b);
        QT[j * (PQ / 2) + d] = (bf16)f2bf(q * 0.08838834764831845f * eb); KT[j * (PQ / 2) + d] = (bf16)f2bf(k * __builtin_amdgcn_rcpf(eb)); }
}
__device__ __forceinline__ void gla_g1_unit(const bf16* P, const float* wd2, const float* bd, bf16* DS, float* DEC, bf16* QKG, int cid, int h, int dir, LAS unsigned char* lds, int tid, int lane, int wave) {
    const int unit = (cid * 4 + h) * 2 + dir;
    asm volatile("" : "+v"(tid));
    u32x4 vr[8]; v_tile_issue(P, cid, h, vr, tid);
    gla_prep(P, wd2, bd, DEC + (size_t)unit * 128, cid, h, dir, lds, tid);
    v_tile_park(vr, lds + L_V, tid);
    __syncthreads();
    int t2 = tid; asm volatile("" : "+v"(t2)); (void)lane;
    const int wdb = wave >> 1, we = wave & 1, g = (t2 >> 4) & 3, li = t2 & 15, q = li >> 2, p = li & 3;
    const LAS unsigned char* QT = lds + L_QT; const LAS unsigned char* KT = lds + L_KT; const LAS unsigned char* V = lds + L_V;
    { bf16* dst = QKG + (size_t)unit * 32768;
#pragma unroll
      for (int i = 0; i < 4; ++i) { const int idx = t2 + 512 * i, row = idx >> 4, ch = idx & 15;
          *(u32x4*)(dst + row * 128 + ch * 8) = *(const LAS u32x4*)(QT + row * PQ + ch * 16); *(u32x4*)(dst + 16384 + row * 128 + ch * 8) = *(const LAS u32x4*)(KT + row * PQ + ch * 16); } }
    f32x4 acc[2][8];
#pragma unroll
    for (int dt = 0; dt < 2; ++dt)
#pragma unroll
        for (int et = 0; et < 8; ++et) acc[dt][et] = (f32x4){0.f, 0.f, 0.f, 0.f};
#pragma unroll
    for (int ks = 0; ks < 4; ++ks) { const int row = 32 * ks + 8 * g + q;
        bf16x8 X[2], Y[8];
#pragma unroll
        for (int dt = 0; dt < 2; ++dt) X[dt] = cat8(tr_read(KT + row * PQ + (32 * wdb + 16 * dt + 4 * p) * 2), tr_read(KT + (row + 4) * PQ + (32 * wdb + 16 * dt + 4 * p) * 2));
#pragma unroll
        for (int et = 0; et < 8; ++et) Y[et] = cat8(tr_read(V + row * PV + (128 * we + 16 * et + 4 * p) * 2), tr_read(V + (row + 4) * PV + (128 * we + 16 * et + 4 * p) * 2));
#pragma unroll
        for (int et = 0; et < 8; ++et) { acc[0][et] = mfma16(X[0], Y[et], acc[0][et]); acc[1][et] = mfma16(X[1], Y[et], acc[1][et]); } }
    const LAS float* DECL = (const LAS float*)(lds + L_DF);
#pragma unroll
    for (int dt = 0; dt < 2; ++dt) { const int d0 = 32 * wdb + 16 * dt + 4 * g; const f32x4 dc = *(const LAS f32x4*)(DECL + d0);
#pragma unroll
        for (int et = 0; et < 8; ++et) { const int e = 128 * we + 16 * et + li; const f32x4 v = acc[dt][et] * dc; u32x2 w; w.x = pg8::cvt_pk_bf16(v[0], v[1]); w.y = pg8::cvt_pk_bf16(v[2], v[3]); *(u32x2*)(DS + ((size_t)unit * 256 + e) * 128 + d0) = w; } }
    __syncthreads();
}
__device__ __forceinline__ int gla_chain_cid(int s, int b, int dir) { return dir ? (s < 2 ? 128 + 2 * b + (1 - s) : 32 * b + 31 - (s - 2)) : (s < 2 ? 128 + 2 * b + s : 32 * b + (s - 2)); }
__device__ __forceinline__ void gla_g2_item(const bf16* DS, const float* DEC, bf16* SP, int item) {
    const int chain = item >> 13, ed = item & 8191, b = chain >> 3, h = (chain >> 1) & 3, dir = chain & 1, e = ed >> 5, d0 = (ed & 31) * 4;
    f32x4 S = {0.f, 0.f, 0.f, 0.f};
#pragma unroll 2
    for (int s = 0; s < 34; ++s) { const int cid = gla_chain_cid(s, b, dir), unit = (cid * 4 + h) * 2 + dir; const size_t off = ((size_t)unit * 256 + e) * 128 + d0;
        const f32x4 dec = *(const f32x4*)(DEC + (size_t)unit * 128 + d0); const u32x2 dw = *(const u32x2*)(DS + off);
        const f32x4 ds = {__uint_as_float(dw.x << 16), __uint_as_float(dw.x & 0xffff0000u), __uint_as_float(dw.y << 16), __uint_as_float(dw.y & 0xffff0000u)};
        u32x2 w; w.x = pk2(S[0], S[1]); w.y = pk2(S[2], S[3]); *(u32x2*)(SP + off) = w;
        S = dec * S + ds; }
}
__device__ __forceinline__ void qk_issue(const bf16* QKG, int unit, u32x4 (&r)[8], int tid) {
#pragma unroll
    for (int i = 0; i < 8; ++i) r[i] = *(const u32x4*)(QKG + (size_t)unit * 32768 + (size_t)(tid + 512 * i) * 8);
}
__device__ __forceinline__ void qk_park(const u32x4 (&r)[8], LAS unsigned char* lds, int tid) {
#pragma unroll
    for (int i = 0; i < 8; ++i) { const int idx = tid + 512 * i; *(LAS u32x4*)(lds + L_QT + (idx >> 4) * PQ + (idx & 15) * 16) = r[i]; }
}
__device__ __forceinline__ void gla_g3_unit(const bf16* P, const bf16* QKG, const bf16* SP, const float* out_g, bf16* CAT, int cid, int h, LAS unsigned char* lds, int tid, int lane, int wave) {
    asm volatile("" : "+v"(tid));
    const int w = wave; (void)lane;
    const LAS unsigned char* QT = lds + L_QT; const LAS unsigned char* KT = lds + L_KT; LAS unsigned char* ST = lds + L_ST; const LAS unsigned char* V = lds + L_V;
    static_assert(L_KT == L_QT + 128 * PQ, "q~ and k~ tiles are adjacent");
    { u32x4 vr[8], qk[8]; v_tile_issue(P, cid, h, vr, tid); qk_issue(QKG, (cid * 4 + h) * 2, qk, tid); v_tile_park(vr, lds + L_V, tid); qk_park(qk, lds, tid); }
    __syncthreads();
    f32x4 o[16];
#pragma unroll
    for (int et = 0; et < 16; ++et) o[et] = (f32x4){0.f, 0.f, 0.f, 0.f};
    u32x4 qk1[8];
#pragma unroll
    for (int dir = 0; dir < 2; ++dir) {
        const int unit = (cid * 4 + h) * 2 + dir;
        int t2 = tid; asm volatile("" : "+v"(t2));
        const int g = (t2 >> 4) & 3, li = t2 & 15, q = li >> 2, p = li & 3;
        u32x4 sp[8];
#pragma unroll
        for (int i = 0; i < 8; ++i) sp[i] = *(const u32x4*)(SP + (size_t)unit * 32768 + (size_t)(tid + 512 * i) * 8);
        bf16x8 Yq[4];
#pragma unroll
        for (int ks = 0; ks < 4; ++ks) Yq[ks] = *(const LAS bf16x8*)(QT + (16 * w + li) * PQ + (32 * ks + 8 * g) * 2);
        bf16x8 Pf[4];
#pragma unroll
        for (int kp = 0; kp < 4; ++kp) {
            f32x4 s0 = {0.f, 0.f, 0.f, 0.f}, s1 = {0.f, 0.f, 0.f, 0.f};
            const int t0 = 2 * kp, t1 = 2 * kp + 1;
            const bool a0 = dir ? (t0 >= w) : (t0 <= w), a1 = dir ? (t1 >= w) : (t1 <= w);
            if (a0 && a1) {
                bf16x8 K0[4], K1[4];
#pragma unroll
                for (int ks = 0; ks < 4; ++ks) { K0[ks] = *(const LAS bf16x8*)(KT + (16 * t0 + li) * PQ + (32 * ks + 8 * g) * 2); K1[ks] = *(const LAS bf16x8*)(KT + (16 * t1 + li) * PQ + (32 * ks + 8 * g) * 2); }
#pragma unroll
                for (int ks = 0; ks < 4; ++ks) { s0 = mfma16(K0[ks], Yq[ks], s0); s1 = mfma16(K1[ks], Yq[ks], s1); }
            } else if (a0) {
                bf16x8 K0[4];
#pragma unroll
                for (int ks = 0; ks < 4; ++ks) K0[ks] = *(const LAS bf16x8*)(KT + (16 * t0 + li) * PQ + (32 * ks + 8 * g) * 2);
#pragma unroll
                for (int ks = 0; ks < 4; ++ks) s0 = mfma16(K0[ks], Yq[ks], s0);
            } else if (a1) {
                bf16x8 K1[4];
#pragma unroll
                for (int ks = 0; ks < 4; ++ks) K1[ks] = *(const LAS bf16x8*)(KT + (16 * t1 + li) * PQ + (32 * ks + 8 * g) * 2);
#pragma unroll
                for (int ks = 0; ks < 4; ++ks) s1 = mfma16(K1[ks], Yq[ks], s1);
            }
            if (t0 == w) {
#pragma unroll
                for (int r = 0; r < 4; ++r) { const bool keep = dir ? (4 * g + r >= li) : (4 * g + r <= li); s0[r] = keep ? s0[r] : 0.f; } }
            if (t1 == w) {
#pragma unroll
                for (int r = 0; r < 4; ++r) { const bool keep = dir ? (4 * g + r >= li) : (4 * g + r <= li); s1[r] = keep ? s1[r] : 0.f; } }
            u32x4 pw; pw.x = pg8::cvt_pk_bf16(s0[0], s0[1]); pw.y = pg8::cvt_pk_bf16(s0[2], s0[3]); pw.z = pg8::cvt_pk_bf16(s1[0], s1[1]); pw.w = pg8::cvt_pk_bf16(s1[2], s1[3]);
            Pf[kp] = __builtin_bit_cast(bf16x8, pw);
        }
#pragma unroll
        for (int kp = 0; kp < 4; ++kp) {
            const bool act = dir ? (2 * kp + 1 >= w) : (2 * kp <= w);
            if (act) {
#pragma unroll
                for (int hf = 0; hf < 2; ++hf) {
                    bf16x8 Xv[8];
#pragma unroll
                    for (int i = 0; i < 8; ++i) { const int et = 8 * hf + i; Xv[i] = cat8(tr_read(V + (32 * kp + 4 * g + q) * PV + (16 * et + 4 * p) * 2), tr_read(V + (32 * kp + 16 + 4 * g + q) * PV + (16 * et + 4 * p) * 2)); }
#pragma unroll
                    for (int i = 0; i < 8; ++i) o[8 * hf + i] = mfma16(Xv[i], Pf[kp], o[8 * hf + i]);
                }
            }
        }
        __syncthreads();
#pragma unroll
        for (int i = 0; i < 8; ++i) { const int idx = tid + 512 * i; *(LAS u32x4*)(ST + (idx >> 4) * PQ + (idx & 15) * 16) = sp[i]; }
        if (dir == 0) qk_issue(QKG, unit + 1, qk1, tid);
        __syncthreads();
#pragma unroll
        for (int ks = 0; ks < 4; ++ks)
#pragma unroll
            for (int hf = 0; hf < 2; ++hf) {
                bf16x8 Xs[8];
#pragma unroll
                for (int i = 0; i < 8; ++i) Xs[i] = *(const LAS bf16x8*)(ST + (16 * (8 * hf + i) + li) * PQ + (32 * ks + 8 * g) * 2);
#pragma unroll
                for (int i = 0; i < 8; ++i) o[8 * hf + i] = mfma16(Xs[i], Yq[ks], o[8 * hf + i]);
            }
        __syncthreads();
        if (dir == 0) { qk_park(qk1, lds, tid); __syncthreads(); }
    }
    int t3 = tid; asm volatile("" : "+v"(t3));
    const int g = (t3 >> 4) & 3, li = t3 & 15;
    float ss = 0.f;
#pragma unroll
    for (int et = 0; et < 16; ++et) ss += (o[et][0] * o[et][0] + o[et][1] * o[et][1]) + (o[et][2] * o[et][2] + o[et][3] * o[et][3]);
    ss += __shfl_xor(ss, 16); ss += __shfl_xor(ss, 32);
    const float rstd = rsqrtf(ss * (1.f / 256.f) + EPS);
    const size_t row = (size_t)cid * CH + 16 * w + li;
#pragma unroll
    for (int et = 0; et < 16; ++et) { const int e0 = h * 256 + 16 * et + 4 * g; const f32x4 gg = *(const f32x4*)(out_g + e0); const u32x2 gw = *(const u32x2*)(P + row * NP + C_G + e0);
        const float g0 = __uint_as_float(gw.x << 16), g1 = __uint_as_float(gw.x & 0xffff0000u), g2 = __uint_as_float(gw.y << 16), g3 = __uint_as_float(gw.y & 0xffff0000u);
        u32x2 ow; ow.x = pk2(o[et][0] * rstd * gg[0] * silu_acc(g0), o[et][1] * rstd * gg[1] * silu_acc(g1)); ow.y = pk2(o[et][2] * rstd * gg[2] * silu_acc(g2), o[et][3] * rstd * gg[3] * silu_acc(g3));
        *(u32x2*)(CAT + row * D + 1024 + e0) = ow; }
}

__device__ __forceinline__ void gmlp_unit_fast(const bf16* P, bf16* CAT, const float* ln_g, const float* ln_b, const bf16* WSB, const float* bs, int cid, int h, LAS unsigned char* lds, int tid, int wave) {
    asm volatile("" : "+v"(tid));
    LAS unsigned char* VL = lds;
    const int g = (tid >> 4) & 3, li = tid & 15, q = li >> 2, p = li & 3, w = wave;
    const size_t row = (size_t)cid * CH + 16 * w + li;
    bf16x8 Yw[4]; u32x2 uw[8];
#pragma unroll
    for (int ks = 0; ks < 4; ++ks) Yw[ks] = *(const bf16x8*)(WSB + ((size_t)(h * CH + 16 * w + li)) * CH + 32 * ks + 8 * g);
#pragma unroll
    for (int dt = 0; dt < 8; ++dt) uw[dt] = *(const u32x2*)(P + row * NP + C_U + h * 128 + 16 * dt + 4 * g);
    const float bsv = bs[h * CH + 16 * w + li];
    { const int j = tid >> 2, qd = tid & 3; const bf16* vp = P + (size_t)(cid * CH + j) * NP + C_V + h * 128 + qd * 32;
      float v[32]; float s = 0.f;
#pragma unroll
      for (int i = 0; i < 4; ++i) { const u32x4 w = *(const u32x4*)(vp + 8 * i);
#pragma unroll
          for (int e = 0; e < 4; ++e) { v[8 * i + 2 * e] = __uint_as_float(w[e] << 16); v[8 * i + 2 * e + 1] = __uint_as_float(w[e] & 0xffff0000u); } }
#pragma unroll
      for (int i = 0; i < 32; ++i) s += v[i];
      s += __shfl_xor(s, 1); s += __shfl_xor(s, 2); const float mu = s * (1.f / 128.f); float q = 0.f;
#pragma unroll
      for (int i = 0; i < 32; ++i) { v[i] -= mu; q += v[i] * v[i]; }
      q += __shfl_xor(q, 1); q += __shfl_xor(q, 2); const float rstd = rsqrtf(q * (1.f / 128.f) + EPS);
      const float* gp = ln_g + h * 128 + qd * 32; const float* bp = ln_b + h * 128 + qd * 32;
#pragma unroll
      for (int i = 0; i < 4; ++i) { const f32x4 g0 = *(const f32x4*)(gp + 8 * i), g1 = *(const f32x4*)(gp + 8 * i + 4), b0 = *(const f32x4*)(bp + 8 * i), b1 = *(const f32x4*)(bp + 8 * i + 4);
          u32x4 o; o.x = pk2(v[8 * i + 0] * rstd * g0[0] + b0[0], v[8 * i + 1] * rstd * g0[1] + b0[1]); o.y = pk2(v[8 * i + 2] * rstd * g0[2] + b0[2], v[8 * i + 3] * rstd * g0[3] + b0[3]);
          o.z = pk2(v[8 * i + 4] * rstd * g1[0] + b1[0], v[8 * i + 5] * rstd * g1[1] + b1[1]); o.w = pk2(v[8 * i + 6] * rstd * g1[2] + b1[2], v[8 * i + 7] * rstd * g1[3] + b1[3]);
          *(LAS u32x4*)(VL + j * PQ + (qd * 32 + 8 * i) * 2) = o; } }
    __syncthreads();
    f32x4 acc[8];
#pragma unroll
    for (int dt = 0; dt < 8; ++dt) acc[dt] = (f32x4){0.f, 0.f, 0.f, 0.f};
#pragma unroll
    for (int ks = 0; ks < 4; ++ks) {
        bf16x8 X[8];
#pragma unroll
        for (int dt = 0; dt < 8; ++dt) X[dt] = cat8(tr_read(VL + (32 * ks + 8 * g + q) * PQ + (16 * dt + 4 * p) * 2), tr_read(VL + (32 * ks + 8 * g + q + 4) * PQ + (16 * dt + 4 * p) * 2));
#pragma unroll
        for (int dt = 0; dt < 8; ++dt) acc[dt] = mfma16(X[dt], Yw[ks], acc[dt]);
    }
#pragma unroll
    for (int dt = 0; dt < 8; ++dt) { const int c0 = h * 128 + 16 * dt + 4 * g;
        const float u0 = __uint_as_float(uw[dt].x << 16), u1 = __uint_as_float(uw[dt].x & 0xffff0000u), u2 = __uint_as_float(uw[dt].y << 16), u3 = __uint_as_float(uw[dt].y & 0xffff0000u);
        u32x2 ow; ow.x = pk2(u0 * (acc[dt][0] + bsv), u1 * (acc[dt][1] + bsv)); ow.y = pk2(u2 * (acc[dt][2] + bsv), u3 * (acc[dt][3] + bsv));
        *(u32x2*)(CAT + row * D + c0) = ow; }
    __syncthreads();
}

constexpr int NPH = 2 + 9 * NL;
struct Args { const float* in[23]; float* out; unsigned char* ws; int ph_lo, ph_hi, li, pad; };

#ifndef DUP_MASK
#define DUP_MASK 0
#endif
#define REP(bit) for (int rep_ = 0; rep_ < (((DUP_MASK) >> (bit)) & 1) + 1; ++rep_)
#define IN(k) (lo <= (k) && (k) < hi)
#define PHASE_IDS() int tid = tid0; asm volatile("" : "+v"(tid)); const int lane = tid & 63, wave = __builtin_amdgcn_readfirstlane(tid >> 6), gw = bid * 8 + wave, ngw = G * 8; (void)lane; (void)gw; (void)ngw
#define SEAM(k) do { if (IN(k) && IN((k) + 1)) xcd_barrier(bar); } while (0)
template <int l> __device__ __forceinline__ void run_layer(const Args& a, LAS unsigned char* lds, const XcdBarrier& bar, int tid0, int G, int bid, int lo, int hi) {
    unsigned char* ws = a.ws;
    const float* x = a.in[0]; const float* ctx = a.in[2];
    const float* g_pre_mix = a.in[6]; const float* g_post_mix = a.in[7]; const float* g_pre_ffn = a.in[8]; const float* g_post_ffn = a.in[9];
    const float* ln_g = a.in[11]; const float* ln_b = a.in[12]; const float* gws = a.in[13]; const float* gbs = a.in[14];
    const float* wd2f = a.in[15]; const float* bdf = a.in[16]; const float* wd2b = a.in[17]; const float* bdb = a.in[18];
    const float* out_g = a.in[19];
    float* MOD = (float*)(ws + WS_MOD); bf16* WIN = (bf16*)(ws + WS_WIN); bf16* WOUT = (bf16*)(ws + WS_WOUT); bf16* WFI = (bf16*)(ws + WS_WFI); bf16* WFO = (bf16*)(ws + WS_WFO);
    float* X = (float*)(ws + WS_X); bf16* H = (bf16*)(ws + WS_H); bf16* P = (bf16*)(ws + WS_P); bf16* CAT = (bf16*)(ws + WS_CAT); bf16* Y = (bf16*)(ws + WS_Y); bf16* HID = (bf16*)(ws + WS_HID);
    bf16* DS = (bf16*)(ws + WS_DS); bf16* SP = (bf16*)(ws + WS_SP); float* DEC = (float*)(ws + WS_DEC); bf16* WSB = (bf16*)(ws + WS_WSB); bf16* QKG = (bf16*)(ws + WS_QK); float* YP = (float*)(ws + WS_YP);
        const int pb = 2 + 9 * l;
        constexpr bool LAST = (l == NL - 1);
        constexpr int NCH_OUT = LAST ? MX / CH : NCHUNK, MROWS = LAST ? MX : M;
        const float* modl = MOD + (size_t)l * 5 * NMOD;
        if (IN(pb + 0)) REP(1) { pg8::Gemm g{H, WIN + (size_t)l * NP * D, M, NP, D, D}; pg8::StaticOrder S; S.init(M, NP, G, bid); pg8::EpiProj E{P, NP, 8};
            pg8::gemm_phase<pg8::EpiProj, pg8::StaticOrder, true, true>(lds, g, S, E); }
        SEAM(pb + 0);
        if (IN(pb + 1)) REP(2) { PHASE_IDS();
            for (int u = bid; u < NCH_OUT * 8; u += G)
                gmlp_unit_fast(P, CAT, ln_g + l * 1024, ln_b + l * 1024, WSB + (size_t)l * 8 * CH * CH, gbs + l * 8 * CH, u >> 3, u & 7, lds, tid, wave);
            for (int u = bid; u < NCHUNK * 8; u += G) { const int dir = u & 1, h = (u >> 1) & 3, cid = u >> 3;
                gla_g1_unit(P, (dir ? wd2b : wd2f) + l * 16 * 512, (dir ? bdb : bdf) + l * 512, DS, DEC, QKG, cid, h, dir, lds, tid, lane, wave); }
        }
        SEAM(pb + 1);
        if (IN(pb + 2)) REP(3) { PHASE_IDS();
            for (int it = bid * 512 + tid; it < 32 * 8192; it += G * 512) gla_g2_item(DS, DEC, SP, it);
        }
        SEAM(pb + 2);
        if (IN(pb + 3)) REP(4) { PHASE_IDS();
            for (int u = bid; u < NCH_OUT * 4; u += G)
                gla_g3_unit(P, QKG, SP, out_g + l * 1024, CAT, u >> 2, u & 3, lds, tid, lane, wave);
        }
        SEAM(pb + 3);
        if (IN(pb + 4)) REP(5) { { pg8::Gemm g{CAT, WOUT + (size_t)l * D * D, MX, D, D, D}; pg8::StaticOrder S; S.init(MX, D, G, bid); pg8::EpiProj E{Y, D, 0};
              pg8::gemm_phase<pg8::EpiProj, pg8::StaticOrder, true, true>(lds, g, S, E); }
            if (!LAST) { pg8::Gemm g{CAT + (size_t)MX * D, WOUT + (size_t)l * D * D, MC, D, D, D}; pg8::SplitOrder S; S.init(MC / 256, D / 256, D / 64, bid); pg8::EpiPartF32 E{YP, D, 0, (size_t)MC * D};
              pg8::gemm_phase<pg8::EpiPartF32, pg8::SplitOrder, false, true>(lds, g, S, E); } }
        SEAM(pb + 4);
        if (IN(pb + 5)) { PHASE_IDS();
            RowArgs r{}; r.xin_x = l == 0 ? x : nullptr; r.xin_c = l == 0 ? ctx : nullptr; r.Y = Y; r.YP = LAST ? nullptr : YP; r.X = X; r.H = H; r.modA = modl; r.gA = g_post_mix + l * D; r.gB = g_pre_ffn + l * D; r.mode = 1; r.write_h = 1;
            row_phase(r, MROWS, lds, tid, lane, gw, ngw);
        }
        SEAM(pb + 5);
        if (IN(pb + 6)) REP(6) { pg8::Gemm g{H, WFI + (size_t)l * 2 * FF * D, MROWS, 2 * FF, D, D}; pg8::StaticOrder S; S.init(MROWS, 2 * FF, G, bid); pg8::EpiSwiglu E{HID, FF};
            pg8::gemm_phase<pg8::EpiSwiglu, pg8::StaticOrder, true, true>(lds, g, S, E); }
        SEAM(pb + 6);
        if (IN(pb + 7)) REP(7) { { pg8::Gemm g{HID, WFO + (size_t)l * D * FF, MX, D, FF, FF}; pg8::StaticOrder S; S.init(MX, D, G, bid); pg8::EpiProj E{Y, D, 0};
              pg8::gemm_phase<pg8::EpiProj, pg8::StaticOrder, true, true>(lds, g, S, E); }
            if (!LAST) { pg8::Gemm g{HID + (size_t)MX * FF, WFO + (size_t)l * D * FF, MC, D, FF, FF}; pg8::SplitOrder S; S.init(MC / 256, D / 256, FF / 64, bid); pg8::EpiPartF32 E{YP, D, 0, (size_t)MC * D};
              pg8::gemm_phase<pg8::EpiPartF32, pg8::SplitOrder, false, true>(lds, g, S, E); } }
        SEAM(pb + 7);
        if (IN(pb + 8)) { PHASE_IDS();
            RowArgs r{}; r.Y = Y; r.YP = LAST ? nullptr : YP; r.X = X; r.out = a.out; r.H = H; r.modA = modl; r.modB = modl + 5 * NMOD; r.gA = g_post_ffn + l * D; r.gB = g_pre_mix + (l + 1 < NL ? l + 1 : l) * D; r.mode = 2; r.write_h = (l + 1 < NL); r.to_out = (l + 1 == NL);
            row_phase(r, MROWS, lds, tid, lane, gw, ngw);
        }
        SEAM(pb + 8);
}
__global__ void __launch_bounds__(512, 2) mega(Args a) {
    extern __shared__ __attribute__((aligned(16))) unsigned char lds_raw[];
    LAS unsigned char* lds = (LAS unsigned char*)lds_raw;
    const int tid0 = threadIdx.x;
    const int G = gridDim.x, bid = blockIdx.x;
    volatile LAS unsigned* MISC = (volatile LAS unsigned*)(lds + MISC_OFF);
    if (tid0 < 32) MISC[tid0] = 0u;
    __syncthreads();
    unsigned char* ws = a.ws;
    const int lo = a.ph_lo, hi = a.ph_hi;
    XcdBarrier bar; bar.bar = (unsigned*)(ws + WS_CTL) + CW_BAR + a.li * XCD_BAR_WORDS; bar.x = 0; bar.st = nullptr;
    if (hi - lo > 1) bar = xcd_barrier_post((unsigned*)(ws + WS_CTL) + CW_BAR + a.li * XCD_BAR_WORDS, MISC + 8);
    const float* x = a.in[0]; const float* c = a.in[1]; const float* ctx = a.in[2]; const float* cctx = a.in[3];
    const float* w_mod = a.in[4]; const float* b_mod = a.in[5];
    const float* g_pre_mix = a.in[6]; const float* g_post_mix = a.in[7]; const float* g_pre_ffn = a.in[8]; const float* g_post_ffn = a.in[9];
    const float* w_in = a.in[10]; const float* ln_g = a.in[11]; const float* ln_b = a.in[12]; const float* gws = a.in[13]; const float* gbs = a.in[14];
    const float* wd2f = a.in[15]; const float* bdf = a.in[16]; const float* wd2b = a.in[17]; const float* bdb = a.in[18];
    const float* out_g = a.in[19]; const float* w_out = a.in[20]; const float* w_fi = a.in[21]; const float* w_fo = a.in[22];
    float* MOD = (float*)(ws + WS_MOD); bf16* WIN = (bf16*)(ws + WS_WIN); bf16* WOUT = (bf16*)(ws + WS_WOUT); bf16* WFI = (bf16*)(ws + WS_WFI); bf16* WFO = (bf16*)(ws + WS_WFO);
    float* X = (float*)(ws + WS_X); bf16* H = (bf16*)(ws + WS_H); bf16* P = (bf16*)(ws + WS_P); bf16* CAT = (bf16*)(ws + WS_CAT); bf16* Y = (bf16*)(ws + WS_Y); bf16* HID = (bf16*)(ws + WS_HID);
    bf16* DS = (bf16*)(ws + WS_DS); bf16* SP = (bf16*)(ws + WS_SP); float* DEC = (float*)(ws + WS_DEC); bf16* WSB = (bf16*)(ws + WS_WSB); bf16* QKG = (bf16*)(ws + WS_QK); float* YP = (float*)(ws + WS_YP);

    if (IN(0)) REP(0) { PHASE_IDS();
        LAS float* act = (LAS float*)(lds + 8 * 8448);
        for (int i = tid; i < 5 * D; i += 512) { const int r = i / D, k = i % D; const float v = r < NB ? c[r * D + k] : cctx[k]; act[i] = silu_acc(v); }
        __syncthreads();
        for (int item = wave * G + bid; item < NL * (NMOD / 32); item += ngw) {
            const int cg = item % (NMOD / 32), l = item / (NMOD / 32), kq = lane >> 3;
            const int j = cg * 32 + 4 * (lane & 7);
            const float* w = w_mod + ((size_t)l * D + kq) * NMOD + j;
            f32x4 a0 = {0.f, 0.f, 0.f, 0.f}, a1 = a0, a2 = a0, a3 = a0, a4 = a0;
#pragma unroll 8
            for (int i = 0; i < D / 8; ++i) { const f32x4 xv = __builtin_nontemporal_load((const f32x4*)(w + (size_t)(8 * i) * NMOD)); const int k = 8 * i + kq;
                a0 += xv * act[0 * D + k]; a1 += xv * act[1 * D + k]; a2 += xv * act[2 * D + k]; a3 += xv * act[3 * D + k]; a4 += xv * act[4 * D + k]; }
#pragma unroll
            for (int t = 0; t < 4; ++t) {
#pragma unroll
                for (int o = 8; o < 64; o <<= 1) { a0[t] += __shfl_xor(a0[t], o); a1[t] += __shfl_xor(a1[t], o); a2[t] += __shfl_xor(a2[t], o); a3[t] += __shfl_xor(a3[t], o); a4[t] += __shfl_xor(a4[t], o); } }
            if (kq == 0) { const f32x4 bb = *(const f32x4*)(b_mod + (size_t)l * NMOD + j); float* o = MOD + (size_t)l * 5 * NMOD + j;
                *(f32x4*)(o) = a0 + bb; *(f32x4*)(o + NMOD) = a1 + bb; *(f32x4*)(o + 2 * NMOD) = a2 + bb; *(f32x4*)(o + 3 * NMOD) = a3 + bb; *(f32x4*)(o + 4 * NMOD) = a4 + bb; }
        }
        for (int it = bid * 512 + tid; it < NL * 8 * CH * CH / 8; it += G * 512) { const f32x4 a0 = *(const f32x4*)(gws + (size_t)it * 8), a1 = *(const f32x4*)(gws + (size_t)it * 8 + 4);
            u32x4 o; o.x = pk2(a0[0], a0[1]); o.y = pk2(a0[2], a0[3]); o.z = pk2(a1[0], a1[1]); o.w = pk2(a1[2], a1[3]); *(u32x4*)(WSB + (size_t)it * 8) = o; }
        LAS float* scr = (LAS float*)(lds + wave * 8448);
        int it0 = 0;
        conv_matrix(w_in, WIN, D, PIN, NP, 1, it0, gw, ngw, scr, lane);
        conv_matrix(w_out, WOUT, D, D, D, 0, it0, gw, ngw, scr, lane);
        conv_matrix(w_fi, WFI, D, 2 * FF, 2 * FF, 2, it0, gw, ngw, scr, lane);
        conv_matrix(w_fo, WFO, FF, D, D, 0, it0, gw, ngw, scr, lane);
    }
    SEAM(0);
    if (IN(1)) { PHASE_IDS();
        RowArgs r{}; r.xin_x = x; r.xin_c = ctx; r.X = X; r.H = H; r.modB = MOD; r.gB = g_pre_mix; r.mode = 0; r.write_h = 1;
        row_phase(r, M, lds, tid, lane, gw, ngw);
    }
    SEAM(1);
    run_layer<0>(a, lds, bar, tid0, G, bid, lo, hi);
    run_layer<1>(a, lds, bar, tid0, G, bid, lo, hi);
    run_layer<2>(a, lds, bar, tid0, G, bid, lo, hi);
    run_layer<3>(a, lds, bar, tid0, G, bid, lo, hi);
#undef IN
#undef SEAM
}

#ifndef MK_SPLIT
#define MK_SPLIT 0
#endif
extern "C" void kernel_launch(void* const* d_in, const int* in_sizes, int n_in, void* d_out, int out_size, void* d_ws, size_t ws_size, hipStream_t stream) {
    static int grid = 0;
    if (grid == 0) {
        if (n_in != 23 || ws_size < WS_END || out_size != MX * D) { fprintf(stderr, "kernel_launch: unexpected shapes (n_in %d, ws %zu, out %d)\n", n_in, ws_size, out_size); grid = -1; return; }
        int dev = 0, cus = 0, per_cu = 0;
        if (hipGetDevice(&dev) != hipSuccess || hipDeviceGetAttribute(&cus, hipDeviceAttributeMultiprocessorCount, dev) != hipSuccess) { grid = -1; return; }
        if (hipFuncSetAttribute((const void*)mega, hipFuncAttributeMaxDynamicSharedMemorySize, LDS_BYTES) != hipSuccess) { fprintf(stderr, "kernel_launch: hipFuncSetAttribute failed\n"); grid = -1; return; }
        if (hipOccupancyMaxActiveBlocksPerMultiprocessor(&per_cu, (const void*)mega, 512, LDS_BYTES) != hipSuccess || per_cu < 1) { fprintf(stderr, "kernel_launch: occupancy query says %d\n", per_cu); }
        (void)hipGetLastError();
        grid = cus;
    }
    if (grid < 0) return;
    (void)hipMemsetAsync((char*)d_ws + WS_CTL, 0, ZERO_BYTES, stream);
    Args a{};
    for (int i = 0; i < 23; ++i) a.in[i] = (const float*)d_in[i];
    a.out = (float*)d_out; a.ws = (unsigned char*)d_ws;
#if MK_SPLIT
    for (int p = 0; p < NPH; ++p) { a.ph_lo = p; a.ph_hi = p + 1; a.li = 0; hipLaunchKernelGGL(mega, dim3(grid), dim3(512), LDS_BYTES, stream, a); }
#else
    a.ph_lo = 0; a.ph_hi = NPH; a.li = 0;
    hipLaunchKernelGGL(mega, dim3(grid), dim3(512), LDS_BYTES, stream, a);
#endif
}
```

```cpp
#include <hip/hip_runtime.h>
#include <cstdio>
#include <cstdint>
namespace pg8 {
#define PG8_LAS __attribute__((address_space(3)))
typedef unsigned short bf16_t;
typedef short bf16x8 __attribute__((ext_vector_type(8)));
typedef float f32x4 __attribute__((ext_vector_type(4)));
typedef unsigned u32x4 __attribute__((ext_vector_type(4)));
constexpr int BM = 256, BK = 64, HALF = 128, HTB = HALF * BK * 2  , STAGE_BYTES = 8 * HTB, NXCD = 8, WGM = 8;

__host__ __device__ __forceinline__ int lds_byte(int r, int c) { const int st = (r >> 4) * 2 + (c >> 5), rr = r & 15, cc = c & 31, ob = rr * 64 + cc * 2; return st * 1024 + (ob ^ (((ob >> 9) & 1) << 5)); }
__host__ __device__ __forceinline__ void stage_rc(int b, int& R, int& C) { const int st = b / 1024, sb = b % 1024, swz = sb ^ (((sb >> 9) & 1) << 5); R = (st >> 1) * 16 + swz / 64; C = (st & 1) * 32 + (swz % 64) / 2; }
__host__ __device__ __forceinline__ int perm32(int rho) { const int n = rho >> 4, i = rho & 15; return 8 * (i >> 2) + 4 * n + (i & 3); }

struct Unit { int pm, pn, koff, ks; };
struct Gemm { const bf16_t* A; const bf16_t* Bt; int M, N, K, ld; };

struct StaticOrder {
    int nM, nN, nwg, G, c;
    __host__ __device__ void init(int M, int N, int G_, int c_) { nM = M / BM; nN = N / BM; nwg = nM * nN; G = G_; c = c_; }
    __host__ __device__ bool next(int i, Unit& u) const {
        const long L = (long)i * G + c; if (L >= nwg) return false;
        int wgid = (int)L; { const int q = nwg / NXCD, r = nwg % NXCD, xcd = wgid % NXCD, off = wgid / NXCD; wgid = (xcd < r ? xcd * (q + 1) : r * (q + 1) + (xcd - r) * q) + off; }
        const int nig = WGM * nN, gid = wgid / nig, fm = gid * WGM, gsz = (nM - fm) < WGM ? (nM - fm) : WGM;
        u.pm = fm + ((wgid % nig) % gsz); u.pn = (wgid % nig) / gsz; u.koff = 0; u.ks = 0; return true;
    }
    __device__ __forceinline__ void a_ready(const Unit&) const {}
    __device__ __forceinline__ void done(const Unit&) const {}
    __device__ __forceinline__ int nt(int full) const { return full; }
};
struct SplitOrder {
    int nN, ntiles, c, kt0, ktn;
    __host__ __device__ void init(int nM, int nN_, int KT, int c_) { nN = nN_; ntiles = nM * nN_; c = c_; const int ks = c / ntiles, base = (KT / 8) & ~1, rem = KT - 8 * base, nbig = rem / 2;
        ktn = base + (ks >= 8 - nbig ? 2 : 0); kt0 = ks * base + (ks > 8 - nbig ? 2 * (ks - (8 - nbig)) : 0); }
    __host__ __device__ bool next(int i, Unit& u) const { if (i != 0 || c >= 8 * ntiles) return false; const int t = c % ntiles; u.pm = t / nN; u.pn = t % nN; u.ks = c / ntiles; u.koff = kt0 * BK * 2; return true; }
    __device__ __forceinline__ void a_ready(const Unit&) const {}
    __device__ __forceinline__ void done(const Unit&) const {}
    __device__ __forceinline__ int nt(int) const { return ktn; }
};


__device__ __forceinline__ unsigned cvt_pk_bf16(float lo, float hi) { unsigned r; asm volatile("v_cvt_pk_bf16_f32 %0, %1, %2" : "=v"(r) : "v"(lo), "v"(hi)); return r; }
__device__ __forceinline__ float fast_sigmoid(float x) { return __builtin_amdgcn_rcpf(1.0f + __builtin_amdgcn_exp2f(-1.4426950408889634f * x)); }
__device__ __forceinline__ float gelu_tanh(float x) { const float y = 1.5957691216057308f * (x + 0.044715f * x * x * x); return x * fast_sigmoid(y); }
__device__ __forceinline__ float silu_f(float x) { return x * fast_sigmoid(x); }

struct EpiF32 {
    static constexpr bool PERM = false, AFTER_DRAIN = false;
    float* C; int ldc; int pad;
    __device__ __forceinline__ void operator()(const f32x4 (&acc)[2][2][4][2], const Unit& u, int wr, int wc, int fr, int fq) const {
        const int row0 = u.pm * BM + wr * 64 + fr, col0 = u.pn * BM + wc * 32 + 4 * fq;
#pragma unroll
        for (int ai = 0; ai < 2; ++ai)
#pragma unroll
            for (int m = 0; m < 4; ++m) { float* rowp = C + (size_t)(row0 + ai * HALF + m * 16) * ldc + col0;
#pragma unroll
                for (int bj = 0; bj < 2; ++bj)
#pragma unroll
                    for (int n = 0; n < 2; ++n) *(f32x4*)(rowp + bj * HALF + n * 16) = acc[ai][bj][m][n]; }
    }
};
struct EpiPartF32 {
    static constexpr bool PERM = false, AFTER_DRAIN = false;
    float* C; int ldc; int pad; size_t split_stride;
    __device__ __forceinline__ void operator()(const f32x4 (&acc)[2][2][4][2], const Unit& u, int wr, int wc, int fr, int fq) const {
        const int row0 = u.pm * BM + wr * 64 + fr, col0 = u.pn * BM + wc * 32 + 4 * fq; float* base = C + (size_t)u.ks * split_stride;
#pragma unroll
        for (int ai = 0; ai < 2; ++ai)
#pragma unroll
            for (int m = 0; m < 4; ++m) { float* rowp = base + (size_t)(row0 + ai * HALF + m * 16) * ldc + col0;
#pragma unroll
                for (int bj = 0; bj < 2; ++bj)
#pragma unroll
                    for (int n = 0; n < 2; ++n) *(f32x4*)(rowp + bj * HALF + n * 16) = acc[ai][bj][m][n]; }
    }
};
struct EpiProj {
    static constexpr bool PERM = true, AFTER_DRAIN = false;
    bf16_t* O; int ldc; int ngelu;
    __device__ __forceinline__ void operator()(const f32x4 (&acc)[2][2][4][2], const Unit& u, int wr, int wc, int fr, int fq) const {
        const int row0 = u.pm * BM + wr * 64 + fr, col0 = u.pn * BM + wc * 32 + 8 * fq;
        const bool act = u.pn < ngelu;
#pragma unroll
        for (int ai = 0; ai < 2; ++ai)
#pragma unroll
            for (int m = 0; m < 4; ++m) { bf16_t* rowp = O + (size_t)(row0 + ai * HALF + m * 16) * ldc + col0;
#pragma unroll
                for (int bj = 0; bj < 2; ++bj) { f32x4 v0 = acc[ai][bj][m][0], v1 = acc[ai][bj][m][1];
                    if (act) {
#pragma unroll
                        for (int j = 0; j < 4; ++j) { v0[j] = gelu_tanh(v0[j]); v1[j] = gelu_tanh(v1[j]); } }
                    u32x4 w; w.x = cvt_pk_bf16(v0[0], v0[1]); w.y = cvt_pk_bf16(v0[2], v0[3]); w.z = cvt_pk_bf16(v1[0], v1[1]); w.w = cvt_pk_bf16(v1[2], v1[3]);
                    *(u32x4*)(rowp + bj * HALF) = w; } }
    }
};
struct EpiSwiglu {
    static constexpr bool PERM = true, AFTER_DRAIN = false;
    bf16_t* O; int ldc; int pad;
    __device__ __forceinline__ void operator()(const f32x4 (&acc)[2][2][4][2], const Unit& u, int wr, int wc, int fr, int fq) const {
        const int row0 = u.pm * BM + wr * 64 + fr, col0 = u.pn * HALF + wc * 32 + 8 * fq;
#pragma unroll
        for (int ai = 0; ai < 2; ++ai)
#pragma unroll
            for (int m = 0; m < 4; ++m) { bf16_t* rowp = O + (size_t)(row0 + ai * HALF + m * 16) * ldc + col0;
                f32x4 h0, h1;
#pragma unroll
                for (int j = 0; j < 4; ++j) { h0[j] = silu_f(acc[ai][0][m][0][j]) * acc[ai][1][m][0][j]; h1[j] = silu_f(acc[ai][0][m][1][j]) * acc[ai][1][m][1][j]; }
                u32x4 w; w.x = cvt_pk_bf16(h0[0], h0[1]); w.y = cvt_pk_bf16(h0[2], h0[3]); w.z = cvt_pk_bf16(h1[0], h1[1]); w.w = cvt_pk_bf16(h1[2], h1[3]);
                *(u32x4*)rowp = w; }
    }
};

template <class Epi, class Sched, bool ALIGN_EPI = false, bool SP2 = false>
__device__ __forceinline__ void gemm_phase(PG8_LAS unsigned char* lds, const Gemm g, const Sched& S, const Epi& E) {
    int tid_o = threadIdx.x; asm volatile("" : "+v"(tid_o));
    const int tid = tid_o, wid = __builtin_amdgcn_readfirstlane(tid >> 6), lane = tid & 63, wr = wid >> 2, wc = wid & 3, fr = lane & 15, fq = lane >> 4;
    const int K = g.ld, nt = S.nt(g.K / BK);
    unsigned voffA[2], voffB[2];
#pragma unroll
    for (int i = 0; i < 2; ++i) { int R, C; stage_rc(tid * 16 + i * 8192, R, C); const int Rb = Epi::PERM ? ((R & ~31) + perm32(R & 31)) : R;
        voffA[i] = (unsigned)(R * K + C) * 2u; voffB[i] = (unsigned)(Rb * K + C) * 2u; }
    const size_t kstep = (size_t)(BK * 2);
    const size_t hstep = (size_t)HALF * K * 2;
    const size_t tstep = 2 * hstep;
    const unsigned ldsw = (unsigned)wid * 1024u;
    const int aoff = lds_byte(wr * 64 + fr, fq * 8), boff = lds_byte(wc * 32 + fr, fq * 8);
#define PG8_SA(b, h) (((b) * 2 + (h)) * HTB)
#define PG8_SB(b, h) ((4 + (b) * 2 + (h)) * HTB)
#define PG8_STAGE(bufoff, gbase, voff) do { _Pragma("unroll") for (int _i = 0; _i < 2; ++_i) \
        __builtin_amdgcn_global_load_lds((const unsigned*)((const char*)(gbase) + (voff)[_i]), (PG8_LAS unsigned*)(lds + (bufoff) + ldsw + _i * 8192), 16, 0, 0); } while (0)
#define PG8_LDA(dst, b, h) do { _Pragma("unroll") for (int m = 0; m < 4; ++m) _Pragma("unroll") for (int k = 0; k < 2; ++k) dst[m][k] = *(const PG8_LAS bf16x8*)(lds + PG8_SA(b, h) + aoff + m * 2048 + k * 1024); } while (0)
#define PG8_LDB(dst, b, h) do { _Pragma("unroll") for (int n = 0; n < 2; ++n) _Pragma("unroll") for (int k = 0; k < 2; ++k) dst[n][k] = *(const PG8_LAS bf16x8*)(lds + PG8_SB(b, h) + boff + n * 2048 + k * 1024); } while (0)
#define PG8_MMA(ai, bj, At, Bt) do { __builtin_amdgcn_s_setprio(1); _Pragma("unroll") for (int m = 0; m < 4; ++m) _Pragma("unroll") for (int n = 0; n < 2; ++n) _Pragma("unroll") for (int k = 0; k < 2; ++k) \
        acc[ai][bj][m][n] = __builtin_amdgcn_mfma_f32_16x16x32_bf16(Bt[n][k], At[m][k], acc[ai][bj][m][n], 0, 0, 0); __builtin_amdgcn_s_setprio(0); } while (0)
#define PG8_WAIT_V(n) asm volatile("s_waitcnt vmcnt(" #n ")" ::: "memory")
#define PG8_WAIT_L(n) asm volatile("s_waitcnt lgkmcnt(" #n ")" ::: "memory")
#define PG8_BAR __builtin_amdgcn_s_barrier()
#define PG8_SCHED __builtin_amdgcn_sched_barrier(0)
    Unit cur, nxt; int ui = 0;
    if (!S.next(0, cur)) return;
    f32x4 acc[2][2][4][2];
#pragma unroll
    for (int a = 0; a < 2; ++a)
#pragma unroll
        for (int b = 0; b < 2; ++b)
#pragma unroll
            for (int m = 0; m < 4; ++m)
#pragma unroll
                for (int n = 0; n < 2; ++n) acc[a][b][m][n] = (f32x4){0.f, 0.f, 0.f, 0.f};
    bf16x8 At[4][2], B0[2][2], B1[2][2];
    const char* cA = (const char*)g.A + (size_t)cur.pm * tstep + cur.koff; const char* cB = (const char*)g.Bt + (size_t)cur.pn * tstep + cur.koff;
    S.a_ready(cur);
    if constexpr (SP2) {
        PG8_STAGE(PG8_SB(0, 0), cB, voffB); PG8_STAGE(PG8_SB(0, 1), cB + hstep, voffB); PG8_STAGE(PG8_SA(0, 0), cA, voffA); PG8_STAGE(PG8_SA(0, 1), cA + hstep, voffA);
        if (wr == 1) PG8_BAR;
        PG8_WAIT_V(2); PG8_BAR;
        PG8_STAGE(PG8_SB(1, 0), cB + kstep, voffB); PG8_STAGE(PG8_SA(1, 0), cA + kstep, voffA); PG8_STAGE(PG8_SB(1, 1), cB + hstep + kstep, voffB);
        PG8_WAIT_V(6); PG8_BAR;
    } else {
        PG8_STAGE(PG8_SB(0, 0), cB, voffB); PG8_STAGE(PG8_SA(0, 0), cA, voffA); PG8_STAGE(PG8_SB(0, 1), cB + hstep, voffB); PG8_STAGE(PG8_SA(0, 1), cA + hstep, voffA);
        if (wr == 1) PG8_BAR;
        PG8_WAIT_V(4); PG8_BAR;
        PG8_STAGE(PG8_SB(1, 0), cB + kstep, voffB); PG8_STAGE(PG8_SA(1, 0), cA + kstep, voffA); PG8_STAGE(PG8_SB(1, 1), cB + hstep + kstep, voffB);
        PG8_WAIT_V(6); PG8_BAR;
    }
    for (;;) {
        const bool has_next = S.next(ui + 1, nxt);
        const char* nA = has_next ? (const char*)g.A + (size_t)nxt.pm * tstep + nxt.koff : cA; const char* nB = has_next ? (const char*)g.Bt + (size_t)nxt.pn * tstep + nxt.koff : cB;
        for (int t = 0; t < nt; t += 2) {
            const bool last = (t == nt - 2);
            const char* a1 = cA + (size_t)(t + 1) * kstep;
            const char* a2 = last ? nA : cA + (size_t)(t + 2) * kstep; const char* b2 = last ? nB : cB + (size_t)(t + 2) * kstep;
            const char* a3 = a2 + kstep; const char* b3 = b2 + kstep;
            if (last && has_next) S.a_ready(nxt);
            if constexpr (SP2) {
            PG8_LDB(B0, 0, 0); PG8_LDB(B1, 0, 1); PG8_SCHED; PG8_LDA(At, 0, 0); PG8_STAGE(PG8_SA(1, 1), a1 + hstep, voffA);
            PG8_WAIT_V(8); PG8_WAIT_L(0); PG8_BAR; PG8_MMA(0, 0, At, B0); PG8_MMA(0, 1, At, B1); PG8_BAR; PG8_SCHED;
            PG8_LDA(At, 0, 1); PG8_STAGE(PG8_SB(0, 0), b2, voffB); PG8_STAGE(PG8_SB(0, 1), b2 + hstep, voffB); PG8_STAGE(PG8_SA(0, 0), a2, voffA);
            PG8_WAIT_V(8); PG8_WAIT_L(0); PG8_BAR; PG8_MMA(1, 0, At, B0); PG8_MMA(1, 1, At, B1); PG8_BAR; PG8_SCHED;
            PG8_LDB(B0, 1, 0); PG8_LDB(B1, 1, 1); PG8_SCHED; PG8_LDA(At, 1, 0); PG8_STAGE(PG8_SA(0, 1), a2 + hstep, voffA);
            PG8_WAIT_V(8); PG8_WAIT_L(0); PG8_BAR; PG8_MMA(0, 0, At, B0); PG8_MMA(0, 1, At, B1); PG8_BAR; PG8_SCHED;
            PG8_LDA(At, 1, 1); PG8_STAGE(PG8_SB(1, 0), b3, voffB); PG8_STAGE(PG8_SB(1, 1), b3 + hstep, voffB); PG8_STAGE(PG8_SA(1, 0), a3, voffA);
            PG8_WAIT_V(8); PG8_WAIT_L(0); PG8_BAR; PG8_MMA(1, 0, At, B0); PG8_MMA(1, 1, At, B1); PG8_BAR; PG8_SCHED;
            } else {
            PG8_LDB(B0, 0, 0); PG8_SCHED; PG8_LDA(At, 0, 0); PG8_STAGE(PG8_SA(1, 1), a1 + hstep, voffA);
            PG8_WAIT_L(8); PG8_BAR; PG8_WAIT_L(0); PG8_MMA(0, 0, At, B0); PG8_BAR; PG8_SCHED;
            PG8_LDB(B1, 0, 1); PG8_STAGE(PG8_SB(0, 0), b2, voffB);
            PG8_BAR; PG8_WAIT_L(0); PG8_MMA(0, 1, At, B1); PG8_BAR;
            PG8_LDA(At, 0, 1); PG8_STAGE(PG8_SA(0, 0), a2, voffA);
            PG8_BAR; PG8_WAIT_L(0); PG8_MMA(1, 0, At, B0); PG8_BAR; PG8_SCHED;
            PG8_STAGE(PG8_SB(0, 1), b2 + hstep, voffB);
            PG8_WAIT_V(6); PG8_BAR; PG8_MMA(1, 1, At, B1); PG8_BAR;
            PG8_LDB(B0, 1, 0); PG8_SCHED; PG8_LDA(At, 1, 0); PG8_STAGE(PG8_SA(0, 1), a2 + hstep, voffA);
            PG8_WAIT_L(8); PG8_BAR; PG8_WAIT_L(0); PG8_MMA(0, 0, At, B0); PG8_BAR; PG8_SCHED;
            PG8_LDB(B1, 1, 1); PG8_STAGE(PG8_SB(1, 0), b3, voffB);
            PG8_BAR; PG8_WAIT_L(0); PG8_MMA(0, 1, At, B1); PG8_BAR;
            PG8_LDA(At, 1, 1); PG8_STAGE(PG8_SA(1, 0), a3, voffA);
            PG8_BAR; PG8_WAIT_L(0); PG8_MMA(1, 0, At, B0); PG8_BAR; PG8_SCHED;
            PG8_STAGE(PG8_SB(1, 1), b3 + hstep, voffB);
            PG8_WAIT_V(6); PG8_BAR; PG8_MMA(1, 1, At, B1); PG8_BAR;
            }
        }
        if constexpr (ALIGN_EPI) { if (wr == 0) PG8_BAR; }
        if constexpr (!Epi::AFTER_DRAIN) { E(acc, cur, wr, wc, fr, fq); S.done(cur); }
        if (!has_next) break;
#pragma unroll
        for (int a = 0; a < 2; ++a)
#pragma unroll
            for (int b = 0; b < 2; ++b)
#pragma unroll
                for (int m = 0; m < 4; ++m)
#pragma unroll
                    for (int n = 0; n < 2; ++n) acc[a][b][m][n] = (f32x4){0.f, 0.f, 0.f, 0.f};
        cur = nxt; cA = nA; cB = nB; ++ui;
        if constexpr (ALIGN_EPI) { if (wr == 1) PG8_BAR; }
    }
    PG8_WAIT_V(0);
    if constexpr (!ALIGN_EPI) { if (wr == 0) PG8_BAR; }
    PG8_BAR;
    if constexpr (Epi::AFTER_DRAIN) { E.fused(acc, cur, wr, wc, fr, fq, lds, wid, lane); S.done(cur); }
#undef PG8_SA
#undef PG8_SB
#undef PG8_STAGE
#undef PG8_LDA
#undef PG8_LDB
#undef PG8_MMA
#undef PG8_WAIT_V
#undef PG8_WAIT_L
#undef PG8_BAR
#undef PG8_SCHED
}
}
#define XB_TMO      128
#define XB_XCNT(j)  (256  + 64 * (j))
#define XB_XSUB(j)  (1280 + 64 * (j))
#define XB_XGEN(j)  (2304 + 64 * (j))
#define XB_TOP      3328
#define XB_TOPGEN   3392
#define XCD_BAR_WORDS 3456
#define XB_SPIN_CAP (1u << 18)
#define LAS __attribute__((address_space(3)))

__device__ __forceinline__ unsigned xb_ld(unsigned* p)              { return __hip_atomic_load(p, __ATOMIC_RELAXED, __HIP_MEMORY_SCOPE_AGENT); }
__device__ __forceinline__ unsigned xb_add(unsigned* p, unsigned v) { return __hip_atomic_fetch_add(p, v, __ATOMIC_RELAXED, __HIP_MEMORY_SCOPE_AGENT); }
__device__ __forceinline__ unsigned xb_xcc_id() { return (unsigned)__builtin_amdgcn_s_getreg((3 << 11) | 20) & 0xFu; }
#define XB_SPIN(cond, bar) do { unsigned _sp = 0; while (cond) { __builtin_amdgcn_s_sleep(1); \
    if ((++_sp & 255u) == 0u) { if (xb_ld(&(bar)[XB_TMO])) break; if (_sp > XB_SPIN_CAP) { atomicAdd(&(bar)[XB_TMO], 1u); break; } } } } while (0)

struct XcdBarrier {
    unsigned* bar; unsigned x;
    volatile LAS unsigned* st;
};

__device__ __forceinline__ XcdBarrier xcd_barrier_post(unsigned* bar, volatile LAS unsigned* st) {
    XcdBarrier b; b.bar = bar; b.x = xb_xcc_id(); b.st = st;
    if (threadIdx.x == 0) (void)xb_add(&bar[XB_XCNT(b.x)], 1u);
    return b;
}
__device__ __forceinline__ void xcd_barrier_complete(unsigned* bar, unsigned x, unsigned& nloc, unsigned& nx) {
    const unsigned G = gridDim.x * gridDim.y * gridDim.z;
    unsigned sum, cnt, mine, sp = 0u;
    for (;;) {
        sum = 0u; cnt = 0u; mine = 0u;
#pragma unroll
        for (unsigned j = 0; j < 16; ++j) { const unsigned c = xb_ld(&bar[XB_XCNT(j)]); sum += c; cnt += (c > 0u) ? 1u : 0u; mine = (j == x) ? c : mine; }
        if (sum == G) break;
        __builtin_amdgcn_s_sleep(1);
        if ((++sp & 255u) == 0u) { if (xb_ld(&bar[XB_TMO])) break; if (sp > XB_SPIN_CAP) { atomicAdd(&bar[XB_TMO], 1u); break; } }
    }
    nloc = mine > 0u ? mine : 1u; nx = cnt > 0u ? cnt : 1u;
}

__device__ __forceinline__ void xcd_barrier(const XcdBarrier& b) {
    asm volatile("s_waitcnt vmcnt(0)" ::: "memory");
    __syncthreads();
    if (threadIdx.x == 0) {
        unsigned* bar = b.bar;
        __builtin_amdgcn_s_waitcnt(0);
        unsigned nloc = b.st[0], nx = b.st[1];
        if (nloc == 0u) { xcd_barrier_complete(bar, b.x, nloc, nx); b.st[0] = nloc; b.st[1] = nx; }
        const unsigned old = xb_add(&bar[XB_XSUB(b.x)], 1u);
        const unsigned gen = old / nloc;
        if (old + 1u == (gen + 1u) * nloc) {
            __builtin_amdgcn_fence(__ATOMIC_RELEASE, "agent");
            asm volatile("s_waitcnt vmcnt(0)" ::: "memory");
            const unsigned og = xb_add(&bar[XB_TOP], 1u);
            const unsigned tg = og / nx;
            if (og + 1u == (tg + 1u) * nx) xb_add(&bar[XB_TOPGEN], 1u);
            else XB_SPIN(xb_ld(&bar[XB_TOPGEN]) == tg, bar);
            __builtin_amdgcn_fence(__ATOMIC_ACQUIRE, "agent");
            xb_add(&bar[XB_XGEN(b.x)], 1u);
            asm volatile("s_waitcnt vmcnt(0)" ::: "memory");
        } else {
            XB_SPIN(xb_ld(&bar[XB_XGEN(b.x)]) == gen, bar);
            __builtin_amdgcn_fence(__ATOMIC_ACQUIRE, "agent");
            asm volatile("s_waitcnt vmcnt(0)" ::: "memory");
        }
    }
    __syncthreads();
}

typedef unsigned short bf16;
typedef float f32x4 __attribute__((ext_vector_type(4)));
typedef unsigned u32x4 __attribute__((ext_vector_type(4)));
typedef unsigned u32x2 __attribute__((ext_vector_type(2)));
constexpr int D = 2048, NB = 4, SEQ = 4096, NL = 4, CTX = 256, CH = 128;
constexpr int MX = NB * SEQ, MC = NB * CTX, M = MX + MC;
constexpr int PIN = 5152, NP = 5376, FF = 5632, NMOD = 6 * D;
constexpr int C_U = 0, C_V = 1024, C_Q = 2048, C_K = 2560, C_VV = 3072, C_G = 4096, C_DF = 5120, C_DB = 5136;
constexpr int NCHUNK = M / CH;
constexpr float EPS = 1e-6f;
constexpr size_t MiB = 1u << 20;
constexpr size_t WS_CTL = 0, WS_MOD = 1 * MiB, ZERO_BYTES = 2 * MiB, WS_WIN = 2 * MiB, WS_WOUT = WS_WIN + 84 * MiB, WS_WFI = WS_WOUT + 32 * MiB, WS_WFO = WS_WFI + 176 * MiB,
                 WS_X = WS_WFO + 88 * MiB, WS_H = WS_X + 136 * MiB, WS_P = WS_H + 68 * MiB, WS_CAT = WS_P + 179 * MiB, WS_Y = WS_CAT + 68 * MiB, WS_HID = WS_Y + 136 * MiB,
                 WS_DS = WS_HID + 187 * MiB, WS_SP = WS_DS + 136 * MiB, WS_DEC = WS_SP + 68 * MiB, WS_WSB = WS_DEC + 1 * MiB, WS_QK = WS_WSB + 1 * MiB, WS_YP = WS_QK + 68 * MiB, WS_END = WS_YP + 64 * MiB;
static_assert((size_t)NL * NP * D * 2 <= 84 * MiB && (size_t)NL * 2 * FF * D * 2 <= 176 * MiB && (size_t)NL * D * FF * 2 <= 88 * MiB && (size_t)M * NP * 2 <= 179 * MiB && (size_t)M * FF * 2 <= 187 * MiB, "ws map");
constexpr int CW_BAR = 4096;
constexpr int LDS_BYTES = 163840, MISC_OFF = LDS_BYTES - 256;

__device__ __forceinline__ float bf2f(bf16 b) { return __uint_as_float(((unsigned)b) << 16); }
__device__ __forceinline__ unsigned f2bf(float f) { unsigned u = __float_as_uint(f); return (u + 0x7fffu + ((u >> 16) & 1u)) >> 16; }
__device__ __forceinline__ unsigned pk2(float lo, float hi) { return f2bf(lo) | (f2bf(hi) << 16); }
__device__ __forceinline__ float wave_sum(float v) {
#pragma unroll
    for (int o = 1; o < 64; o <<= 1) v += __shfl_xor(v, o);
    return v;
}
__device__ __forceinline__ float sigmoid_acc(float x) { return 1.0f / (1.0f + __expf(-x)); }
__device__ __forceinline__ float silu_acc(float x) { return x * sigmoid_acc(x); }
__device__ __forceinline__ float log_sigmoid(float z) { return fminf(z, 0.f) - log1pf(__expf(-fabsf(z))); }
__device__ __forceinline__ int mod_row(int row) { return row < MX ? row / SEQ : NB; }
#define LDS_WAIT() asm volatile("s_waitcnt lgkmcnt(0)" ::: "memory")


__device__ __forceinline__ int map_col(int mode, int r) {
    if (mode == 0) return r;
    if (mode == 1) return r < PIN ? r : -1;
    const int pn = r >> 8, rr = r & 255; return rr < 128 ? pn * 128 + rr : FF + pn * 128 + (rr - 128);
}
__device__ __forceinline__ void transpose_item(const float* W, int K, int Nsrc, bf16* T, int n0, int c0, int k0, LAS float* scr, int lane) {
    if (c0 >= 0) {
#pragma unroll 8
        for (int i = 0; i < 32; ++i) { const int kk = 2 * i + (lane >> 5); scr[kk * 33 + (lane & 31)] = __builtin_nontemporal_load(W + (size_t)(k0 + kk) * Nsrc + c0 + (lane & 31)); }
    } else {
#pragma unroll 8
        for (int i = 0; i < 32; ++i) { const int kk = 2 * i + (lane >> 5); scr[kk * 33 + (lane & 31)] = 0.f; }
    }
    LDS_WAIT(); asm volatile("" ::: "memory");
    const int c = lane & 7;
#pragma unroll
    for (int j = 0; j < 4; ++j) { const int n = (lane >> 3) + 8 * j; const LAS float* s = scr + (8 * c) * 33 + n;
        u32x4 o; o.x = pk2(s[0 * 33], s[1 * 33]); o.y = pk2(s[2 * 33], s[3 * 33]); o.z = pk2(s[4 * 33], s[5 * 33]); o.w = pk2(s[6 * 33], s[7 * 33]);
        __builtin_nontemporal_store(o, (u32x4*)(T + (size_t)(n0 + n) * K + k0 + 8 * c)); }
    LDS_WAIT(); asm volatile("" ::: "memory");
}
__device__ __forceinline__ void conv_matrix(const float* W, bf16* T, int K, int Nsrc, int Ndst, int mode, int& it0, int gw, int ngw, LAS float* scr, int lane) {
    const int nblk = Ndst / 32, per_layer = (K / 64) * nblk, total = NL * per_layer;
    int first = ((gw - it0) % ngw + ngw) % ngw;
    for (int it = first; it < total; it += ngw) {
        const int l = it / per_layer, r = it % per_layer, kb = r / nblk, nb = r % nblk;
        transpose_item(W + (size_t)l * K * Nsrc, K, Nsrc, T + (size_t)l * Ndst * K, 32 * nb, map_col(mode, 32 * nb), 64 * kb, scr, lane);
    }
    it0 += total;
}
struct RowArgs { const float* xin_x; const float* xin_c; const float* YP; const bf16* Y; float* X; float* Xw; float* out; bf16* H; const float* modA; const float* modB; const float* gA; const float* gB; int mode; int write_h; int to_out; int pad; };
__device__ __forceinline__ void row_vectors(const RowArgs& a, LAS float* VEC, int tid) {
    for (int i = tid; i < 5 * (D / 4); i += 512) { const int r = i / (D / 4), c = (i % (D / 4)) * 4;
        if (a.mode != 0) { const f32x4 m = *(const f32x4*)(a.modA + (size_t)r * NMOD + (a.mode == 1 ? 2 : 5) * D + c), g = *(const f32x4*)(a.gA + c); *(LAS f32x4*)(VEC + (r * 3 + 0) * D + c) = m * g; }
        if (a.write_h) { const float* msh = (a.mode == 1 ? a.modA + (size_t)r * NMOD + 3 * D : a.modB + (size_t)r * NMOD);
            const f32x4 sh = *(const f32x4*)(msh + c), sc = *(const f32x4*)(msh + D + c), g = *(const f32x4*)(a.gB + c);
            *(LAS f32x4*)(VEC + (r * 3 + 1) * D + c) = g * (sc + 1.0f); *(LAS f32x4*)(VEC + (r * 3 + 2) * D + c) = sh; } }
}
__device__ __forceinline__ bool row_from_input(const RowArgs& a) { return !(a.mode == 2 || a.xin_x == nullptr); }
__device__ __forceinline__ f32x4 row_load_x(const RowArgs& a, int row, int off) {
    if (row_from_input(a)) { const float* p = row < MX ? a.xin_x + (size_t)row * D : a.xin_c + (size_t)(row - MX) * D; return __builtin_nontemporal_load((const f32x4*)(p + off)); }
    return __builtin_nontemporal_load((const f32x4*)(a.X + (size_t)row * D + off));
}
#define RCOL(lane, j) (8 * (lane) + 512 * ((j) >> 1) + 4 * ((j) & 1))
__device__ __forceinline__ void row_unpack8(const u32x4 w, f32x4& lo, f32x4& hi) {
    lo = (f32x4){__uint_as_float(w.x << 16), __uint_as_float(w.x & 0xffff0000u), __uint_as_float(w.y << 16), __uint_as_float(w.y & 0xffff0000u)};
    hi = (f32x4){__uint_as_float(w.z << 16), __uint_as_float(w.z & 0xffff0000u), __uint_as_float(w.w << 16), __uint_as_float(w.w & 0xffff0000u)};
}
__device__ __forceinline__ void row_finish(const RowArgs& a, int row, int lane, f32x4 (&x)[8], const f32x4 (&y)[8], const LAS float* VEC) {
    const LAS float* V0 = VEC + (mod_row(row) * 3) * D;
    if (a.mode != 0) {
        float ss = 0.f;
#pragma unroll
        for (int j = 0; j < 8; ++j) ss += (y[j][0] * y[j][0] + y[j][1] * y[j][1]) + (y[j][2] * y[j][2] + y[j][3] * y[j][3]);
        const float rstd = rsqrtf(wave_sum(ss) * (1.f / D) + EPS);
#pragma unroll
        for (int j = 0; j < 8; ++j) { const f32x4 mg = *(const LAS f32x4*)(V0 + RCOL(lane, j)); x[j] = x[j] + mg * (y[j] * rstd); }
        if (a.to_out) { if (row < MX) {
#pragma unroll
            for (int j = 0; j < 8; ++j) __builtin_nontemporal_store(x[j], (f32x4*)(a.out + (size_t)row * D + RCOL(lane, j))); } }
        else {
#pragma unroll
            for (int j = 0; j < 8; ++j) __builtin_nontemporal_store(x[j], (f32x4*)(a.Xw + (size_t)row * D + RCOL(lane, j))); }
    }
    if (a.write_h) {
        float ss = 0.f;
#pragma unroll
        for (int j = 0; j < 8; ++j) ss += (x[j][0] * x[j][0] + x[j][1] * x[j][1]) + (x[j][2] * x[j][2] + x[j][3] * x[j][3]);
        const float rstd = rsqrtf(wave_sum(ss) * (1.f / D) + EPS);
        bf16* hr = a.H + (size_t)row * D;
#pragma unroll
        for (int m = 0; m < 4; ++m) { f32x4 h[2];
#pragma unroll
            for (int t = 0; t < 2; ++t) { const int j = 2 * m + t; const f32x4 gs = *(const LAS f32x4*)(V0 + D + RCOL(lane, j)), sh = *(const LAS f32x4*)(V0 + 2 * D + RCOL(lane, j)); h[t] = (x[j] * rstd) * gs + sh; }
            u32x4 w; w.x = pk2(h[0][0], h[0][1]); w.y = pk2(h[0][2], h[0][3]); w.z = pk2(h[1][0], h[1][1]); w.w = pk2(h[1][2], h[1][3]); *(u32x4*)(hr + 8 * lane + 512 * m) = w; }
    }
}
__device__ __forceinline__ void row_pass(const RowArgs& a, int row, int lane, const LAS float* VEC) {
    f32x4 x[8], y[8];
#pragma unroll
    for (int j = 0; j < 8; ++j) x[j] = row_load_x(a, row, RCOL(lane, j));
    if (a.mode != 0) {
        if (a.YP != nullptr && row >= MX) {
            const float* yp = a.YP + (size_t)(row - MX) * D;
#pragma unroll
            for (int j = 0; j < 8; ++j) { f32x4 s = *(const f32x4*)(yp + RCOL(lane, j));
#pragma unroll 1
                for (int k = 1; k < 8; ++k) s += *(const f32x4*)(yp + (size_t)k * MC * D + RCOL(lane, j));
                y[j] = s; }
        } else {
            const bf16* yr = a.Y + (size_t)row * D;
#pragma unroll
            for (int m = 0; m < 4; ++m) row_unpack8(*(const u32x4*)(yr + 8 * lane + 512 * m), y[2 * m], y[2 * m + 1]);
        }
    } else {
#pragma unroll
        for (int j = 0; j < 8; ++j) y[j] = (f32x4){0.f, 0.f, 0.f, 0.f};
    }
    row_finish(a, row, lane, x, y, VEC);
}
__device__ __forceinline__ void row_pass2(const RowArgs& a, int r0, int r1, int lane, const LAS float* VEC) {
    f32x4 x0[8], x1[8]; u32x4 w0[4], w1[4];
#pragma unroll
    for (int j = 0; j < 8; ++j) { x0[j] = row_load_x(a, r0, RCOL(lane, j)); x1[j] = row_load_x(a, r1, RCOL(lane, j)); }
    if (a.mode != 0) {
#pragma unroll
        for (int m = 0; m < 4; ++m) { w0[m] = __builtin_nontemporal_load((const u32x4*)(a.Y + (size_t)r0 * D + 8 * lane + 512 * m)); w1[m] = __builtin_nontemporal_load((const u32x4*)(a.Y + (size_t)r1 * D + 8 * lane + 512 * m)); }
    } else {
#pragma unroll
        for (int m = 0; m < 4; ++m) { w0[m] = (u32x4){0u, 0u, 0u, 0u}; w1[m] = (u32x4){0u, 0u, 0u, 0u}; }
    }
    { f32x4 y[8];
#pragma unroll
      for (int m = 0; m < 4; ++m) row_unpack8(w0[m], y[2 * m], y[2 * m + 1]);
      row_finish(a, r0, lane, x0, y, VEC); }
    { f32x4 y[8];
#pragma unroll
      for (int m = 0; m < 4; ++m) row_unpack8(w1[m], y[2 * m], y[2 * m + 1]);
      row_finish(a, r1, lane, x1, y, VEC); }
}
__device__ __forceinline__ void row_phase(const RowArgs& a, int nrows, LAS unsigned char* lds, int tid, int lane, int gw, int ngw) {
    LAS float* VEC = (LAS float*)lds;
    row_vectors(a, VEC, tid);
    __syncthreads();
    for (int r0 = gw; r0 < nrows; r0 += 2 * ngw) { const int r1 = r0 + ngw;
        if (r1 < MX) row_pass2(a, r0, r1, lane, VEC);
        else { row_pass(a, r0, lane, VEC); if (r1 < nrows) row_pass(a, r1, lane, VEC); } }
    __syncthreads();
}

__device__ __forceinline__ void gmlp_unit_simple(const bf16* P, bf16* CAT, const float* ln_g, const float* ln_b, const float* ws, const float* bs, int cid, int h, LAS float* vln, int tid) {
    { const int j = tid >> 2, qd = tid & 3; const bf16* vp = P + (size_t)(cid * CH + j) * NP + C_V + h * 128 + qd * 32;
      float v[32]; float s = 0.f;
#pragma unroll
      for (int i = 0; i < 4; ++i) { const u32x4 w = *(const u32x4*)(vp + 8 * i);
#pragma unroll
          for (int e = 0; e < 4; ++e) { v[8 * i + 2 * e] = __uint_as_float(w[e] << 16); v[8 * i + 2 * e + 1] = __uint_as_float(w[e] & 0xffff0000u); } }
#pragma unroll
      for (int i = 0; i < 32; ++i) s += v[i];
      s += __shfl_xor(s, 1); s += __shfl_xor(s, 2); const float mu = s * (1.f / 128.f); float q = 0.f;
#pragma unroll
      for (int i = 0; i < 32; ++i) { v[i] -= mu; q += v[i] * v[i]; }
      q += __shfl_xor(q, 1); q += __shfl_xor(q, 2); const float rstd = rsqrtf(q * (1.f / 128.f) + EPS);
#pragma unroll
      for (int i = 0; i < 32; ++i) { const int d = qd * 32 + i; vln[j * CH + d] = v[i] * rstd * ln_g[h * 128 + d] + ln_b[h * 128 + d]; } }
    __syncthreads();
    const int d = tid & 127, ig = __builtin_amdgcn_readfirstlane(tid >> 7);
    for (int ii = 0; ii < 32; ++ii) { const int i = ig * 32 + ii; const float* wr = ws + ((size_t)h * CH + i) * CH; float acc = 0.f;
#pragma unroll 16
        for (int j = 0; j < CH; ++j) acc += wr[j] * vln[j * CH + d];
        const size_t row = (size_t)cid * CH + i; const float u = bf2f(P[row * NP + C_U + h * 128 + d]);
        CAT[row * D + h * 128 + d] = (bf16)f2bf(u * (acc + bs[h * CH + i])); }
    __syncthreads();
}


typedef short bf16x8 __attribute__((ext_vector_type(8)));
typedef short s16x4 __attribute__((ext_vector_type(4)));
typedef short v4i16_t __attribute__((ext_vector_type(4)));
constexpr int PQ = 288, PV = 544;
constexpr int L_QT = 0, L_KT = 36864, L_ST = 0, L_V = 73728, L_DF = 143360, L_TOT = 151552;
__device__ __forceinline__ s16x4 tr_read(const LAS unsigned char* p) { return __builtin_bit_cast(s16x4, __builtin_amdgcn_ds_read_tr16_b64_v4i16((LAS v4i16_t*)p)); }
__device__ __forceinline__ bf16x8 cat8(s16x4 lo, s16x4 hi) { return (bf16x8){lo[0], lo[1], lo[2], lo[3], hi[0], hi[1], hi[2], hi[3]}; }
__device__ __forceinline__ float logsig_fast(float z) { return fminf(z, 0.f) - __logf(1.0f + __expf(-fabsf(z))); }
__device__ __forceinline__ f32x4 mfma16(bf16x8 a, bf16x8 b, f32x4 c) { return __builtin_amdgcn_mfma_f32_16x16x32_bf16(a, b, c, 0, 0, 0); }

__device__ __forceinline__ void v_tile_issue(const bf16* P, int cid, int h, u32x4 (&vr)[8], int tid) {
#pragma unroll
    for (int i = 0; i < 8; ++i) { const int idx = tid + 512 * i, row = idx >> 5, ch = idx & 31; vr[i] = *(const u32x4*)(P + (size_t)(cid * CH + row) * NP + C_VV + h * 256 + ch * 8); }
}
__device__ __forceinline__ void v_tile_park(const u32x4 (&vr)[8], LAS unsigned char* V, int tid) {
#pragma unroll
    for (int i = 0; i < 8; ++i) { const int idx = tid + 512 * i, row = idx >> 5, ch = idx & 31; *(LAS u32x4*)(V + row * PV + ch * 16) = vr[i]; }
}
constexpr int PB = 132;
__device__ __forceinline__ float gla_decay_tile(const bf16* P, const float* wd2, const float* bd, int cid, int h, int dir, LAS float* B, int wave, int tid) {
    asm volatile("" : "+v"(tid));
    const int g = (tid >> 4) & 3, li = tid & 15, dcol = h * 128 + 16 * wave + li;
    bf16x8 Bw = {0, 0, 0, 0, 0, 0, 0, 0}, A[8];
    if (g < 2) { u32x4 w; w.x = pk2(wd2[(8 * g + 0) * 512 + dcol], wd2[(8 * g + 1) * 512 + dcol]); w.y = pk2(wd2[(8 * g + 2) * 512 + dcol], wd2[(8 * g + 3) * 512 + dcol]);
        w.z = pk2(wd2[(8 * g + 4) * 512 + dcol], wd2[(8 * g + 5) * 512 + dcol]); w.w = pk2(wd2[(8 * g + 6) * 512 + dcol], wd2[(8 * g + 7) * 512 + dcol]); Bw = __builtin_bit_cast(bf16x8, w); }
    const float bdv = bd[dcol];
    const bf16* dfp = P + (size_t)(cid * CH + li) * NP + (dir ? C_DB : C_DF) + 8 * (g & 1);
#pragma unroll
    for (int s = 0; s < 8; ++s) { const int jt = dir ? 7 - s : s; const bf16x8 v = *(const bf16x8*)(dfp + (size_t)(16 * jt) * NP); A[s] = (g < 2) ? v : (bf16x8){0, 0, 0, 0, 0, 0, 0, 0}; }
    f32x4 bt[8]; float carry = 0.f;
#pragma unroll
    for (int s = 0; s < 8; ++s) {
        const f32x4 z = mfma16(A[s], Bw, (f32x4){0.f, 0.f, 0.f, 0.f});
        const float l0 = logsig_fast(z[0] + bdv) * (1.f / 16.f), l1 = logsig_fast(z[1] + bdv) * (1.f / 16.f), l2 = logsig_fast(z[2] + bdv) * (1.f / 16.f), l3 = logsig_fast(z[3] + bdv) * (1.f / 16.f);
        f32x4 pr; float t;
        if (!dir) { pr[0] = l0; pr[1] = pr[0] + l1; pr[2] = pr[1] + l2; pr[3] = pr[2] + l3; t = pr[3]; }
        else      { pr[3] = l3; pr[2] = pr[3] + l2; pr[1] = pr[2] + l1; pr[0] = pr[1] + l0; t = pr[0]; }
        float t2;
        if (!dir) { const float u1 = __shfl_up(t, 16); const float t1 = t + (g >= 1 ? u1 : 0.f); const float u2 = __shfl_up(t1, 32); t2 = t1 + (g >= 2 ? u2 : 0.f); }
        else      { const float u1 = __shfl_down(t, 16); const float t1 = t + (g <= 2 ? u1 : 0.f); const float u2 = __shfl_down(t1, 32); t2 = t1 + (g <= 1 ? u2 : 0.f); }
        const float base = carry + (t2 - t);
        bt[s] = pr + base;
        carry += __shfl(t2, dir ? li : li + 48); }
#pragma unroll
    for (int s = 0; s < 8; ++s) { const int jt = dir ? 7 - s : s;
#pragma unroll
        for (int r = 0; r < 4; ++r) B[(16 * jt + 4 * g + r) * PB + 16 * wave + li] = bt[s][r]; }
    return carry;
}
__device__ __forceinline__ void gla_g1_unit(const bf16* P, const float* wd2, const float* bd, bf16* DS, float* DEC, int cid, int h, int dir, LAS unsigned char* lds, int tid, int lane, int wave) {
    const int unit = (cid * 4 + h) * 2 + dir;
    asm volatile("" : "+v"(tid)); (void)lane;
    u32x4 vr[8], rk[4]; v_tile_issue(P, cid, h, vr, tid);
#pragma unroll
    for (int i = 0; i < 4; ++i) { const int idx = tid + 512 * i, row = idx >> 4, ch = idx & 15; rk[i] = *(const u32x4*)(P + (size_t)(cid * CH + row) * NP + C_K + h * 128 + ch * 8); }
    LAS float* B = (LAS float*)(lds + L_V); LAS float* DECL = (LAS float*)(lds + L_DF);
    { const float tot = gla_decay_tile(P, wd2, bd, cid, h, dir, B, wave, tid);
      if (((tid >> 4) & 3) == 0) { const float dc = __expf(tot); DEC[(size_t)unit * 128 + 16 * wave + (tid & 15)] = dc; DECL[16 * wave + (tid & 15)] = dc; } }
    __syncthreads();
    { int t2 = tid; asm volatile("" : "+v"(t2));
#pragma unroll
      for (int i = 0; i < 4; ++i) { const int idx = t2 + 512 * i, j = idx >> 4, c = idx & 15;
          const f32x4 b0 = *(const LAS f32x4*)(B + j * PB + 8 * c), b1 = *(const LAS f32x4*)(B + j * PB + 8 * c + 4);
          f32x4 k0, k1; row_unpack8(rk[i], k0, k1);
#pragma unroll
          for (int t = 0; t < 4; ++t) { k0[t] = k0[t] * __expf(-b0[t]); k1[t] = k1[t] * __expf(-b1[t]); }
          u32x4 kw; kw.x = pg8::cvt_pk_bf16(k0[0], k0[1]); kw.y = pg8::cvt_pk_bf16(k0[2], k0[3]); kw.z = pg8::cvt_pk_bf16(k1[0], k1[1]); kw.w = pg8::cvt_pk_bf16(k1[2], k1[3]);
          *(LAS u32x4*)(lds + L_KT + j * PQ + c * 16) = kw; } }
    __syncthreads();
    v_tile_park(vr, lds + L_V, tid);
    __syncthreads();
    int t2 = tid; asm volatile("" : "+v"(t2));
    const int wdb = wave >> 1, we = wave & 1, g = (t2 >> 4) & 3, li = t2 & 15, q = li >> 2, p = li & 3;
    const LAS unsigned char* KT = lds + L_KT; const LAS unsigned char* V = lds + L_V;
    f32x4 acc[2][8];
#pragma unroll
    for (int dt = 0; dt < 2; ++dt)
#pragma unroll
        for (int et = 0; et < 8; ++et) acc[dt][et] = (f32x4){0.f, 0.f, 0.f, 0.f};
#pragma unroll
    for (int ks = 0; ks < 4; ++ks) { const int row = 32 * ks + 8 * g + q;
        bf16x8 X[2], Y[8];
#pragma unroll
        for (int dt = 0; dt < 2; ++dt) X[dt] = cat8(tr_read(KT + row * PQ + (32 * wdb + 16 * dt + 4 * p) * 2), tr_read(KT + (row + 4) * PQ + (32 * wdb + 16 * dt + 4 * p) * 2));
#pragma unroll
        for (int et = 0; et < 8; ++et) Y[et] = cat8(tr_read(V + row * PV + (128 * we + 16 * et + 4 * p) * 2), tr_read(V + (row + 4) * PV + (128 * we + 16 * et + 4 * p) * 2));
#pragma unroll
        for (int et = 0; et < 8; ++et) { acc[0][et] = mfma16(X[0], Y[et], acc[0][et]); acc[1][et] = mfma16(X[1], Y[et], acc[1][et]); } }
#pragma unroll
    for (int dt = 0; dt < 2; ++dt) { const int d0 = 32 * wdb + 16 * dt + 4 * g; const f32x4 dc = *(const LAS f32x4*)(DECL + d0);
#pragma unroll
        for (int et = 0; et < 8; ++et) { const int e = 128 * we + 16 * et + li; const f32x4 v = acc[dt][et] * dc; u32x2 w; w.x = pg8::cvt_pk_bf16(v[0], v[1]); w.y = pg8::cvt_pk_bf16(v[2], v[3]); *(u32x2*)(DS + ((size_t)unit * 256 + e) * 128 + d0) = w; } }
    __syncthreads();
}
__device__ __forceinline__ int gla_chain_cid(int s, int b, int dir) { return dir ? (s < 2 ? 128 + 2 * b + (1 - s) : 32 * b + 31 - (s - 2)) : (s < 2 ? 128 + 2 * b + s : 32 * b + (s - 2)); }
__device__ __forceinline__ void gla_g2_item(const bf16* DS, const float* DEC, bf16* SP, int item) {
    const int chain = item >> 13, ed = item & 8191, b = chain >> 3, h = (chain >> 1) & 3, dir = chain & 1, e = ed >> 5, d0 = (ed & 31) * 4;
    f32x4 S = {0.f, 0.f, 0.f, 0.f};
#pragma unroll 2
    for (int s = 0; s < 34; ++s) { const int cid = gla_chain_cid(s, b, dir), unit = (cid * 4 + h) * 2 + dir; const size_t off = ((size_t)unit * 256 + e) * 128 + d0;
        const f32x4 dec = *(const f32x4*)(DEC + (size_t)unit * 128 + d0); const u32x2 dw = *(const u32x2*)(DS + off);
        const f32x4 ds = {__uint_as_float(dw.x << 16), __uint_as_float(dw.x & 0xffff0000u), __uint_as_float(dw.y << 16), __uint_as_float(dw.y & 0xffff0000u)};
        u32x2 w; w.x = pk2(S[0], S[1]); w.y = pk2(S[2], S[3]); *(u32x2*)(SP + off) = w;
        S = dec * S + ds; }
}
__device__ __forceinline__ void gla_g3_unit(const bf16* P, const float* wd2f, const float* bdf, const float* wd2b, const float* bdb, const bf16* SP, const float* out_g, bf16* CAT, int cid, int h, LAS unsigned char* lds, int tid, int lane, int wave) {
    asm volatile("" : "+v"(tid));
    const int w = wave; (void)lane;
    const LAS unsigned char* QT = lds + L_QT; const LAS unsigned char* KT = lds + L_KT; LAS unsigned char* ST = lds + L_ST; const LAS unsigned char* V = lds + L_V;
    static_assert(L_KT == L_QT + 128 * PQ && 128 * PB * 4 <= 2 * 128 * PQ, "q~ and k~ tiles are adjacent and hold the b tile");
    f32x4 o[16];
#pragma unroll
    for (int et = 0; et < 16; ++et) o[et] = (f32x4){0.f, 0.f, 0.f, 0.f};
#pragma unroll
    for (int dir = 0; dir < 2; ++dir) {
        const int unit = (cid * 4 + h) * 2 + dir;
        { u32x4 rk[4], rq[4];
#pragma unroll
          for (int i = 0; i < 4; ++i) { const int idx = tid + 512 * i, row = idx >> 4, ch = idx & 15; const bf16* pr = P + (size_t)(cid * CH + row) * NP + h * 128 + ch * 8; rk[i] = *(const u32x4*)(pr + C_K); rq[i] = *(const u32x4*)(pr + C_Q); }
          LAS float* B = (LAS float*)(lds + L_QT);
          (void)gla_decay_tile(P, dir ? wd2b : wd2f, dir ? bdb : bdf, cid, h, dir, B, wave, tid);
          u32x4 vr[8]; if (dir == 0) v_tile_issue(P, cid, h, vr, tid);
          __syncthreads();
          u32x4 qw[4], kw[4];
#pragma unroll
          for (int i = 0; i < 4; ++i) { const int idx = tid + 512 * i, j = idx >> 4, c = idx & 15;
              const f32x4 b0 = *(const LAS f32x4*)(B + j * PB + 8 * c), b1 = *(const LAS f32x4*)(B + j * PB + 8 * c + 4);
              f32x4 q0, q1, k0, k1; row_unpack8(rq[i], q0, q1); row_unpack8(rk[i], k0, k1);
              f32x4 e0, e1;
#pragma unroll
              for (int t = 0; t < 4; ++t) { e0[t] = __expf(b0[t]); e1[t] = __expf(b1[t]); }
              q0 = q0 * e0 * 0.08838834764831845f; q1 = q1 * e1 * 0.08838834764831845f;
#pragma unroll
              for (int t = 0; t < 4; ++t) { k0[t] = k0[t] * __builtin_amdgcn_rcpf(e0[t]); k1[t] = k1[t] * __builtin_amdgcn_rcpf(e1[t]); }
              qw[i].x = pg8::cvt_pk_bf16(q0[0], q0[1]); qw[i].y = pg8::cvt_pk_bf16(q0[2], q0[3]); qw[i].z = pg8::cvt_pk_bf16(q1[0], q1[1]); qw[i].w = pg8::cvt_pk_bf16(q1[2], q1[3]);
              kw[i].x = pg8::cvt_pk_bf16(k0[0], k0[1]); kw[i].y = pg8::cvt_pk_bf16(k0[2], k0[3]); kw[i].z = pg8::cvt_pk_bf16(k1[0], k1[1]); kw[i].w = pg8::cvt_pk_bf16(k1[2], k1[3]); }
          if (dir == 0) v_tile_park(vr, lds + L_V, tid);
          __syncthreads();
#pragma unroll
          for (int i = 0; i < 4; ++i) { const int idx = tid + 512 * i, j = idx >> 4, c = idx & 15; *(LAS u32x4*)(lds + L_QT + j * PQ + c * 16) = qw[i]; *(LAS u32x4*)(lds + L_KT + j * PQ + c * 16) = kw[i]; }
          __syncthreads(); }
        int t2 = tid; asm volatile("" : "+v"(t2));
        const int g = (t2 >> 4) & 3, li = t2 & 15, q = li >> 2, p = li & 3;
        u32x4 sp[8];
#pragma unroll
        for (int i = 0; i < 8; ++i) sp[i] = *(const u32x4*)(SP + (size_t)unit * 32768 + (size_t)(tid + 512 * i) * 8);
        bf16x8 Yq[4];
#pragma unroll
        for (int ks = 0; ks < 4; ++ks) Yq[ks] = *(const LAS bf16x8*)(QT + (16 * w + li) * PQ + (32 * ks + 8 * g) * 2);
        bf16x8 Pf[4];
#pragma unroll
        for (int kp = 0; kp < 4; ++kp) {
            f32x4 s0 = {0.f, 0.f, 0.f, 0.f}, s1 = {0.f, 0.f, 0.f, 0.f};
            const int t0 = 2 * kp, t1 = 2 * kp + 1;
            const bool a0 = dir ? (t0 >= w) : (t0 <= w), a1 = dir ? (t1 >= w) : (t1 <= w);
            if (a0 && a1) {
                bf16x8 K0[4], K1[4];
#pragma unroll
                for (int ks = 0; ks < 4; ++ks) { K0[ks] = *(const LAS bf16x8*)(KT + (16 * t0 + li) * PQ + (32 * ks + 8 * g) * 2); K1[ks] = *(const LAS bf16x8*)(KT + (16 * t1 + li) * PQ + (32 * ks + 8 * g) * 2); }
#pragma unroll
                for (int ks = 0; ks < 4; ++ks) { s0 = mfma16(K0[ks], Yq[ks], s0); s1 = mfma16(K1[ks], Yq[ks], s1); }
            } else if (a0) {
                bf16x8 K0[4];
#pragma unroll
                for (int ks = 0; ks < 4; ++ks) K0[ks] = *(const LAS bf16x8*)(KT + (16 * t0 + li) * PQ + (32 * ks + 8 * g) * 2);
#pragma unroll
                for (int ks = 0; ks < 4; ++ks) s0 = mfma16(K0[ks], Yq[ks], s0);
            } else if (a1) {
                bf16x8 K1[4];
#pragma unroll
                for (int ks = 0; ks < 4; ++ks) K1[ks] = *(const LAS bf16x8*)(KT + (16 * t1 + li) * PQ + (32 * ks + 8 * g) * 2);
#pragma unroll
                for (int ks = 0; ks < 4; ++ks) s1 = mfma16(K1[ks], Yq[ks], s1);
            }
            if (t0 == w) {
#pragma unroll
                for (int r = 0; r < 4; ++r) { const bool keep = dir ? (4 * g + r >= li) : (4 * g + r <= li); s0[r] = keep ? s0[r] : 0.f; } }
            if (t1 == w) {
#pragma unroll
                for (int r = 0; r < 4; ++r) { const bool keep = dir ? (4 * g + r >= li) : (4 * g + r <= li); s1[r] = keep ? s1[r] : 0.f; } }
            u32x4 pw; pw.x = pg8::cvt_pk_bf16(s0[0], s0[1]); pw.y = pg8::cvt_pk_bf16(s0[2], s0[3]); pw.z = pg8::cvt_pk_bf16(s1[0], s1[1]); pw.w = pg8::cvt_pk_bf16(s1[2], s1[3]);
            Pf[kp] = __builtin_bit_cast(bf16x8, pw);
        }
#pragma unroll
        for (int kp = 0; kp < 4; ++kp) {
            const bool act = dir ? (2 * kp + 1 >= w) : (2 * kp <= w);
            if (act) {
#pragma unroll
                for (int hf = 0; hf < 2; ++hf) {
                    bf16x8 Xv[8];
#pragma unroll
                    for (int i = 0; i < 8; ++i) { const int et = 8 * hf + i; Xv[i] = cat8(tr_read(V + (32 * kp + 4 * g + q) * PV + (16 * et + 4 * p) * 2), tr_read(V + (32 * kp + 16 + 4 * g + q) * PV + (16 * et + 4 * p) * 2)); }
#pragma unroll
                    for (int i = 0; i < 8; ++i) o[8 * hf + i] = mfma16(Xv[i], Pf[kp], o[8 * hf + i]);
                }
            }
        }
        __syncthreads();
#pragma unroll
        for (int i = 0; i < 8; ++i) { const int idx = tid + 512 * i; *(LAS u32x4*)(ST + (idx >> 4) * PQ + (idx & 15) * 16) = sp[i]; }
        __syncthreads();
#pragma unroll
        for (int ks = 0; ks < 4; ++ks)
#pragma unroll
            for (int hf = 0; hf < 2; ++hf) {
                bf16x8 Xs[8];
#pragma unroll
                for (int i = 0; i < 8; ++i) Xs[i] = *(const LAS bf16x8*)(ST + (16 * (8 * hf + i) + li) * PQ + (32 * ks + 8 * g) * 2);
#pragma unroll
                for (int i = 0; i < 8; ++i) o[8 * hf + i] = mfma16(Xs[i], Yq[ks], o[8 * hf + i]);
            }
        __syncthreads();
    }
    int t3 = tid; asm volatile("" : "+v"(t3));
    const int g = (t3 >> 4) & 3, li = t3 & 15;
    float ss = 0.f;
#pragma unroll
    for (int et = 0; et < 16; ++et) ss += (o[et][0] * o[et][0] + o[et][1] * o[et][1]) + (o[et][2] * o[et][2] + o[et][3] * o[et][3]);
    ss += __shfl_xor(ss, 16); ss += __shfl_xor(ss, 32);
    const float rstd = rsqrtf(ss * (1.f / 256.f) + EPS);
    const size_t row = (size_t)cid * CH + 16 * w + li;
#pragma unroll
    for (int et = 0; et < 16; ++et) { const int e0 = h * 256 + 16 * et + 4 * g; const f32x4 gg = *(const f32x4*)(out_g + e0); const u32x2 gw = *(const u32x2*)(P + row * NP + C_G + e0);
        const float g0 = __uint_as_float(gw.x << 16), g1 = __uint_as_float(gw.x & 0xffff0000u), g2 = __uint_as_float(gw.y << 16), g3 = __uint_as_float(gw.y & 0xffff0000u);
        u32x2 ow; ow.x = pk2(o[et][0] * rstd * gg[0] * silu_acc(g0), o[et][1] * rstd * gg[1] * silu_acc(g1)); ow.y = pk2(o[et][2] * rstd * gg[2] * silu_acc(g2), o[et][3] * rstd * gg[3] * silu_acc(g3));
        *(u32x2*)(CAT + row * D + 1024 + e0) = ow; }
}

__device__ __forceinline__ void gmlp_unit_fast(const bf16* P, bf16* CAT, const float* ln_g, const float* ln_b, const bf16* WSB, const float* bs, int cid, int h, LAS unsigned char* lds, int tid, int wave) {
    asm volatile("" : "+v"(tid));
    LAS unsigned char* VL = lds;
    const int g = (tid >> 4) & 3, li = tid & 15, q = li >> 2, p = li & 3, w = wave;
    const size_t row = (size_t)cid * CH + 16 * w + li;
    bf16x8 Yw[4]; u32x2 uw[8];
#pragma unroll
    for (int ks = 0; ks < 4; ++ks) Yw[ks] = *(const bf16x8*)(WSB + ((size_t)(h * CH + 16 * w + li)) * CH + 32 * ks + 8 * g);
#pragma unroll
    for (int dt = 0; dt < 8; ++dt) uw[dt] = *(const u32x2*)(P + row * NP + C_U + h * 128 + 16 * dt + 4 * g);
    const float bsv = bs[h * CH + 16 * w + li];
    { const int j = tid >> 2, qd = tid & 3; const bf16* vp = P + (size_t)(cid * CH + j) * NP + C_V + h * 128 + qd * 32;
      float v[32]; float s = 0.f;
#pragma unroll
      for (int i = 0; i < 4; ++i) { const u32x4 w = *(const u32x4*)(vp + 8 * i);
#pragma unroll
          for (int e = 0; e < 4; ++e) { v[8 * i + 2 * e] = __uint_as_float(w[e] << 16); v[8 * i + 2 * e + 1] = __uint_as_float(w[e] & 0xffff0000u); } }
#pragma unroll
      for (int i = 0; i < 32; ++i) s += v[i];
      s += __shfl_xor(s, 1); s += __shfl_xor(s, 2); const float mu = s * (1.f / 128.f); float q = 0.f;
#pragma unroll
      for (int i = 0; i < 32; ++i) { v[i] -= mu; q += v[i] * v[i]; }
      q += __shfl_xor(q, 1); q += __shfl_xor(q, 2); const float rstd = rsqrtf(q * (1.f / 128.f) + EPS);
      const float* gp = ln_g + h * 128 + qd * 32; const float* bp = ln_b + h * 128 + qd * 32;
#pragma unroll
      for (int i = 0; i < 4; ++i) { const f32x4 g0 = *(const f32x4*)(gp + 8 * i), g1 = *(const f32x4*)(gp + 8 * i + 4), b0 = *(const f32x4*)(bp + 8 * i), b1 = *(const f32x4*)(bp + 8 * i + 4);
          u32x4 o; o.x = pk2(v[8 * i + 0] * rstd * g0[0] + b0[0], v[8 * i + 1] * rstd * g0[1] + b0[1]); o.y = pk2(v[8 * i + 2] * rstd * g0[2] + b0[2], v[8 * i + 3] * rstd * g0[3] + b0[3]);
          o.z = pk2(v[8 * i + 4] * rstd * g1[0] + b1[0], v[8 * i + 5] * rstd * g1[1] + b1[1]); o.w = pk2(v[8 * i + 6] * rstd * g1[2] + b1[2], v[8 * i + 7] * rstd * g1[3] + b1[3]);
          *(LAS u32x4*)(VL + j * PQ + (qd * 32 + 8 * i) * 2) = o; } }
    __syncthreads();
    f32x4 acc[8];
#pragma unroll
    for (int dt = 0; dt < 8; ++dt) acc[dt] = (f32x4){0.f, 0.f, 0.f, 0.f};
#pragma unroll
    for (int ks = 0; ks < 4; ++ks) {
        bf16x8 X[8];
#pragma unroll
        for (int dt = 0; dt < 8; ++dt) X[dt] = cat8(tr_read(VL + (32 * ks + 8 * g + q) * PQ + (16 * dt + 4 * p) * 2), tr_read(VL + (32 * ks + 8 * g + q + 4) * PQ + (16 * dt + 4 * p) * 2));
#pragma unroll
        for (int dt = 0; dt < 8; ++dt) acc[dt] = mfma16(X[dt], Yw[ks], acc[dt]);
    }
#pragma unroll
    for (int dt = 0; dt < 8; ++dt) { const int c0 = h * 128 + 16 * dt + 4 * g;
        const float u0 = __uint_as_float(uw[dt].x << 16), u1 = __uint_as_float(uw[dt].x & 0xffff0000u), u2 = __uint_as_float(uw[dt].y << 16), u3 = __uint_as_float(uw[dt].y & 0xffff0000u);
        u32x2 ow; ow.x = pk2(u0 * (acc[dt][0] + bsv), u1 * (acc[dt][1] + bsv)); ow.y = pk2(u2 * (acc[dt][2] + bsv), u3 * (acc[dt][3] + bsv));
        *(u32x2*)(CAT + row * D + c0) = ow; }
    __syncthreads();
}

constexpr int NPH = 2 + 9 * NL;
struct Args { const float* in[23]; float* out; unsigned char* ws; int ph_lo, ph_hi, li, pad; };

#ifndef DUP_MASK
#define DUP_MASK 0
#endif
#define REP(bit) for (int rep_ = 0; rep_ < (((DUP_MASK) >> (bit)) & 1) + 1; ++rep_)
#define IN(k) (lo <= (k) && (k) < hi)
#define PHASE_IDS() int tid = tid0; asm volatile("" : "+v"(tid)); const int lane = tid & 63, wave = __builtin_amdgcn_readfirstlane(tid >> 6), gw = bid * 8 + wave, ngw = G * 8; (void)lane; (void)gw; (void)ngw
#define SEAM(k) do { if (IN(k) && IN((k) + 1)) xcd_barrier(bar); } while (0)
template <int l> __device__ __forceinline__ void run_layer(const Args& a, LAS unsigned char* lds, const XcdBarrier& bar, int tid0, int G, int bid, int lo, int hi) {
    unsigned char* ws = a.ws;
    const float* x = a.in[0]; const float* ctx = a.in[2];
    const float* g_pre_mix = a.in[6]; const float* g_post_mix = a.in[7]; const float* g_pre_ffn = a.in[8]; const float* g_post_ffn = a.in[9];
    const float* ln_g = a.in[11]; const float* ln_b = a.in[12]; const float* gws = a.in[13]; const float* gbs = a.in[14];
    const float* wd2f = a.in[15]; const float* bdf = a.in[16]; const float* wd2b = a.in[17]; const float* bdb = a.in[18];
    const float* out_g = a.in[19];
    float* MOD = (float*)(ws + WS_MOD); bf16* WIN = (bf16*)(ws + WS_WIN); bf16* WOUT = (bf16*)(ws + WS_WOUT); bf16* WFI = (bf16*)(ws + WS_WFI); bf16* WFO = (bf16*)(ws + WS_WFO);
    float* X = (float*)(ws + WS_X); bf16* H = (bf16*)(ws + WS_H); bf16* P = (bf16*)(ws + WS_P); bf16* CAT = (bf16*)(ws + WS_CAT); bf16* Y = (bf16*)(ws + WS_Y); bf16* HID = (bf16*)(ws + WS_HID);
    bf16* DS = (bf16*)(ws + WS_DS); bf16* SP = (bf16*)(ws + WS_SP); float* DEC = (float*)(ws + WS_DEC); bf16* WSB = (bf16*)(ws + WS_WSB); bf16* QKG = (bf16*)(ws + WS_QK); float* YP = (float*)(ws + WS_YP);
        const int pb = 2 + 9 * l;
        constexpr bool LAST = (l == NL - 1);
        constexpr int NCH_OUT = LAST ? MX / CH : NCHUNK, MROWS = LAST ? MX : M;
        const float* modl = MOD + (size_t)l * 5 * NMOD;
        if (IN(pb + 0)) REP(1) { pg8::Gemm g{H, WIN + (size_t)l * NP * D, M, NP, D, D}; pg8::StaticOrder S; S.init(M, NP, G, bid); pg8::EpiProj E{P, NP, 8};
            pg8::gemm_phase<pg8::EpiProj, pg8::StaticOrder, true, true>(lds, g, S, E); }
        SEAM(pb + 0);
        constexpr int NGM = NCH_OUT * 8, NGM1 = 384;
        if (IN(pb + 1)) REP(2) { PHASE_IDS();
            for (int u = bid; u < NCHUNK * 8; u += G) { const int dir = u & 1, h = (u >> 1) & 3, cid = u >> 3;
                gla_g1_unit(P, (dir ? wd2b : wd2f) + l * 16 * 512, (dir ? bdb : bdf) + l * 512, DS, DEC, cid, h, dir, lds, tid, lane, wave); }
            if (G == 256) { if (bid >= 64) for (int u = bid - 64; u < NGM1; u += 192)
                gmlp_unit_fast(P, CAT, ln_g + l * 1024, ln_b + l * 1024, WSB + (size_t)l * 8 * CH * CH, gbs + l * 8 * CH, u >> 3, u & 7, lds, tid, wave); }
            else for (int u = bid; u < NGM1; u += G)
                gmlp_unit_fast(P, CAT, ln_g + l * 1024, ln_b + l * 1024, WSB + (size_t)l * 8 * CH * CH, gbs + l * 8 * CH, u >> 3, u & 7, lds, tid, wave);
        }
        SEAM(pb + 1);
        if (IN(pb + 2)) REP(3) { PHASE_IDS();
            for (int it = bid * 512 + tid; it < 32 * 8192; it += G * 512) gla_g2_item(DS, DEC, SP, it);
        }
        SEAM(pb + 2);
        if (IN(pb + 3)) REP(4) { PHASE_IDS();
            for (int u = bid; u < NCH_OUT * 4; u += G)
                gla_g3_unit(P, wd2f + l * 16 * 512, bdf + l * 512, wd2b + l * 16 * 512, bdb + l * 512, SP, out_g + l * 1024, CAT, u >> 2, u & 3, lds, tid, lane, wave);
            if (G == 256 && !LAST) { if (bid >= 32) for (int u = NGM1 + bid - 32; u < NGM; u += 224)
                gmlp_unit_fast(P, CAT, ln_g + l * 1024, ln_b + l * 1024, WSB + (size_t)l * 8 * CH * CH, gbs + l * 8 * CH, u >> 3, u & 7, lds, tid, wave); }
            else for (int u = NGM1 + bid; u < NGM; u += G)
                gmlp_unit_fast(P, CAT, ln_g + l * 1024, ln_b + l * 1024, WSB + (size_t)l * 8 * CH * CH, gbs + l * 8 * CH, u >> 3, u & 7, lds, tid, wave);
        }
        SEAM(pb + 3);
        if (IN(pb + 4)) REP(5) { { pg8::Gemm g{CAT, WOUT + (size_t)l * D * D, MX, D, D, D}; pg8::StaticOrder S; S.init(MX, D, G, bid); pg8::EpiProj E{Y, D, 0};
              pg8::gemm_phase<pg8::EpiProj, pg8::StaticOrder, true, true>(lds, g, S, E); }
            if (!LAST) { pg8::Gemm g{CAT + (size_t)MX * D, WOUT + (size_t)l * D * D, MC, D, D, D}; pg8::SplitOrder S; S.init(MC / 256, D / 256, D / 64, bid); pg8::EpiPartF32 E{YP, D, 0, (size_t)MC * D};
              pg8::gemm_phase<pg8::EpiPartF32, pg8::SplitOrder, false, true>(lds, g, S, E); } }
        SEAM(pb + 4);
        if (IN(pb + 5)) { PHASE_IDS();
            RowArgs r{}; r.xin_x = l == 0 ? x : nullptr; r.xin_c = l == 0 ? ctx : nullptr; r.Y = Y; r.YP = LAST ? nullptr : YP; r.X = X; r.Xw = X; r.H = H; r.modA = modl; r.gA = g_post_mix + l * D; r.gB = g_pre_ffn + l * D; r.mode = 1; r.write_h = 1;
            if ((DUP_MASK >> 8) & 1) { RowArgs d = r; d.Xw = (float*)HID; d.H = (bf16*)(ws + WS_QK); d.out = (float*)HID; row_phase(d, MROWS, lds, tid, lane, gw, ngw); }
            row_phase(r, MROWS, lds, tid, lane, gw, ngw);
        }
        SEAM(pb + 5);
        if (IN(pb + 6)) REP(6) { pg8::Gemm g{H, WFI + (size_t)l * 2 * FF * D, MROWS, 2 * FF, D, D}; pg8::StaticOrder S; S.init(MROWS, 2 * FF, G, bid); pg8::EpiSwiglu E{HID, FF};
            pg8::gemm_phase<pg8::EpiSwiglu, pg8::StaticOrder, true, true>(lds, g, S, E); }
        SEAM(pb + 6);
        if (IN(pb + 7)) REP(7) { { pg8::Gemm g{HID, WFO + (size_t)l * D * FF, MX, D, FF, FF}; pg8::StaticOrder S; S.init(MX, D, G, bid); pg8::EpiProj E{Y, D, 0};
              pg8::gemm_phase<pg8::EpiProj, pg8::StaticOrder, true, true>(lds, g, S, E); }
            if (!LAST) { pg8::Gemm g{HID + (size_t)MX * FF, WFO + (size_t)l * D * FF, MC, D, FF, FF}; pg8::SplitOrder S; S.init(MC / 256, D / 256, FF / 64, bid); pg8::EpiPartF32 E{YP, D, 0, (size_t)MC * D};
              pg8::gemm_phase<pg8::EpiPartF32, pg8::SplitOrder, false, true>(lds, g, S, E); } }
        SEAM(pb + 7);
        if (IN(pb + 8)) { PHASE_IDS();
            RowArgs r{}; r.Y = Y; r.YP = LAST ? nullptr : YP; r.X = X; r.Xw = X; r.out = a.out; r.H = H; r.modA = modl; r.modB = modl + 5 * NMOD; r.gA = g_post_ffn + l * D; r.gB = g_pre_mix + (l + 1 < NL ? l + 1 : l) * D; r.mode = 2; r.write_h = (l + 1 < NL); r.to_out = (l + 1 == NL);
            if ((DUP_MASK >> 8) & 1) { RowArgs d = r; d.Xw = (float*)HID; d.H = (bf16*)(ws + WS_QK); d.out = (float*)HID; row_phase(d, MROWS, lds, tid, lane, gw, ngw); }
            row_phase(r, MROWS, lds, tid, lane, gw, ngw);
        }
        SEAM(pb + 8);
}
__global__ void __launch_bounds__(512, 2) mega(Args a) {
    extern __shared__ __attribute__((aligned(16))) unsigned char lds_raw[];
    LAS unsigned char* lds = (LAS unsigned char*)lds_raw;
    const int tid0 = threadIdx.x;
    const int G = gridDim.x, bid = blockIdx.x;
    volatile LAS unsigned* MISC = (volatile LAS unsigned*)(lds + MISC_OFF);
    if (tid0 < 32) MISC[tid0] = 0u;
    __syncthreads();
    unsigned char* ws = a.ws;
    const int lo = a.ph_lo, hi = a.ph_hi;
    XcdBarrier bar; bar.bar = (unsigned*)(ws + WS_CTL) + CW_BAR + a.li * XCD_BAR_WORDS; bar.x = 0; bar.st = nullptr;
    if (hi - lo > 1) bar = xcd_barrier_post((unsigned*)(ws + WS_CTL) + CW_BAR + a.li * XCD_BAR_WORDS, MISC + 8);
    const float* x = a.in[0]; const float* c = a.in[1]; const float* ctx = a.in[2]; const float* cctx = a.in[3];
    const float* w_mod = a.in[4]; const float* b_mod = a.in[5];
    const float* g_pre_mix = a.in[6]; const float* g_post_mix = a.in[7]; const float* g_pre_ffn = a.in[8]; const float* g_post_ffn = a.in[9];
    const float* w_in = a.in[10]; const float* ln_g = a.in[11]; const float* ln_b = a.in[12]; const float* gws = a.in[13]; const float* gbs = a.in[14];
    const float* wd2f = a.in[15]; const float* bdf = a.in[16]; const float* wd2b = a.in[17]; const float* bdb = a.in[18];
    const float* out_g = a.in[19]; const float* w_out = a.in[20]; const float* w_fi = a.in[21]; const float* w_fo = a.in[22];
    float* MOD = (float*)(ws + WS_MOD); bf16* WIN = (bf16*)(ws + WS_WIN); bf16* WOUT = (bf16*)(ws + WS_WOUT); bf16* WFI = (bf16*)(ws + WS_WFI); bf16* WFO = (bf16*)(ws + WS_WFO);
    float* X = (float*)(ws + WS_X); bf16* H = (bf16*)(ws + WS_H); bf16* P = (bf16*)(ws + WS_P); bf16* CAT = (bf16*)(ws + WS_CAT); bf16* Y = (bf16*)(ws + WS_Y); bf16* HID = (bf16*)(ws + WS_HID);
    bf16* DS = (bf16*)(ws + WS_DS); bf16* SP = (bf16*)(ws + WS_SP); float* DEC = (float*)(ws + WS_DEC); bf16* WSB = (bf16*)(ws + WS_WSB); bf16* QKG = (bf16*)(ws + WS_QK); float* YP = (float*)(ws + WS_YP);

    if (IN(0)) REP(0) { PHASE_IDS();
        LAS float* act = (LAS float*)(lds + 8 * 8448);
        for (int i = tid; i < 5 * D; i += 512) { const int r = i / D, k = i % D; const float v = r < NB ? c[r * D + k] : cctx[k]; act[i] = silu_acc(v); }
        __syncthreads();
        for (int item = wave * G + bid; item < NL * (NMOD / 32); item += ngw) {
            const int cg = item % (NMOD / 32), l = item / (NMOD / 32), kq = lane >> 3;
            const int j = cg * 32 + 4 * (lane & 7);
            const float* w = w_mod + ((size_t)l * D + kq) * NMOD + j;
            f32x4 a0 = {0.f, 0.f, 0.f, 0.f}, a1 = a0, a2 = a0, a3 = a0, a4 = a0;
#pragma unroll 8
            for (int i = 0; i < D / 8; ++i) { const f32x4 xv = __builtin_nontemporal_load((const f32x4*)(w + (size_t)(8 * i) * NMOD)); const int k = 8 * i + kq;
                a0 += xv * act[0 * D + k]; a1 += xv * act[1 * D + k]; a2 += xv * act[2 * D + k]; a3 += xv * act[3 * D + k]; a4 += xv * act[4 * D + k]; }
#pragma unroll
            for (int t = 0; t < 4; ++t) {
#pragma unroll
                for (int o = 8; o < 64; o <<= 1) { a0[t] += __shfl_xor(a0[t], o); a1[t] += __shfl_xor(a1[t], o); a2[t] += __shfl_xor(a2[t], o); a3[t] += __shfl_xor(a3[t], o); a4[t] += __shfl_xor(a4[t], o); } }
            if (kq == 0) { const f32x4 bb = *(const f32x4*)(b_mod + (size_t)l * NMOD + j); float* o = MOD + (size_t)l * 5 * NMOD + j;
                *(f32x4*)(o) = a0 + bb; *(f32x4*)(o + NMOD) = a1 + bb; *(f32x4*)(o + 2 * NMOD) = a2 + bb; *(f32x4*)(o + 3 * NMOD) = a3 + bb; *(f32x4*)(o + 4 * NMOD) = a4 + bb; }
        }
        for (int it = bid * 512 + tid; it < NL * 8 * CH * CH / 8; it += G * 512) { const f32x4 a0 = *(const f32x4*)(gws + (size_t)it * 8), a1 = *(const f32x4*)(gws + (size_t)it * 8 + 4);
            u32x4 o; o.x = pk2(a0[0], a0[1]); o.y = pk2(a0[2], a0[3]); o.z = pk2(a1[0], a1[1]); o.w = pk2(a1[2], a1[3]); *(u32x4*)(WSB + (size_t)it * 8) = o; }
        LAS float* scr = (LAS float*)(lds + wave * 8448);
        int it0 = 0;
        conv_matrix(w_in, WIN, D, PIN, NP, 1, it0, gw, ngw, scr, lane);
        conv_matrix(w_out, WOUT, D, D, D, 0, it0, gw, ngw, scr, lane);
        conv_matrix(w_fi, WFI, D, 2 * FF, 2 * FF, 2, it0, gw, ngw, scr, lane);
        conv_matrix(w_fo, WFO, FF, D, D, 0, it0, gw, ngw, scr, lane);
    }
    SEAM(0);
    if (IN(1)) { PHASE_IDS();
        RowArgs r{}; r.xin_x = x; r.xin_c = ctx; r.X = X; r.Xw = X; r.H = H; r.modB = MOD; r.gB = g_pre_mix; r.mode = 0; r.write_h = 1;
        row_phase(r, M, lds, tid, lane, gw, ngw);
    }
    SEAM(1);
    run_layer<0>(a, lds, bar, tid0, G, bid, lo, hi);
    run_layer<1>(a, lds, bar, tid0, G, bid, lo, hi);
    run_layer<2>(a, lds, bar, tid0, G, bid, lo, hi);
    run_layer<3>(a, lds, bar, tid0, G, bid, lo, hi);
#undef IN
#undef SEAM
}

#ifndef MK_SPLIT
#define MK_SPLIT 0
#endif
extern "C" void kernel_launch(void* const* d_in, const int* in_sizes, int n_in, void* d_out, int out_size, void* d_ws, size_t ws_size, hipStream_t stream) {
    static int grid = 0;
    if (grid == 0) {
        if (n_in != 23 || ws_size < WS_END || out_size != MX * D) { fprintf(stderr, "kernel_launch: unexpected shapes (n_in %d, ws %zu, out %d)\n", n_in, ws_size, out_size); grid = -1; return; }
        int dev = 0, cus = 0, per_cu = 0;
        if (hipGetDevice(&dev) != hipSuccess || hipDeviceGetAttribute(&cus, hipDeviceAttributeMultiprocessorCount, dev) != hipSuccess) { grid = -1; return; }
        if (hipFuncSetAttribute((const void*)mega, hipFuncAttributeMaxDynamicSharedMemorySize, LDS_BYTES) != hipSuccess) { fprintf(stderr, "kernel_launch: hipFuncSetAttribute failed\n"); grid = -1; return; }
        if (hipOccupancyMaxActiveBlocksPerMultiprocessor(&per_cu, (const void*)mega, 512, LDS_BYTES) != hipSuccess || per_cu < 1) { fprintf(stderr, "kernel_launch: occupancy query says %d\n", per_cu); }
        (void)hipGetLastError();
        grid = cus;
    }
    if (grid < 0) return;
    (void)hipMemsetAsync((char*)d_ws + WS_CTL, 0, ZERO_BYTES, stream);
    Args a{};
    for (int i = 0; i < 23; ++i) a.in[i] = (const float*)d_in[i];
    a.out = (float*)d_out; a.ws = (unsigned char*)d_ws;
#if MK_SPLIT
    for (int p = 0; p < NPH; ++p) { a.ph_lo = p; a.ph_hi = p + 1; a.li = 0; hipLaunchKernelGGL(mega, dim3(grid), dim3(512), LDS_BYTES, stream, a); }
#else
    a.ph_lo = 0; a.ph_hi = NPH; a.li = 0;
    hipLaunchKernelGGL(mega, dim3(grid), dim3(512), LDS_BYTES, stream, a);
#endif
}
```

```cpp
#include <hip/hip_runtime.h>
#include <cstdio>
#include <cstdint>
namespace pg8 {
#define PG8_LAS __attribute__((address_space(3)))
typedef unsigned short bf16_t;
typedef short bf16x8 __attribute__((ext_vector_type(8)));
typedef float f32x4 __attribute__((ext_vector_type(4)));
typedef unsigned u32x4 __attribute__((ext_vector_type(4)));
constexpr int BM = 256, BK = 64, HALF = 128, HTB = HALF * BK * 2  , STAGE_BYTES = 8 * HTB, NXCD = 8, WGM = 8;

__host__ __device__ __forceinline__ int lds_byte(int r, int c) { const int st = (r >> 4) * 2 + (c >> 5), rr = r & 15, cc = c & 31, ob = rr * 64 + cc * 2; return st * 1024 + (ob ^ (((ob >> 9) & 1) << 5)); }
__host__ __device__ __forceinline__ void stage_rc(int b, int& R, int& C) { const int st = b / 1024, sb = b % 1024, swz = sb ^ (((sb >> 9) & 1) << 5); R = (st >> 1) * 16 + swz / 64; C = (st & 1) * 32 + (swz % 64) / 2; }
__host__ __device__ __forceinline__ int perm32(int rho) { const int n = rho >> 4, i = rho & 15; return 8 * (i >> 2) + 4 * n + (i & 3); }

struct Unit { int pm, pn, koff, ks; };
struct Gemm { const bf16_t* A; const bf16_t* Bt; int M, N, K, ld; };

struct StaticOrder {
    int nM, nN, nwg, G, c;
    __host__ __device__ void init(int M, int N, int G_, int c_) { nM = M / BM; nN = N / BM; nwg = nM * nN; G = G_; c = c_; }
    __host__ __device__ bool next(int i, Unit& u) const {
        const long L = (long)i * G + c; if (L >= nwg) return false;
        int wgid = (int)L; { const int q = nwg / NXCD, r = nwg % NXCD, xcd = wgid % NXCD, off = wgid / NXCD; wgid = (xcd < r ? xcd * (q + 1) : r * (q + 1) + (xcd - r) * q) + off; }
        const int nig = WGM * nN, gid = wgid / nig, fm = gid * WGM, gsz = (nM - fm) < WGM ? (nM - fm) : WGM;
        u.pm = fm + ((wgid % nig) % gsz); u.pn = (wgid % nig) / gsz; u.koff = 0; u.ks = 0; return true;
    }
    __device__ __forceinline__ void a_ready(const Unit&) const {}
    __device__ __forceinline__ void done(const Unit&) const {}
    __device__ __forceinline__ int nt(int full) const { return full; }
};
struct SplitOrder {
    int nN, ntiles, c, kt0, ktn;
    __host__ __device__ void init(int nM, int nN_, int KT, int c_) { nN = nN_; ntiles = nM * nN_; c = c_; const int ks = c / ntiles, base = (KT / 8) & ~1, rem = KT - 8 * base, nbig = rem / 2;
        ktn = base + (ks >= 8 - nbig ? 2 : 0); kt0 = ks * base + (ks > 8 - nbig ? 2 * (ks - (8 - nbig)) : 0); }
    __host__ __device__ bool next(int i, Unit& u) const { if (i != 0 || c >= 8 * ntiles) return false; const int t = c % ntiles; u.pm = t / nN; u.pn = t % nN; u.ks = c / ntiles; u.koff = kt0 * BK * 2; return true; }
    __device__ __forceinline__ void a_ready(const Unit&) const {}
    __device__ __forceinline__ void done(const Unit&) const {}
    __device__ __forceinline__ int nt(int) const { return ktn; }
};


__device__ __forceinline__ unsigned cvt_pk_bf16(float lo, float hi) { unsigned r; asm volatile("v_cvt_pk_bf16_f32 %0, %1, %2" : "=v"(r) : "v"(lo), "v"(hi)); return r; }
__device__ __forceinline__ float fast_sigmoid(float x) { return __builtin_amdgcn_rcpf(1.0f + __builtin_amdgcn_exp2f(-1.4426950408889634f * x)); }
__device__ __forceinline__ float gelu_tanh(float x) { const float y = 1.5957691216057308f * (x + 0.044715f * x * x * x); return x * fast_sigmoid(y); }
__device__ __forceinline__ float silu_f(float x) { return x * fast_sigmoid(x); }

struct EpiF32 {
    static constexpr bool PERM = false, AFTER_DRAIN = false;
    float* C; int ldc; int pad;
    __device__ __forceinline__ void operator()(const f32x4 (&acc)[2][2][4][2], const Unit& u, int wr, int wc, int fr, int fq) const {
        const int row0 = u.pm * BM + wr * 64 + fr, col0 = u.pn * BM + wc * 32 + 4 * fq;
#pragma unroll
        for (int ai = 0; ai < 2; ++ai)
#pragma unroll
            for (int m = 0; m < 4; ++m) { float* rowp = C + (size_t)(row0 + ai * HALF + m * 16) * ldc + col0;
#pragma unroll
                for (int bj = 0; bj < 2; ++bj)
#pragma unroll
                    for (int n = 0; n < 2; ++n) *(f32x4*)(rowp + bj * HALF + n * 16) = acc[ai][bj][m][n]; }
    }
};
struct EpiPartF32 {
    static constexpr bool PERM = false, AFTER_DRAIN = false;
    float* C; int ldc; int pad; size_t split_stride;
    __device__ __forceinline__ void operator()(const f32x4 (&acc)[2][2][4][2], const Unit& u, int wr, int wc, int fr, int fq) const {
        const int row0 = u.pm * BM + wr * 64 + fr, col0 = u.pn * BM + wc * 32 + 4 * fq; float* base = C + (size_t)u.ks * split_stride;
#pragma unroll
        for (int ai = 0; ai < 2; ++ai)
#pragma unroll
            for (int m = 0; m < 4; ++m) { float* rowp = base + (size_t)(row0 + ai * HALF + m * 16) * ldc + col0;
#pragma unroll
                for (int bj = 0; bj < 2; ++bj)
#pragma unroll
                    for (int n = 0; n < 2; ++n) *(f32x4*)(rowp + bj * HALF + n * 16) = acc[ai][bj][m][n]; }
    }
};
struct EpiProj {
    static constexpr bool PERM = true, AFTER_DRAIN = false;
    bf16_t* O; int ldc; int ngelu;
    __device__ __forceinline__ void operator()(const f32x4 (&acc)[2][2][4][2], const Unit& u, int wr, int wc, int fr, int fq) const {
        const int row0 = u.pm * BM + wr * 64 + fr, col0 = u.pn * BM + wc * 32 + 8 * fq;
        const bool act = u.pn < ngelu;
#pragma unroll
        for (int ai = 0; ai < 2; ++ai)
#pragma unroll
            for (int m = 0; m < 4; ++m) { bf16_t* rowp = O + (size_t)(row0 + ai * HALF + m * 16) * ldc + col0;
#pragma unroll
                for (int bj = 0; bj < 2; ++bj) { f32x4 v0 = acc[ai][bj][m][0], v1 = acc[ai][bj][m][1];
                    if (act) {
#pragma unroll
                        for (int j = 0; j < 4; ++j) { v0[j] = gelu_tanh(v0[j]); v1[j] = gelu_tanh(v1[j]); } }
                    u32x4 w; w.x = cvt_pk_bf16(v0[0], v0[1]); w.y = cvt_pk_bf16(v0[2], v0[3]); w.z = cvt_pk_bf16(v1[0], v1[1]); w.w = cvt_pk_bf16(v1[2], v1[3]);
                    *(u32x4*)(rowp + bj * HALF) = w; } }
    }
};
struct EpiSwiglu {
    static constexpr bool PERM = true, AFTER_DRAIN = false;
    bf16_t* O; int ldc; int pad;
    __device__ __forceinline__ void operator()(const f32x4 (&acc)[2][2][4][2], const Unit& u, int wr, int wc, int fr, int fq) const {
        const int row0 = u.pm * BM + wr * 64 + fr, col0 = u.pn * HALF + wc * 32 + 8 * fq;
#pragma unroll
        for (int ai = 0; ai < 2; ++ai)
#pragma unroll
            for (int m = 0; m < 4; ++m) { bf16_t* rowp = O + (size_t)(row0 + ai * HALF + m * 16) * ldc + col0;
                f32x4 h0, h1;
#pragma unroll
                for (int j = 0; j < 4; ++j) { h0[j] = silu_f(acc[ai][0][m][0][j]) * acc[ai][1][m][0][j]; h1[j] = silu_f(acc[ai][0][m][1][j]) * acc[ai][1][m][1][j]; }
                u32x4 w; w.x = cvt_pk_bf16(h0[0], h0[1]); w.y = cvt_pk_bf16(h0[2], h0[3]); w.z = cvt_pk_bf16(h1[0], h1[1]); w.w = cvt_pk_bf16(h1[2], h1[3]);
                *(u32x4*)rowp = w; }
    }
};

template <class Epi, class Sched, bool ALIGN_EPI = false, bool SP2 = false>
__device__ __forceinline__ void gemm_phase(PG8_LAS unsigned char* lds, const Gemm g, const Sched& S, const Epi& E) {
    int tid_o = threadIdx.x; asm volatile("" : "+v"(tid_o));
    const int tid = tid_o, wid = __builtin_amdgcn_readfirstlane(tid >> 6), lane = tid & 63, wr = wid >> 2, wc = wid & 3, fr = lane & 15, fq = lane >> 4;
    const int K = g.ld, nt = S.nt(g.K / BK);
    unsigned voffA[2], voffB[2];
#pragma unroll
    for (int i = 0; i < 2; ++i) { int R, C; stage_rc(tid * 16 + i * 8192, R, C); const int Rb = Epi::PERM ? ((R & ~31) + perm32(R & 31)) : R;
        voffA[i] = (unsigned)(R * K + C) * 2u; voffB[i] = (unsigned)(Rb * K + C) * 2u; }
    const size_t kstep = (size_t)(BK * 2);
    const size_t hstep = (size_t)HALF * K * 2;
    const size_t tstep = 2 * hstep;
    const unsigned ldsw = (unsigned)wid * 1024u;
    const int aoff = lds_byte(wr * 64 + fr, fq * 8), boff = lds_byte(wc * 32 + fr, fq * 8);
#define PG8_SA(b, h) (((b) * 2 + (h)) * HTB)
#define PG8_SB(b, h) ((4 + (b) * 2 + (h)) * HTB)
#define PG8_STAGE(bufoff, gbase, voff) do { _Pragma("unroll") for (int _i = 0; _i < 2; ++_i) \
        __builtin_amdgcn_global_load_lds((const unsigned*)((const char*)(gbase) + (voff)[_i]), (PG8_LAS unsigned*)(lds + (bufoff) + ldsw + _i * 8192), 16, 0, 0); } while (0)
#define PG8_LDA(dst, b, h) do { _Pragma("unroll") for (int m = 0; m < 4; ++m) _Pragma("unroll") for (int k = 0; k < 2; ++k) dst[m][k] = *(const PG8_LAS bf16x8*)(lds + PG8_SA(b, h) + aoff + m * 2048 + k * 1024); } while (0)
#define PG8_LDB(dst, b, h) do { _Pragma("unroll") for (int n = 0; n < 2; ++n) _Pragma("unroll") for (int k = 0; k < 2; ++k) dst[n][k] = *(const PG8_LAS bf16x8*)(lds + PG8_SB(b, h) + boff + n * 2048 + k * 1024); } while (0)
#define PG8_MMA(ai, bj, At, Bt) do { __builtin_amdgcn_s_setprio(1); _Pragma("unroll") for (int m = 0; m < 4; ++m) _Pragma("unroll") for (int n = 0; n < 2; ++n) _Pragma("unroll") for (int k = 0; k < 2; ++k) \
        acc[ai][bj][m][n] = __builtin_amdgcn_mfma_f32_16x16x32_bf16(Bt[n][k], At[m][k], acc[ai][bj][m][n], 0, 0, 0); __builtin_amdgcn_s_setprio(0); } while (0)
#define PG8_WAIT_V(n) asm volatile("s_waitcnt vmcnt(" #n ")" ::: "memory")
#define PG8_WAIT_L(n) asm volatile("s_waitcnt lgkmcnt(" #n ")" ::: "memory")
#define PG8_BAR __builtin_amdgcn_s_barrier()
#define PG8_SCHED __builtin_amdgcn_sched_barrier(0)
    Unit cur, nxt; int ui = 0;
    if (!S.next(0, cur)) return;
    f32x4 acc[2][2][4][2];
#pragma unroll
    for (int a = 0; a < 2; ++a)
#pragma unroll
        for (int b = 0; b < 2; ++b)
#pragma unroll
            for (int m = 0; m < 4; ++m)
#pragma unroll
                for (int n = 0; n < 2; ++n) acc[a][b][m][n] = (f32x4){0.f, 0.f, 0.f, 0.f};
    bf16x8 At[4][2], B0[2][2], B1[2][2];
    const char* cA = (const char*)g.A + (size_t)cur.pm * tstep + cur.koff; const char* cB = (const char*)g.Bt + (size_t)cur.pn * tstep + cur.koff;
    S.a_ready(cur);
    if constexpr (SP2) {
        PG8_STAGE(PG8_SB(0, 0), cB, voffB); PG8_STAGE(PG8_SB(0, 1), cB + hstep, voffB); PG8_STAGE(PG8_SA(0, 0), cA, voffA); PG8_STAGE(PG8_SA(0, 1), cA + hstep, voffA);
        if (wr == 1) PG8_BAR;
        PG8_WAIT_V(2); PG8_BAR;
        PG8_STAGE(PG8_SB(1, 0), cB + kstep, voffB); PG8_STAGE(PG8_SA(1, 0), cA + kstep, voffA); PG8_STAGE(PG8_SB(1, 1), cB + hstep + kstep, voffB);
        PG8_WAIT_V(6); PG8_BAR;
    } else {
        PG8_STAGE(PG8_SB(0, 0), cB, voffB); PG8_STAGE(PG8_SA(0, 0), cA, voffA); PG8_STAGE(PG8_SB(0, 1), cB + hstep, voffB); PG8_STAGE(PG8_SA(0, 1), cA + hstep, voffA);
        if (wr == 1) PG8_BAR;
        PG8_WAIT_V(4); PG8_BAR;
        PG8_STAGE(PG8_SB(1, 0), cB + kstep, voffB); PG8_STAGE(PG8_SA(1, 0), cA + kstep, voffA); PG8_STAGE(PG8_SB(1, 1), cB + hstep + kstep, voffB);
        PG8_WAIT_V(6); PG8_BAR;
    }
    for (;;) {
        const bool has_next = S.next(ui + 1, nxt);
        const char* nA = has_next ? (const char*)g.A + (size_t)nxt.pm * tstep + nxt.koff : cA; const char* nB = has_next ? (const char*)g.Bt + (size_t)nxt.pn * tstep + nxt.koff : cB;
        for (int t = 0; t < nt; t += 2) {
            const bool last = (t == nt - 2);
            const char* a1 = cA + (size_t)(t + 1) * kstep;
            const char* a2 = last ? nA : cA + (size_t)(t + 2) * kstep; const char* b2 = last ? nB : cB + (size_t)(t + 2) * kstep;
            const char* a3 = a2 + kstep; const char* b3 = b2 + kstep;
            if (last && has_next) S.a_ready(nxt);
            if constexpr (SP2) {
            PG8_LDB(B0, 0, 0); PG8_LDB(B1, 0, 1); PG8_SCHED; PG8_LDA(At, 0, 0); PG8_STAGE(PG8_SA(1, 1), a1 + hstep, voffA);
            PG8_WAIT_V(8); PG8_WAIT_L(0); PG8_BAR; PG8_MMA(0, 0, At, B0); PG8_MMA(0, 1, At, B1); PG8_BAR; PG8_SCHED;
            PG8_LDA(At, 0, 1); PG8_STAGE(PG8_SB(0, 0), b2, voffB); PG8_STAGE(PG8_SB(0, 1), b2 + hstep, voffB); PG8_STAGE(PG8_SA(0, 0), a2, voffA);
            PG8_WAIT_V(8); PG8_WAIT_L(0); PG8_BAR; PG8_MMA(1, 0, At, B0); PG8_MMA(1, 1, At, B1); PG8_BAR; PG8_SCHED;
            PG8_LDB(B0, 1, 0); PG8_LDB(B1, 1, 1); PG8_SCHED; PG8_LDA(At, 1, 0); PG8_STAGE(PG8_SA(0, 1), a2 + hstep, voffA);
            PG8_WAIT_V(8); PG8_WAIT_L(0); PG8_BAR; PG8_MMA(0, 0, At, B0); PG8_MMA(0, 1, At, B1); PG8_BAR; PG8_SCHED;
            PG8_LDA(At, 1, 1); PG8_STAGE(PG8_SB(1, 0), b3, voffB); PG8_STAGE(PG8_SB(1, 1), b3 + hstep, voffB); PG8_STAGE(PG8_SA(1, 0), a3, voffA);
            PG8_WAIT_V(8); PG8_WAIT_L(0); PG8_BAR; PG8_MMA(1, 0, At, B0); PG8_MMA(1, 1, At, B1); PG8_BAR; PG8_SCHED;
            } else {
            PG8_LDB(B0, 0, 0); PG8_SCHED; PG8_LDA(At, 0, 0); PG8_STAGE(PG8_SA(1, 1), a1 + hstep, voffA);
            PG8_WAIT_L(8); PG8_BAR; PG8_WAIT_L(0); PG8_MMA(0, 0, At, B0); PG8_BAR; PG8_SCHED;
            PG8_LDB(B1, 0, 1); PG8_STAGE(PG8_SB(0, 0), b2, voffB);
            PG8_BAR; PG8_WAIT_L(0); PG8_MMA(0, 1, At, B1); PG8_BAR;
            PG8_LDA(At, 0, 1); PG8_STAGE(PG8_SA(0, 0), a2, voffA);
            PG8_BAR; PG8_WAIT_L(0); PG8_MMA(1, 0, At, B0); PG8_BAR; PG8_SCHED;
            PG8_STAGE(PG8_SB(0, 1), b2 + hstep, voffB);
            PG8_WAIT_V(6); PG8_BAR; PG8_MMA(1, 1, At, B1); PG8_BAR;
            PG8_LDB(B0, 1, 0); PG8_SCHED; PG8_LDA(At, 1, 0); PG8_STAGE(PG8_SA(0, 1), a2 + hstep, voffA);
            PG8_WAIT_L(8); PG8_BAR; PG8_WAIT_L(0); PG8_MMA(0, 0, At, B0); PG8_BAR; PG8_SCHED;
            PG8_LDB(B1, 1, 1); PG8_STAGE(PG8_SB(1, 0), b3, voffB);
            PG8_BAR; PG8_WAIT_L(0); PG8_MMA(0, 1, At, B1); PG8_BAR;
            PG8_LDA(At, 1, 1); PG8_STAGE(PG8_SA(1, 0), a3, voffA);
            PG8_BAR; PG8_WAIT_L(0); PG8_MMA(1, 0, At, B0); PG8_BAR; PG8_SCHED;
            PG8_STAGE(PG8_SB(1, 1), b3 + hstep, voffB);
            PG8_WAIT_V(6); PG8_BAR; PG8_MMA(1, 1, At, B1); PG8_BAR;
            }
        }
        if constexpr (ALIGN_EPI) { if (wr == 0) PG8_BAR; }
        if constexpr (!Epi::AFTER_DRAIN) { E(acc, cur, wr, wc, fr, fq); S.done(cur); }
        if (!has_next) break;
#pragma unroll
        for (int a = 0; a < 2; ++a)
#pragma unroll
            for (int b = 0; b < 2; ++b)
#pragma unroll
                for (int m = 0; m < 4; ++m)
#pragma unroll
                    for (int n = 0; n < 2; ++n) acc[a][b][m][n] = (f32x4){0.f, 0.f, 0.f, 0.f};
        cur = nxt; cA = nA; cB = nB; ++ui;
        if constexpr (ALIGN_EPI) { if (wr == 1) PG8_BAR; }
    }
    PG8_WAIT_V(0);
    if constexpr (!ALIGN_EPI) { if (wr == 0) PG8_BAR; }
    PG8_BAR;
    if constexpr (Epi::AFTER_DRAIN) { E.fused(acc, cur, wr, wc, fr, fq, lds, wid, lane); S.done(cur); }
#undef PG8_SA
#undef PG8_SB
#undef PG8_STAGE
#undef PG8_LDA
#undef PG8_LDB
#undef PG8_MMA
#undef PG8_WAIT_V
#undef PG8_WAIT_L
#undef PG8_BAR
#undef PG8_SCHED
}
}
#define XB_TMO      128
#define XB_XCNT(j)  (256  + 64 * (j))
#define XB_XSUB(j)  (1280 + 64 * (j))
#define XB_XGEN(j)  (2304 + 64 * (j))
#define XB_TOP      3328
#define XB_TOPGEN   3392
#define XCD_BAR_WORDS 3456
#define XB_SPIN_CAP (1u << 18)
#define LAS __attribute__((address_space(3)))

__device__ __forceinline__ unsigned xb_ld(unsigned* p)              { return __hip_atomic_load(p, __ATOMIC_RELAXED, __HIP_MEMORY_SCOPE_AGENT); }
__device__ __forceinline__ unsigned xb_add(unsigned* p, unsigned v) { return __hip_atomic_fetch_add(p, v, __ATOMIC_RELAXED, __HIP_MEMORY_SCOPE_AGENT); }
__device__ __forceinline__ unsigned xb_xcc_id() { return (unsigned)__builtin_amdgcn_s_getreg((3 << 11) | 20) & 0xFu; }
#define XB_SPIN(cond, bar) do { unsigned _sp = 0; while (cond) { __builtin_amdgcn_s_sleep(1); \
    if ((++_sp & 255u) == 0u) { if (xb_ld(&(bar)[XB_TMO])) break; if (_sp > XB_SPIN_CAP) { atomicAdd(&(bar)[XB_TMO], 1u); break; } } } } while (0)

struct XcdBarrier {
    unsigned* bar; unsigned x;
    volatile LAS unsigned* st;
};

__device__ __forceinline__ XcdBarrier xcd_barrier_post(unsigned* bar, volatile LAS unsigned* st) {
    XcdBarrier b; b.bar = bar; b.x = xb_xcc_id(); b.st = st;
    if (threadIdx.x == 0) (void)xb_add(&bar[XB_XCNT(b.x)], 1u);
    return b;
}
__device__ __forceinline__ void xcd_barrier_complete(unsigned* bar, unsigned x, unsigned& nloc, unsigned& nx) {
    const unsigned G = gridDim.x * gridDim.y * gridDim.z;
    unsigned sum, cnt, mine, sp = 0u;
    for (;;) {
        sum = 0u; cnt = 0u; mine = 0u;
#pragma unroll
        for (unsigned j = 0; j < 16; ++j) { const unsigned c = xb_ld(&bar[XB_XCNT(j)]); sum += c; cnt += (c > 0u) ? 1u : 0u; mine = (j == x) ? c : mine; }
        if (sum == G) break;
        __builtin_amdgcn_s_sleep(1);
        if ((++sp & 255u) == 0u) { if (xb_ld(&bar[XB_TMO])) break; if (sp > XB_SPIN_CAP) { atomicAdd(&bar[XB_TMO], 1u); break; } }
    }
    nloc = mine > 0u ? mine : 1u; nx = cnt > 0u ? cnt : 1u;
}

__device__ __forceinline__ void xcd_barrier(const XcdBarrier& b) {
    asm volatile("s_waitcnt vmcnt(0)" ::: "memory");
    __syncthreads();
    if (threadIdx.x == 0) {
        unsigned* bar = b.bar;
        __builtin_amdgcn_s_waitcnt(0);
        unsigned nloc = b.st[0], nx = b.st[1];
        if (nloc == 0u) { xcd_barrier_complete(bar, b.x, nloc, nx); b.st[0] = nloc; b.st[1] = nx; }
        const unsigned old = xb_add(&bar[XB_XSUB(b.x)], 1u);
        const unsigned gen = old / nloc;
        if (old + 1u == (gen + 1u) * nloc) {
            __builtin_amdgcn_fence(__ATOMIC_RELEASE, "agent");
            asm volatile("s_waitcnt vmcnt(0)" ::: "memory");
            const unsigned og = xb_add(&bar[XB_TOP], 1u);
            const unsigned tg = og / nx;
            if (og + 1u == (tg + 1u) * nx) xb_add(&bar[XB_TOPGEN], 1u);
            else XB_SPIN(xb_ld(&bar[XB_TOPGEN]) == tg, bar);
            __builtin_amdgcn_fence(__ATOMIC_ACQUIRE, "agent");
            xb_add(&bar[XB_XGEN(b.x)], 1u);
            asm volatile("s_waitcnt vmcnt(0)" ::: "memory");
        } else {
            XB_SPIN(xb_ld(&bar[XB_XGEN(b.x)]) == gen, bar);
            __builtin_amdgcn_fence(__ATOMIC_ACQUIRE, "agent");
            asm volatile("s_waitcnt vmcnt(0)" ::: "memory");
        }
    }
    __syncthreads();
}

typedef unsigned short bf16;
typedef float f32x4 __attribute__((ext_vector_type(4)));
typedef unsigned u32x4 __attribute__((ext_vector_type(4)));
typedef unsigned u32x2 __attribute__((ext_vector_type(2)));
constexpr int D = 2048, NB = 4, SEQ = 4096, NL = 4, CTX = 256, CH = 128;
constexpr int MX = NB * SEQ, MC = NB * CTX, M = MX + MC;
constexpr int PIN = 5152, NP = 5376, FF = 5632, NMOD = 6 * D;
constexpr int C_U = 0, C_V = 1024, C_Q = 2048, C_K = 2560, C_VV = 3072, C_G = 4096, C_DF = 5120, C_DB = 5136;
constexpr int NCHUNK = M / CH;
constexpr float EPS = 1e-6f;
constexpr size_t MiB = 1u << 20;
constexpr size_t WS_CTL = 0, WS_MOD = 1 * MiB, ZERO_BYTES = 2 * MiB, WS_WIN = 2 * MiB, WS_WOUT = WS_WIN + 84 * MiB, WS_WFI = WS_WOUT + 32 * MiB, WS_WFO = WS_WFI + 176 * MiB,
                 WS_X = WS_WFO + 88 * MiB, WS_H = WS_X + 136 * MiB, WS_P = WS_H + 68 * MiB, WS_CAT = WS_P + 179 * MiB, WS_Y = WS_CAT + 68 * MiB, WS_HID = WS_Y + 136 * MiB,
                 WS_DS = WS_HID + 187 * MiB, WS_SP = WS_DS + 136 * MiB, WS_DEC = WS_SP + 68 * MiB, WS_WSB = WS_DEC + 1 * MiB, WS_QK = WS_WSB + 1 * MiB, WS_YP = WS_QK + 68 * MiB, WS_END = WS_YP + 64 * MiB;
static_assert((size_t)NL * NP * D * 2 <= 84 * MiB && (size_t)NL * 2 * FF * D * 2 <= 176 * MiB && (size_t)NL * D * FF * 2 <= 88 * MiB && (size_t)M * NP * 2 <= 179 * MiB && (size_t)M * FF * 2 <= 187 * MiB, "ws map");
constexpr int CW_BAR = 4096;
constexpr int LDS_BYTES = 163840, MISC_OFF = LDS_BYTES - 256;

__device__ __forceinline__ float bf2f(bf16 b) { return __uint_as_float(((unsigned)b) << 16); }
__device__ __forceinline__ unsigned f2bf(float f) { unsigned u = __float_as_uint(f); return (u + 0x7fffu + ((u >> 16) & 1u)) >> 16; }
__device__ __forceinline__ unsigned pk2(float lo, float hi) { return f2bf(lo) | (f2bf(hi) << 16); }
__device__ __forceinline__ float wave_sum(float v) {
#pragma unroll
    for (int o = 1; o < 64; o <<= 1) v += __shfl_xor(v, o);
    return v;
}
__device__ __forceinline__ float sigmoid_acc(float x) { return 1.0f / (1.0f + __expf(-x)); }
__device__ __forceinline__ float silu_acc(float x) { return x * sigmoid_acc(x); }
__device__ __forceinline__ float log_sigmoid(float z) { return fminf(z, 0.f) - log1pf(__expf(-fabsf(z))); }
__device__ __forceinline__ int mod_row(int row) { return row < MX ? row / SEQ : NB; }
#define LDS_WAIT() asm volatile("s_waitcnt lgkmcnt(0)" ::: "memory")


__device__ __forceinline__ int map_col(int mode, int r) {
    if (mode == 0) return r;
    if (mode == 1) return r < PIN ? r : -1;
    const int pn = r >> 8, rr = r & 255; return rr < 128 ? pn * 128 + rr : FF + pn * 128 + (rr - 128);
}
__device__ __forceinline__ void transpose_item(const float* W, int K, int Nsrc, bf16* T, int n0, int c0, int k0, LAS float* scr, int lane) {
    if (c0 >= 0) {
#pragma unroll 8
        for (int i = 0; i < 32; ++i) { const int kk = 2 * i + (lane >> 5); scr[kk * 33 + (lane & 31)] = __builtin_nontemporal_load(W + (size_t)(k0 + kk) * Nsrc + c0 + (lane & 31)); }
    } else {
#pragma unroll 8
        for (int i = 0; i < 32; ++i) { const int kk = 2 * i + (lane >> 5); scr[kk * 33 + (lane & 31)] = 0.f; }
    }
    LDS_WAIT(); asm volatile("" ::: "memory");
    const int c = lane & 7;
#pragma unroll
    for (int j = 0; j < 4; ++j) { const int n = (lane >> 3) + 8 * j; const LAS float* s = scr + (8 * c) * 33 + n;
        u32x4 o; o.x = pk2(s[0 * 33], s[1 * 33]); o.y = pk2(s[2 * 33], s[3 * 33]); o.z = pk2(s[4 * 33], s[5 * 33]); o.w = pk2(s[6 * 33], s[7 * 33]);
        __builtin_nontemporal_store(o, (u32x4*)(T + (size_t)(n0 + n) * K + k0 + 8 * c)); }
    LDS_WAIT(); asm volatile("" ::: "memory");
}
__device__ __forceinline__ void conv_matrix(const float* W, bf16* T, int K, int Nsrc, int Ndst, int mode, int& it0, int gw, int ngw, LAS float* scr, int lane) {
    const int nblk = Ndst / 32, per_layer = (K / 64) * nblk, total = NL * per_layer;
    int first = ((gw - it0) % ngw + ngw) % ngw;
    for (int it = first; it < total; it += ngw) {
        const int l = it / per_layer, r = it % per_layer, kb = r / nblk, nb = r % nblk;
        transpose_item(W + (size_t)l * K * Nsrc, K, Nsrc, T + (size_t)l * Ndst * K, 32 * nb, map_col(mode, 32 * nb), 64 * kb, scr, lane);
    }
    it0 += total;
}
struct RowArgs { const float* xin_x; const float* xin_c; const float* YP; const bf16* Y; bf16* X; bf16* Xw; float* out; bf16* H; const float* modA; const float* modB; const float* gA; const float* gB; int mode; int write_h; int to_out; int pad; };
__device__ __forceinline__ void row_vectors(const RowArgs& a, LAS float* VEC, int tid) {
    for (int i = tid; i < 5 * (D / 4); i += 512) { const int r = i / (D / 4), c = (i % (D / 4)) * 4;
        if (a.mode != 0) { const f32x4 m = *(const f32x4*)(a.modA + (size_t)r * NMOD + (a.mode == 1 ? 2 : 5) * D + c), g = *(const f32x4*)(a.gA + c); *(LAS f32x4*)(VEC + (r * 3 + 0) * D + c) = m * g; }
        if (a.write_h) { const float* msh = (a.mode == 1 ? a.modA + (size_t)r * NMOD + 3 * D : a.modB + (size_t)r * NMOD);
            const f32x4 sh = *(const f32x4*)(msh + c), sc = *(const f32x4*)(msh + D + c), g = *(const f32x4*)(a.gB + c);
            *(LAS f32x4*)(VEC + (r * 3 + 1) * D + c) = g * (sc + 1.0f); *(LAS f32x4*)(VEC + (r * 3 + 2) * D + c) = sh; } }
}
__device__ __forceinline__ bool row_from_input(const RowArgs& a) { return !(a.mode == 2 || a.xin_x == nullptr); }
__device__ __forceinline__ f32x4 row_load_x(const RowArgs& a, int row, int off) {
    if (row_from_input(a)) { const float* p = row < MX ? a.xin_x + (size_t)row * D : a.xin_c + (size_t)(row - MX) * D; return __builtin_nontemporal_load((const f32x4*)(p + off)); }
    const u32x2 w = __builtin_nontemporal_load((const u32x2*)(a.X + (size_t)row * D + off));
    return (f32x4){__uint_as_float(w.x << 16), __uint_as_float(w.x & 0xffff0000u), __uint_as_float(w.y << 16), __uint_as_float(w.y & 0xffff0000u)};
}
#define RCOL(lane, j) (8 * (lane) + 512 * ((j) >> 1) + 4 * ((j) & 1))
__device__ __forceinline__ void row_unpack8(const u32x4 w, f32x4& lo, f32x4& hi) {
    lo = (f32x4){__uint_as_float(w.x << 16), __uint_as_float(w.x & 0xffff0000u), __uint_as_float(w.y << 16), __uint_as_float(w.y & 0xffff0000u)};
    hi = (f32x4){__uint_as_float(w.z << 16), __uint_as_float(w.z & 0xffff0000u), __uint_as_float(w.w << 16), __uint_as_float(w.w & 0xffff0000u)};
}
__device__ __forceinline__ void row_finish(const RowArgs& a, int row, int lane, f32x4 (&x)[8], const f32x4 (&y)[8], const LAS float* VEC) {
    const LAS float* V0 = VEC + (mod_row(row) * 3) * D;
    if (a.mode != 0) {
        float ss = 0.f;
#pragma unroll
        for (int j = 0; j < 8; ++j) ss += (y[j][0] * y[j][0] + y[j][1] * y[j][1]) + (y[j][2] * y[j][2] + y[j][3] * y[j][3]);
        const float rstd = rsqrtf(wave_sum(ss) * (1.f / D) + EPS);
#pragma unroll
        for (int j = 0; j < 8; ++j) { const f32x4 mg = *(const LAS f32x4*)(V0 + RCOL(lane, j)); x[j] = x[j] + mg * (y[j] * rstd); }
        if (a.to_out) { if (row < MX) {
#pragma unroll
            for (int j = 0; j < 8; ++j) __builtin_nontemporal_store(x[j], (f32x4*)(a.out + (size_t)row * D + RCOL(lane, j))); } }
        else {
#pragma unroll
            for (int m = 0; m < 4; ++m) { u32x4 w; w.x = pk2(x[2 * m][0], x[2 * m][1]); w.y = pk2(x[2 * m][2], x[2 * m][3]); w.z = pk2(x[2 * m + 1][0], x[2 * m + 1][1]); w.w = pk2(x[2 * m + 1][2], x[2 * m + 1][3]); __builtin_nontemporal_store(w, (u32x4*)(a.Xw + (size_t)row * D + 8 * lane + 512 * m)); } }
    }
    if (a.write_h) {
        float ss = 0.f;
#pragma unroll
        for (int j = 0; j < 8; ++j) ss += (x[j][0] * x[j][0] + x[j][1] * x[j][1]) + (x[j][2] * x[j][2] + x[j][3] * x[j][3]);
        const float rstd = rsqrtf(wave_sum(ss) * (1.f / D) + EPS);
        bf16* hr = a.H + (size_t)row * D;
#pragma unroll
        for (int m = 0; m < 4; ++m) { f32x4 h[2];
#pragma unroll
            for (int t = 0; t < 2; ++t) { const int j = 2 * m + t; const f32x4 gs = *(const LAS f32x4*)(V0 + D + RCOL(lane, j)), sh = *(const LAS f32x4*)(V0 + 2 * D + RCOL(lane, j)); h[t] = (x[j] * rstd) * gs + sh; }
            u32x4 w; w.x = pk2(h[0][0], h[0][1]); w.y = pk2(h[0][2], h[0][3]); w.z = pk2(h[1][0], h[1][1]); w.w = pk2(h[1][2], h[1][3]); *(u32x4*)(hr + 8 * lane + 512 * m) = w; }
    }
}
__device__ __forceinline__ void row_pass(const RowArgs& a, int row, int lane, const LAS float* VEC) {
    f32x4 x[8], y[8];
#pragma unroll
    for (int j = 0; j < 8; ++j) x[j] = row_load_x(a, row, RCOL(lane, j));
    if (a.mode != 0) {
        if (a.YP != nullptr && row >= MX) {
            const float* yp = a.YP + (size_t)(row - MX) * D;
#pragma unroll
            for (int j = 0; j < 8; ++j) { f32x4 s = *(const f32x4*)(yp + RCOL(lane, j));
#pragma unroll 1
                for (int k = 1; k < 8; ++k) s += *(const f32x4*)(yp + (size_t)k * MC * D + RCOL(lane, j));
                y[j] = s; }
        } else {
            const bf16* yr = a.Y + (size_t)row * D;
#pragma unroll
            for (int m = 0; m < 4; ++m) row_unpack8(*(const u32x4*)(yr + 8 * lane + 512 * m), y[2 * m], y[2 * m + 1]);
        }
    } else {
#pragma unroll
        for (int j = 0; j < 8; ++j) y[j] = (f32x4){0.f, 0.f, 0.f, 0.f};
    }
    row_finish(a, row, lane, x, y, VEC);
}
__device__ __forceinline__ void row_pass2(const RowArgs& a, int r0, int r1, int lane, const LAS float* VEC) {
    f32x4 x0[8], x1[8]; u32x4 w0[4], w1[4];
#pragma unroll
    for (int j = 0; j < 8; ++j) { x0[j] = row_load_x(a, r0, RCOL(lane, j)); x1[j] = row_load_x(a, r1, RCOL(lane, j)); }
    if (a.mode != 0) {
#pragma unroll
        for (int m = 0; m < 4; ++m) { w0[m] = __builtin_nontemporal_load((const u32x4*)(a.Y + (size_t)r0 * D + 8 * lane + 512 * m)); w1[m] = __builtin_nontemporal_load((const u32x4*)(a.Y + (size_t)r1 * D + 8 * lane + 512 * m)); }
    } else {
#pragma unroll
        for (int m = 0; m < 4; ++m) { w0[m] = (u32x4){0u, 0u, 0u, 0u}; w1[m] = (u32x4){0u, 0u, 0u, 0u}; }
    }
    { f32x4 y[8];
#pragma unroll
      for (int m = 0; m < 4; ++m) row_unpack8(w0[m], y[2 * m], y[2 * m + 1]);
      row_finish(a, r0, lane, x0, y, VEC); }
    { f32x4 y[8];
#pragma unroll
      for (int m = 0; m < 4; ++m) row_unpack8(w1[m], y[2 * m], y[2 * m + 1]);
      row_finish(a, r1, lane, x1, y, VEC); }
}
__device__ __forceinline__ void row_phase(const RowArgs& a, int nrows, LAS unsigned char* lds, int tid, int lane, int gw, int ngw) {
    LAS float* VEC = (LAS float*)lds;
    row_vectors(a, VEC, tid);
    __syncthreads();
    for (int r0 = gw; r0 < nrows; r0 += 2 * ngw) { const int r1 = r0 + ngw;
        if (r1 < MX) row_pass2(a, r0, r1, lane, VEC);
        else { row_pass(a, r0, lane, VEC); if (r1 < nrows) row_pass(a, r1, lane, VEC); } }
    __syncthreads();
}

__device__ __forceinline__ void gmlp_unit_simple(const bf16* P, bf16* CAT, const float* ln_g, const float* ln_b, const float* ws, const float* bs, int cid, int h, LAS float* vln, int tid) {
    { const int j = tid >> 2, qd = tid & 3; const bf16* vp = P + (size_t)(cid * CH + j) * NP + C_V + h * 128 + qd * 32;
      float v[32]; float s = 0.f;
#pragma unroll
      for (int i = 0; i < 4; ++i) { const u32x4 w = *(const u32x4*)(vp + 8 * i);
#pragma unroll
          for (int e = 0; e < 4; ++e) { v[8 * i + 2 * e] = __uint_as_float(w[e] << 16); v[8 * i + 2 * e + 1] = __uint_as_float(w[e] & 0xffff0000u); } }
#pragma unroll
      for (int i = 0; i < 32; ++i) s += v[i];
      s += __shfl_xor(s, 1); s += __shfl_xor(s, 2); const float mu = s * (1.f / 128.f); float q = 0.f;
#pragma unroll
      for (int i = 0; i < 32; ++i) { v[i] -= mu; q += v[i] * v[i]; }
      q += __shfl_xor(q, 1); q += __shfl_xor(q, 2); const float rstd = rsqrtf(q * (1.f / 128.f) + EPS);
#pragma unroll
      for (int i = 0; i < 32; ++i) { const int d = qd * 32 + i; vln[j * CH + d] = v[i] * rstd * ln_g[h * 128 + d] + ln_b[h * 128 + d]; } }
    __syncthreads();
    const int d = tid & 127, ig = __builtin_amdgcn_readfirstlane(tid >> 7);
    for (int ii = 0; ii < 32; ++ii) { const int i = ig * 32 + ii; const float* wr = ws + ((size_t)h * CH + i) * CH; float acc = 0.f;
#pragma unroll 16
        for (int j = 0; j < CH; ++j) acc += wr[j] * vln[j * CH + d];
        const size_t row = (size_t)cid * CH + i; const float u = bf2f(P[row * NP + C_U + h * 128 + d]);
        CAT[row * D + h * 128 + d] = (bf16)f2bf(u * (acc + bs[h * CH + i])); }
    __syncthreads();
}


typedef short bf16x8 __attribute__((ext_vector_type(8)));
typedef short s16x4 __attribute__((ext_vector_type(4)));
typedef short v4i16_t __attribute__((ext_vector_type(4)));
constexpr int PQ = 288, PV = 544;
constexpr int L_QT = 0, L_KT = 36864, L_ST = 0, L_V = 73728, L_DF = 143360, L_TOT = 151552;
__device__ __forceinline__ s16x4 tr_read(const LAS unsigned char* p) { return __builtin_bit_cast(s16x4, __builtin_amdgcn_ds_read_tr16_b64_v4i16((LAS v4i16_t*)p)); }
__device__ __forceinline__ bf16x8 cat8(s16x4 lo, s16x4 hi) { return (bf16x8){lo[0], lo[1], lo[2], lo[3], hi[0], hi[1], hi[2], hi[3]}; }
__device__ __forceinline__ float logsig_fast(float z) { return fminf(z, 0.f) - __logf(1.0f + __expf(-fabsf(z))); }
__device__ __forceinline__ f32x4 mfma16(bf16x8 a, bf16x8 b, f32x4 c) { return __builtin_amdgcn_mfma_f32_16x16x32_bf16(a, b, c, 0, 0, 0); }

__device__ __forceinline__ void v_tile_issue(const bf16* P, int cid, int h, u32x4 (&vr)[8], int tid) {
#pragma unroll
    for (int i = 0; i < 8; ++i) { const int idx = tid + 512 * i, row = idx >> 5, ch = idx & 31; vr[i] = *(const u32x4*)(P + (size_t)(cid * CH + row) * NP + C_VV + h * 256 + ch * 8); }
}
__device__ __forceinline__ void v_tile_park(const u32x4 (&vr)[8], LAS unsigned char* V, int tid) {
#pragma unroll
    for (int i = 0; i < 8; ++i) { const int idx = tid + 512 * i, row = idx >> 5, ch = idx & 31; *(LAS u32x4*)(V + row * PV + ch * 16) = vr[i]; }
}
constexpr int PB = 132;
__device__ __forceinline__ float gla_decay_tile(const bf16* P, const float* wd2, const float* bd, int cid, int h, int dir, LAS float* B, int wave, int tid) {
    asm volatile("" : "+v"(tid));
    const int g = (tid >> 4) & 3, li = tid & 15, dcol = h * 128 + 16 * wave + li;
    bf16x8 Bw = {0, 0, 0, 0, 0, 0, 0, 0}, A[8];
    if (g < 2) { u32x4 w; w.x = pk2(wd2[(8 * g + 0) * 512 + dcol], wd2[(8 * g + 1) * 512 + dcol]); w.y = pk2(wd2[(8 * g + 2) * 512 + dcol], wd2[(8 * g + 3) * 512 + dcol]);
        w.z = pk2(wd2[(8 * g + 4) * 512 + dcol], wd2[(8 * g + 5) * 512 + dcol]); w.w = pk2(wd2[(8 * g + 6) * 512 + dcol], wd2[(8 * g + 7) * 512 + dcol]); Bw = __builtin_bit_cast(bf16x8, w); }
    const float bdv = bd[dcol];
    const bf16* dfp = P + (size_t)(cid * CH + li) * NP + (dir ? C_DB : C_DF) + 8 * (g & 1);
#pragma unroll
    for (int s = 0; s < 8; ++s) { const int jt = dir ? 7 - s : s; const bf16x8 v = *(const bf16x8*)(dfp + (size_t)(16 * jt) * NP); A[s] = (g < 2) ? v : (bf16x8){0, 0, 0, 0, 0, 0, 0, 0}; }
    f32x4 bt[8]; float carry = 0.f;
#pragma unroll
    for (int s = 0; s < 8; ++s) {
        const f32x4 z = mfma16(A[s], Bw, (f32x4){0.f, 0.f, 0.f, 0.f});
        const float l0 = logsig_fast(z[0] + bdv) * (1.f / 16.f), l1 = logsig_fast(z[1] + bdv) * (1.f / 16.f), l2 = logsig_fast(z[2] + bdv) * (1.f / 16.f), l3 = logsig_fast(z[3] + bdv) * (1.f / 16.f);
        f32x4 pr; float t;
        if (!dir) { pr[0] = l0; pr[1] = pr[0] + l1; pr[2] = pr[1] + l2; pr[3] = pr[2] + l3; t = pr[3]; }
        else      { pr[3] = l3; pr[2] = pr[3] + l2; pr[1] = pr[2] + l1; pr[0] = pr[1] + l0; t = pr[0]; }
        float t2;
        if (!dir) { const float u1 = __shfl_up(t, 16); const float t1 = t + (g >= 1 ? u1 : 0.f); const float u2 = __shfl_up(t1, 32); t2 = t1 + (g >= 2 ? u2 : 0.f); }
        else      { const float u1 = __shfl_down(t, 16); const float t1 = t + (g <= 2 ? u1 : 0.f); const float u2 = __shfl_down(t1, 32); t2 = t1 + (g <= 1 ? u2 : 0.f); }
        const float base = carry + (t2 - t);
        bt[s] = pr + base;
        carry += __shfl(t2, dir ? li : li + 48); }
#pragma unroll
    for (int s = 0; s < 8; ++s) { const int jt = dir ? 7 - s : s;
#pragma unroll
        for (int r = 0; r < 4; ++r) B[(16 * jt + 4 * g + r) * PB + 16 * wave + li] = bt[s][r]; }
    return carry;
}
__device__ __forceinline__ void gla_g1_unit(const bf16* P, const float* wd2, const float* bd, bf16* DS, float* DEC, int cid, int h, int dir, LAS unsigned char* lds, int tid, int lane, int wave) {
    const int unit = (cid * 4 + h) * 2 + dir;
    asm volatile("" : "+v"(tid)); (void)lane;
    u32x4 vr[8], rk[4]; v_tile_issue(P, cid, h, vr, tid);
#pragma unroll
    for (int i = 0; i < 4; ++i) { const int idx = tid + 512 * i, row = idx >> 4, ch = idx & 15; rk[i] = *(const u32x4*)(P + (size_t)(cid * CH + row) * NP + C_K + h * 128 + ch * 8); }
    LAS float* B = (LAS float*)(lds + L_V); LAS float* DECL = (LAS float*)(lds + L_DF);
    { const float tot = gla_decay_tile(P, wd2, bd, cid, h, dir, B, wave, tid);
      if (((tid >> 4) & 3) == 0) { const float dc = __expf(tot); DEC[(size_t)unit * 128 + 16 * wave + (tid & 15)] = dc; DECL[16 * wave + (tid & 15)] = dc; } }
    __syncthreads();
    { int t2 = tid; asm volatile("" : "+v"(t2));
#pragma unroll
      for (int i = 0; i < 4; ++i) { const int idx = t2 + 512 * i, j = idx >> 4, c = idx & 15;
          const f32x4 b0 = *(const LAS f32x4*)(B + j * PB + 8 * c), b1 = *(const LAS f32x4*)(B + j * PB + 8 * c + 4);
          f32x4 k0, k1; row_unpack8(rk[i], k0, k1);
#pragma unroll
          for (int t = 0; t < 4; ++t) { k0[t] = k0[t] * __expf(-b0[t]); k1[t] = k1[t] * __expf(-b1[t]); }
          u32x4 kw; kw.x = pg8::cvt_pk_bf16(k0[0], k0[1]); kw.y = pg8::cvt_pk_bf16(k0[2], k0[3]); kw.z = pg8::cvt_pk_bf16(k1[0], k1[1]); kw.w = pg8::cvt_pk_bf16(k1[2], k1[3]);
          *(LAS u32x4*)(lds + L_KT + j * PQ + c * 16) = kw; } }
    __syncthreads();
    v_tile_park(vr, lds + L_V, tid);
    __syncthreads();
    int t2 = tid; asm volatile("" : "+v"(t2));
    const int wdb = wave >> 1, we = wave & 1, g = (t2 >> 4) & 3, li = t2 & 15, q = li >> 2, p = li & 3;
    const LAS unsigned char* KT = lds + L_KT; const LAS unsigned char* V = lds + L_V;
    f32x4 acc[2][8];
#pragma unroll
    for (int dt = 0; dt < 2; ++dt)
#pragma unroll
        for (int et = 0; et < 8; ++et) acc[dt][et] = (f32x4){0.f, 0.f, 0.f, 0.f};
#pragma unroll
    for (int ks = 0; ks < 4; ++ks) { const int row = 32 * ks + 8 * g + q;
        bf16x8 X[2], Y[8];
#pragma unroll
        for (int dt = 0; dt < 2; ++dt) X[dt] = cat8(tr_read(KT + row * PQ + (32 * wdb + 16 * dt + 4 * p) * 2), tr_read(KT + (row + 4) * PQ + (32 * wdb + 16 * dt + 4 * p) * 2));
#pragma unroll
        for (int et = 0; et < 8; ++et) Y[et] = cat8(tr_read(V + row * PV + (128 * we + 16 * et + 4 * p) * 2), tr_read(V + (row + 4) * PV + (128 * we + 16 * et + 4 * p) * 2));
#pragma unroll
        for (int et = 0; et < 8; ++et) { acc[0][et] = mfma16(X[0], Y[et], acc[0][et]); acc[1][et] = mfma16(X[1], Y[et], acc[1][et]); } }
#pragma unroll
    for (int dt = 0; dt < 2; ++dt) { const int d0 = 32 * wdb + 16 * dt + 4 * g; const f32x4 dc = *(const LAS f32x4*)(DECL + d0);
#pragma unroll
        for (int et = 0; et < 8; ++et) { const int e = 128 * we + 16 * et + li; const f32x4 v = acc[dt][et] * dc; u32x2 w; w.x = pg8::cvt_pk_bf16(v[0], v[1]); w.y = pg8::cvt_pk_bf16(v[2], v[3]); *(u32x2*)(DS + ((size_t)unit * 256 + e) * 128 + d0) = w; } }
    __syncthreads();
}
__device__ __forceinline__ int gla_chain_cid(int s, int b, int dir) { return dir ? (s < 2 ? 128 + 2 * b + (1 - s) : 32 * b + 31 - (s - 2)) : (s < 2 ? 128 + 2 * b + s : 32 * b + (s - 2)); }
__device__ __forceinline__ void gla_g2_item(const bf16* DS, const float* DEC, bf16* SP, int item) {
    const int chain = item >> 13, ed = item & 8191, b = chain >> 3, h = (chain >> 1) & 3, dir = chain & 1, e = ed >> 5, d0 = (ed & 31) * 4;
    f32x4 S = {0.f, 0.f, 0.f, 0.f};
#pragma unroll 2
    for (int s = 0; s < 34; ++s) { const int cid = gla_chain_cid(s, b, dir), unit = (cid * 4 + h) * 2 + dir; const size_t off = ((size_t)unit * 256 + e) * 128 + d0;
        const f32x4 dec = *(const f32x4*)(DEC + (size_t)unit * 128 + d0); const u32x2 dw = *(const u32x2*)(DS + off);
        const f32x4 ds = {__uint_as_float(dw.x << 16), __uint_as_float(dw.x & 0xffff0000u), __uint_as_float(dw.y << 16), __uint_as_float(dw.y & 0xffff0000u)};
        u32x2 w; w.x = pk2(S[0], S[1]); w.y = pk2(S[2], S[3]); *(u32x2*)(SP + off) = w;
        S = dec * S + ds; }
}
__device__ __forceinline__ void gla_g3_unit(const bf16* P, const float* wd2f, const float* bdf, const float* wd2b, const float* bdb, const bf16* SP, const float* out_g, bf16* CAT, int cid, int h, LAS unsigned char* lds, int tid, int lane, int wave) {
    asm volatile("" : "+v"(tid));
    const int w = wave; (void)lane;
    const LAS unsigned char* QT = lds + L_QT; const LAS unsigned char* KT = lds + L_KT; LAS unsigned char* ST = lds + L_ST; const LAS unsigned char* V = lds + L_V;
    static_assert(L_KT == L_QT + 128 * PQ && 128 * PB * 4 <= 2 * 128 * PQ, "q~ and k~ tiles are adjacent and hold the b tile");
    f32x4 o[2][8];
#pragma unroll
    for (int et = 0; et < 2; ++et)
#pragma unroll
        for (int it = 0; it < 8; ++it) o[et][it] = (f32x4){0.f, 0.f, 0.f, 0.f};
#pragma unroll
    for (int dir = 0; dir < 2; ++dir) {
        const int unit = (cid * 4 + h) * 2 + dir;
        { u32x4 rk[4], rq[4];
#pragma unroll
          for (int i = 0; i < 4; ++i) { const int idx = tid + 512 * i, row = idx >> 4, ch = idx & 15; const bf16* pr = P + (size_t)(cid * CH + row) * NP + h * 128 + ch * 8; rk[i] = *(const u32x4*)(pr + C_K); rq[i] = *(const u32x4*)(pr + C_Q); }
          LAS float* B = (LAS float*)(lds + L_QT);
          (void)gla_decay_tile(P, dir ? wd2b : wd2f, dir ? bdb : bdf, cid, h, dir, B, wave, tid);
          u32x4 vr[8]; if (dir == 0) v_tile_issue(P, cid, h, vr, tid);
          __syncthreads();
          u32x4 qw[4], kw[4];
#pragma unroll
          for (int i = 0; i < 4; ++i) { const int idx = tid + 512 * i, j = idx >> 4, c = idx & 15;
              const f32x4 b0 = *(const LAS f32x4*)(B + j * PB + 8 * c), b1 = *(const LAS f32x4*)(B + j * PB + 8 * c + 4);
              f32x4 q0, q1, k0, k1; row_unpack8(rq[i], q0, q1); row_unpack8(rk[i], k0, k1);
              f32x4 e0, e1;
#pragma unroll
              for (int t = 0; t < 4; ++t) { e0[t] = __expf(b0[t]); e1[t] = __expf(b1[t]); }
              q0 = q0 * e0 * 0.08838834764831845f; q1 = q1 * e1 * 0.08838834764831845f;
#pragma unroll
              for (int t = 0; t < 4; ++t) { k0[t] = k0[t] * __builtin_amdgcn_rcpf(e0[t]); k1[t] = k1[t] * __builtin_amdgcn_rcpf(e1[t]); }
              qw[i].x = pg8::cvt_pk_bf16(q0[0], q0[1]); qw[i].y = pg8::cvt_pk_bf16(q0[2], q0[3]); qw[i].z = pg8::cvt_pk_bf16(q1[0], q1[1]); qw[i].w = pg8::cvt_pk_bf16(q1[2], q1[3]);
              kw[i].x = pg8::cvt_pk_bf16(k0[0], k0[1]); kw[i].y = pg8::cvt_pk_bf16(k0[2], k0[3]); kw[i].z = pg8::cvt_pk_bf16(k1[0], k1[1]); kw[i].w = pg8::cvt_pk_bf16(k1[2], k1[3]); }
          if (dir == 0) v_tile_park(vr, lds + L_V, tid);
          __syncthreads();
#pragma unroll
          for (int i = 0; i < 4; ++i) { const int idx = tid + 512 * i, j = idx >> 4, c = idx & 15; *(LAS u32x4*)(lds + L_QT + j * PQ + c * 16) = qw[i]; *(LAS u32x4*)(lds + L_KT + j * PQ + c * 16) = kw[i]; }
          __syncthreads(); }
        int t2 = tid; asm volatile("" : "+v"(t2));
        const int g = (t2 >> 4) & 3, li = t2 & 15, q = li >> 2, p = li & 3;
        bf16x8 XS[2][4];
#pragma unroll
        for (int et = 0; et < 2; ++et)
#pragma unroll
            for (int ks = 0; ks < 4; ++ks) XS[et][ks] = *(const bf16x8*)(SP + (size_t)unit * 32768 + (size_t)(32 * w + 16 * et + li) * 128 + 32 * ks + 8 * g);
        u32x2 pw[8];
        { bf16x8 Yq[4];
#pragma unroll
          for (int ks = 0; ks < 4; ++ks) Yq[ks] = *(const LAS bf16x8*)(QT + (16 * w + li) * PQ + (32 * ks + 8 * g) * 2);
#pragma unroll
          for (int kp = 0; kp < 4; ++kp) {
            f32x4 s0 = {0.f, 0.f, 0.f, 0.f}, s1 = {0.f, 0.f, 0.f, 0.f};
            const int t0 = 2 * kp, t1 = 2 * kp + 1;
            const bool a0 = dir ? (t0 >= w) : (t0 <= w), a1 = dir ? (t1 >= w) : (t1 <= w);
            if (a0 && a1) {
                bf16x8 K0[4], K1[4];
#pragma unroll
                for (int ks = 0; ks < 4; ++ks) { K0[ks] = *(const LAS bf16x8*)(KT + (16 * t0 + li) * PQ + (32 * ks + 8 * g) * 2); K1[ks] = *(const LAS bf16x8*)(KT + (16 * t1 + li) * PQ + (32 * ks + 8 * g) * 2); }
#pragma unroll
                for (int ks = 0; ks < 4; ++ks) { s0 = mfma16(K0[ks], Yq[ks], s0); s1 = mfma16(K1[ks], Yq[ks], s1); }
            } else if (a0) {
                bf16x8 K0[4];
#pragma unroll
                for (int ks = 0; ks < 4; ++ks) K0[ks] = *(const LAS bf16x8*)(KT + (16 * t0 + li) * PQ + (32 * ks + 8 * g) * 2);
#pragma unroll
                for (int ks = 0; ks < 4; ++ks) s0 = mfma16(K0[ks], Yq[ks], s0);
            } else if (a1) {
                bf16x8 K1[4];
#pragma unroll
                for (int ks = 0; ks < 4; ++ks) K1[ks] = *(const LAS bf16x8*)(KT + (16 * t1 + li) * PQ + (32 * ks + 8 * g) * 2);
#pragma unroll
                for (int ks = 0; ks < 4; ++ks) s1 = mfma16(K1[ks], Yq[ks], s1);
            }
            if (t0 == w) {
#pragma unroll
                for (int r = 0; r < 4; ++r) { const bool keep = dir ? (4 * g + r >= li) : (4 * g + r <= li); s0[r] = keep ? s0[r] : 0.f; } }
            if (t1 == w) {
#pragma unroll
                for (int r = 0; r < 4; ++r) { const bool keep = dir ? (4 * g + r >= li) : (4 * g + r <= li); s1[r] = keep ? s1[r] : 0.f; } }
            pw[t0].x = pg8::cvt_pk_bf16(s0[0], s0[1]); pw[t0].y = pg8::cvt_pk_bf16(s0[2], s0[3]); pw[t1].x = pg8::cvt_pk_bf16(s1[0], s1[1]); pw[t1].y = pg8::cvt_pk_bf16(s1[2], s1[3]);
          } }
        __syncthreads();
        LAS unsigned char* PT = lds + L_KT;
#pragma unroll
        for (int jt = 0; jt < 8; ++jt) *(LAS u32x2*)(PT + (16 * w + li) * PQ + (16 * jt + 4 * g) * 2) = pw[jt];
        bf16x8 Xv[2][4];
#pragma unroll
        for (int et = 0; et < 2; ++et)
#pragma unroll
            for (int kp = 0; kp < 4; ++kp) Xv[et][kp] = cat8(tr_read(V + (32 * kp + 8 * g + q) * PV + (32 * w + 16 * et + 4 * p) * 2), tr_read(V + (32 * kp + 8 * g + q + 4) * PV + (32 * w + 16 * et + 4 * p) * 2));
        __syncthreads();
#pragma unroll
        for (int it = 0; it < 8; ++it) {
            bf16x8 Yi[4];
#pragma unroll
            for (int ks = 0; ks < 4; ++ks) Yi[ks] = *(const LAS bf16x8*)(QT + (16 * it + li) * PQ + (32 * ks + 8 * g) * 2);
            bf16x8 Pf[4];
#pragma unroll
            for (int kp = 0; kp < 4; ++kp) { const bool act = dir ? (kp >= (it >> 1)) : (kp <= (it >> 1)); if (act) Pf[kp] = *(const LAS bf16x8*)(PT + (16 * it + li) * PQ + (32 * kp + 8 * g) * 2); }
#pragma unroll
            for (int ks = 0; ks < 4; ++ks) { o[0][it] = mfma16(XS[0][ks], Yi[ks], o[0][it]); o[1][it] = mfma16(XS[1][ks], Yi[ks], o[1][it]); }
#pragma unroll
            for (int kp = 0; kp < 4; ++kp) { const bool act = dir ? (kp >= (it >> 1)) : (kp <= (it >> 1));
                if (act) { o[0][it] = mfma16(Xv[0][kp], Pf[kp], o[0][it]); o[1][it] = mfma16(Xv[1][kp], Pf[kp], o[1][it]); } }
        }
        __syncthreads();
    }
    int t3 = tid; asm volatile("" : "+v"(t3));
    const int g = (t3 >> 4) & 3, li = t3 & 15;
    u32x2 gwv[2][8];
#pragma unroll
    for (int et = 0; et < 2; ++et)
#pragma unroll
        for (int it = 0; it < 8; ++it) gwv[et][it] = *(const u32x2*)(P + ((size_t)cid * CH + 16 * it + li) * NP + C_G + h * 256 + 32 * w + 16 * et + 4 * g);
    LAS float* RED = (LAS float*)(lds + L_DF);
#pragma unroll
    for (int it = 0; it < 8; ++it) { float s = 0.f;
#pragma unroll
        for (int et = 0; et < 2; ++et) s += (o[et][it][0] * o[et][it][0] + o[et][it][1] * o[et][it][1]) + (o[et][it][2] * o[et][it][2] + o[et][it][3] * o[et][it][3]);
        s += __shfl_xor(s, 16); s += __shfl_xor(s, 32);
        if (g == 0) RED[w * 128 + 16 * it + li] = s; }
    __syncthreads();
    f32x4 gg[2];
#pragma unroll
    for (int et = 0; et < 2; ++et) gg[et] = *(const f32x4*)(out_g + h * 256 + 32 * w + 16 * et + 4 * g);
#pragma unroll
    for (int it = 0; it < 8; ++it) { float tot = 0.f;
#pragma unroll
        for (int ww = 0; ww < 8; ++ww) tot += RED[ww * 128 + 16 * it + li];
        const float rstd = rsqrtf(tot * (1.f / 256.f) + EPS); const size_t row = (size_t)cid * CH + 16 * it + li;
#pragma unroll
        for (int et = 0; et < 2; ++et) { const u32x2 gw = gwv[et][it];
            const float g0 = __uint_as_float(gw.x << 16), g1 = __uint_as_float(gw.x & 0xffff0000u), g2 = __uint_as_float(gw.y << 16), g3 = __uint_as_float(gw.y & 0xffff0000u);
            u32x2 ow; ow.x = pk2(o[et][it][0] * rstd * gg[et][0] * silu_acc(g0), o[et][it][1] * rstd * gg[et][1] * silu_acc(g1)); ow.y = pk2(o[et][it][2] * rstd * gg[et][2] * silu_acc(g2), o[et][it][3] * rstd * gg[et][3] * silu_acc(g3));
            *(u32x2*)(CAT + row * D + 1024 + h * 256 + 32 * w + 16 * et + 4 * g) = ow; } }
}

__device__ __forceinline__ void gmlp_unit_fast(const bf16* P, bf16* CAT, const float* ln_g, const float* ln_b, const bf16* WSB, const float* bs, int cid, int h, LAS unsigned char* lds, int tid, int wave) {
    asm volatile("" : "+v"(tid));
    LAS unsigned char* VL = lds;
    const int g = (tid >> 4) & 3, li = tid & 15, q = li >> 2, p = li & 3, w = wave;
    const size_t row = (size_t)cid * CH + 16 * w + li;
    bf16x8 Yw[4]; u32x2 uw[8];
#pragma unroll
    for (int ks = 0; ks < 4; ++ks) Yw[ks] = *(const bf16x8*)(WSB + ((size_t)(h * CH + 16 * w + li)) * CH + 32 * ks + 8 * g);
#pragma unroll
    for (int dt = 0; dt < 8; ++dt) uw[dt] = *(const u32x2*)(P + row * NP + C_U + h * 128 + 16 * dt + 4 * g);
    const float bsv = bs[h * CH + 16 * w + li];
    { const int j = tid >> 2, qd = tid & 3; const bf16* vp = P + (size_t)(cid * CH + j) * NP + C_V + h * 128 + qd * 32;
      float v[32]; float s = 0.f;
#pragma unroll
      for (int i = 0; i < 4; ++i) { const u32x4 w = *(const u32x4*)(vp + 8 * i);
#pragma unroll
          for (int e = 0; e < 4; ++e) { v[8 * i + 2 * e] = __uint_as_float(w[e] << 16); v[8 * i + 2 * e + 1] = __uint_as_float(w[e] & 0xffff0000u); } }
#pragma unroll
      for (int i = 0; i < 32; ++i) s += v[i];
      s += __shfl_xor(s, 1); s += __shfl_xor(s, 2); const float mu = s * (1.f / 128.f); float q = 0.f;
#pragma unroll
      for (int i = 0; i < 32; ++i) { v[i] -= mu; q += v[i] * v[i]; }
      q += __shfl_xor(q, 1); q += __shfl_xor(q, 2); const float rstd = rsqrtf(q * (1.f / 128.f) + EPS);
      const float* gp = ln_g + h * 128 + qd * 32; const float* bp = ln_b + h * 128 + qd * 32;
#pragma unroll
      for (int i = 0; i < 4; ++i) { const f32x4 g0 = *(const f32x4*)(gp + 8 * i), g1 = *(const f32x4*)(gp + 8 * i + 4), b0 = *(const f32x4*)(bp + 8 * i), b1 = *(const f32x4*)(bp + 8 * i + 4);
          u32x4 o; o.x = pk2(v[8 * i + 0] * rstd * g0[0] + b0[0], v[8 * i + 1] * rstd * g0[1] + b0[1]); o.y = pk2(v[8 * i + 2] * rstd * g0[2] + b0[2], v[8 * i + 3] * rstd * g0[3] + b0[3]);
          o.z = pk2(v[8 * i + 4] * rstd * g1[0] + b1[0], v[8 * i + 5] * rstd * g1[1] + b1[1]); o.w = pk2(v[8 * i + 6] * rstd * g1[2] + b1[2], v[8 * i + 7] * rstd * g1[3] + b1[3]);
          *(LAS u32x4*)(VL + j * PQ + (qd * 32 + 8 * i) * 2) = o; } }
    __syncthreads();
    f32x4 acc[8];
#pragma unroll
    for (int dt = 0; dt < 8; ++dt) acc[dt] = (f32x4){0.f, 0.f, 0.f, 0.f};
#pragma unroll
    for (int ks = 0; ks < 4; ++ks) {
        bf16x8 X[8];
#pragma unroll
        for (int dt = 0; dt < 8; ++dt) X[dt] = cat8(tr_read(VL + (32 * ks + 8 * g + q) * PQ + (16 * dt + 4 * p) * 2), tr_read(VL + (32 * ks + 8 * g + q + 4) * PQ + (16 * dt + 4 * p) * 2));
#pragma unroll
        for (int dt = 0; dt < 8; ++dt) acc[dt] = mfma16(X[dt], Yw[ks], acc[dt]);
    }
#pragma unroll
    for (int dt = 0; dt < 8; ++dt) { const int c0 = h * 128 + 16 * dt + 4 * g;
        const float u0 = __uint_as_float(uw[dt].x << 16), u1 = __uint_as_float(uw[dt].x & 0xffff0000u), u2 = __uint_as_float(uw[dt].y << 16), u3 = __uint_as_float(uw[dt].y & 0xffff0000u);
        u32x2 ow; ow.x = pk2(u0 * (acc[dt][0] + bsv), u1 * (acc[dt][1] + bsv)); ow.y = pk2(u2 * (acc[dt][2] + bsv), u3 * (acc[dt][3] + bsv));
        *(u32x2*)(CAT + row * D + c0) = ow; }
    __syncthreads();
}

constexpr int NPH = 2 + 9 * NL;
struct Args { const float* in[23]; float* out; unsigned char* ws; int ph_lo, ph_hi, li, pad; };

#ifndef DUP_MASK
#define DUP_MASK 0
#endif
#define REP(bit) for (int rep_ = 0; rep_ < (((DUP_MASK) >> (bit)) & 1) + 1; ++rep_)
#define IN(k) (lo <= (k) && (k) < hi)
#define PHASE_IDS() int tid = tid0; asm volatile("" : "+v"(tid)); const int lane = tid & 63, wave = __builtin_amdgcn_readfirstlane(tid >> 6), gw = bid * 8 + wave, ngw = G * 8; (void)lane; (void)gw; (void)ngw
#define SEAM(k) do { if (IN(k) && IN((k) + 1)) xcd_barrier(bar); } while (0)
template <int l> __device__ __forceinline__ void run_layer(const Args& a, LAS unsigned char* lds, const XcdBarrier& bar, int tid0, int G, int bid, int lo, int hi) {
    unsigned char* ws = a.ws;
    const float* x = a.in[0]; const float* ctx = a.in[2];
    const float* g_pre_mix = a.in[6]; const float* g_post_mix = a.in[7]; const float* g_pre_ffn = a.in[8]; const float* g_post_ffn = a.in[9];
    const float* ln_g = a.in[11]; const float* ln_b = a.in[12]; const float* gws = a.in[13]; const float* gbs = a.in[14];
    const float* wd2f = a.in[15]; const float* bdf = a.in[16]; const float* wd2b = a.in[17]; const float* bdb = a.in[18];
    const float* out_g = a.in[19];
    float* MOD = (float*)(ws + WS_MOD); bf16* WIN = (bf16*)(ws + WS_WIN); bf16* WOUT = (bf16*)(ws + WS_WOUT); bf16* WFI = (bf16*)(ws + WS_WFI); bf16* WFO = (bf16*)(ws + WS_WFO);
    bf16* X = (bf16*)(ws + WS_X); bf16* H = (bf16*)(ws + WS_H); bf16* P = (bf16*)(ws + WS_P); bf16* CAT = (bf16*)(ws + WS_CAT); bf16* Y = (bf16*)(ws + WS_Y); bf16* HID = (bf16*)(ws + WS_HID);
    bf16* DS = (bf16*)(ws + WS_DS); bf16* SP = (bf16*)(ws + WS_SP); float* DEC = (float*)(ws + WS_DEC); bf16* WSB = (bf16*)(ws + WS_WSB); bf16* QKG = (bf16*)(ws + WS_QK); float* YP = (float*)(ws + WS_YP);
        const int pb = 2 + 9 * l;
        constexpr bool LAST = (l == NL - 1);
        constexpr int NCH_OUT = LAST ? MX / CH : NCHUNK, MROWS = LAST ? MX : M;
        const float* modl = MOD + (size_t)l * 5 * NMOD;
        if (IN(pb + 0)) REP(1) { pg8::Gemm g{H, WIN + (size_t)l * NP * D, M, NP, D, D}; pg8::StaticOrder S; S.init(M, NP, G, bid); pg8::EpiProj E{P, NP, 8};
            pg8::gemm_phase<pg8::EpiProj, pg8::StaticOrder, true, true>(lds, g, S, E); }
        SEAM(pb + 0);
        constexpr int NGM = NCH_OUT * 8, NGM1 = 384;
        if (IN(pb + 1)) REP(2) { PHASE_IDS();
            for (int u = bid; u < NCHUNK * 8; u += G) { const int dir = u & 1, h = (u >> 1) & 3, cid = u >> 3;
                gla_g1_unit(P, (dir ? wd2b : wd2f) + l * 16 * 512, (dir ? bdb : bdf) + l * 512, DS, DEC, cid, h, dir, lds, tid, lane, wave); }
            if (G == 256) { if (bid >= 64) for (int u = bid - 64; u < NGM1; u += 192)
                gmlp_unit_fast(P, CAT, ln_g + l * 1024, ln_b + l * 1024, WSB + (size_t)l * 8 * CH * CH, gbs + l * 8 * CH, u >> 3, u & 7, lds, tid, wave); }
            else for (int u = bid; u < NGM1; u += G)
                gmlp_unit_fast(P, CAT, ln_g + l * 1024, ln_b + l * 1024, WSB + (size_t)l * 8 * CH * CH, gbs + l * 8 * CH, u >> 3, u & 7, lds, tid, wave);
        }
        SEAM(pb + 1);
        if (IN(pb + 2)) REP(3) { PHASE_IDS();
            for (int it = bid * 512 + tid; it < 32 * 8192; it += G * 512) gla_g2_item(DS, DEC, SP, it);
        }
        SEAM(pb + 2);
        if (IN(pb + 3)) REP(4) { PHASE_IDS();
            for (int u = bid; u < NCH_OUT * 4; u += G)
                gla_g3_unit(P, wd2f + l * 16 * 512, bdf + l * 512, wd2b + l * 16 * 512, bdb + l * 512, SP, out_g + l * 1024, CAT, u >> 2, u & 3, lds, tid, lane, wave);
            if (G == 256 && !LAST) { if (bid >= 32) for (int u = NGM1 + bid - 32; u < NGM; u += 224)
                gmlp_unit_fast(P, CAT, ln_g + l * 1024, ln_b + l * 1024, WSB + (size_t)l * 8 * CH * CH, gbs + l * 8 * CH, u >> 3, u & 7, lds, tid, wave); }
            else for (int u = NGM1 + bid; u < NGM; u += G)
                gmlp_unit_fast(P, CAT, ln_g + l * 1024, ln_b + l * 1024, WSB + (size_t)l * 8 * CH * CH, gbs + l * 8 * CH, u >> 3, u & 7, lds, tid, wave);
        }
        SEAM(pb + 3);
        if (IN(pb + 4)) REP(5) { { pg8::Gemm g{CAT, WOUT + (size_t)l * D * D, MX, D, D, D}; pg8::StaticOrder S; S.init(MX, D, G, bid); pg8::EpiProj E{Y, D, 0};
              pg8::gemm_phase<pg8::EpiProj, pg8::StaticOrder, true, true>(lds, g, S, E); }
            if (!LAST) { pg8::Gemm g{CAT + (size_t)MX * D, WOUT + (size_t)l * D * D, MC, D, D, D}; pg8::SplitOrder S; S.init(MC / 256, D / 256, D / 64, bid); pg8::EpiPartF32 E{YP, D, 0, (size_t)MC * D};
              pg8::gemm_phase<pg8::EpiPartF32, pg8::SplitOrder, false, true>(lds, g, S, E); } }
        SEAM(pb + 4);
        if (IN(pb + 5)) { PHASE_IDS();
            RowArgs r{}; r.xin_x = l == 0 ? x : nullptr; r.xin_c = l == 0 ? ctx : nullptr; r.Y = Y; r.YP = LAST ? nullptr : YP; r.X = X; r.Xw = X; r.H = H; r.modA = modl; r.gA = g_post_mix + l * D; r.gB = g_pre_ffn + l * D; r.mode = 1; r.write_h = 1;
            if ((DUP_MASK >> 8) & 1) { RowArgs d = r; d.Xw = (bf16*)HID; d.H = (bf16*)(ws + WS_QK); d.out = (float*)HID; row_phase(d, MROWS, lds, tid, lane, gw, ngw); }
            row_phase(r, MROWS, lds, tid, lane, gw, ngw);
        }
        SEAM(pb + 5);
        if (IN(pb + 6)) REP(6) { pg8::Gemm g{H, WFI + (size_t)l * 2 * FF * D, MROWS, 2 * FF, D, D}; pg8::StaticOrder S; S.init(MROWS, 2 * FF, G, bid); pg8::EpiSwiglu E{HID, FF};
            pg8::gemm_phase<pg8::EpiSwiglu, pg8::StaticOrder, true, true>(lds, g, S, E); }
        SEAM(pb + 6);
        if (IN(pb + 7)) REP(7) { { pg8::Gemm g{HID, WFO + (size_t)l * D * FF, MX, D, FF, FF}; pg8::StaticOrder S; S.init(MX, D, G, bid); pg8::EpiProj E{Y, D, 0};
              pg8::gemm_phase<pg8::EpiProj, pg8::StaticOrder, true, true>(lds, g, S, E); }
            if (!LAST) { pg8::Gemm g{HID + (size_t)MX * FF, WFO + (size_t)l * D * FF, MC, D, FF, FF}; pg8::SplitOrder S; S.init(MC / 256, D / 256, FF / 64, bid); pg8::EpiPartF32 E{YP, D, 0, (size_t)MC * D};
              pg8::gemm_phase<pg8::EpiPartF32, pg8::SplitOrder, false, true>(lds, g, S, E); } }
        SEAM(pb + 7);
        if (IN(pb + 8)) { PHASE_IDS();
            RowArgs r{}; r.Y = Y; r.YP = LAST ? nullptr : YP; r.X = X; r.Xw = X; r.out = a.out; r.H = H; r.modA = modl; r.modB = modl + 5 * NMOD; r.gA = g_post_ffn + l * D; r.gB = g_pre_mix + (l + 1 < NL ? l + 1 : l) * D; r.mode = 2; r.write_h = (l + 1 < NL); r.to_out = (l + 1 == NL);
            if ((DUP_MASK >> 8) & 1) { RowArgs d = r; d.Xw = (bf16*)HID; d.H = (bf16*)(ws + WS_QK); d.out = (float*)HID; row_phase(d, MROWS, lds, tid, lane, gw, ngw); }
            row_phase(r, MROWS, lds, tid, lane, gw, ngw);
        }
        SEAM(pb + 8);
}
__global__ void __launch_bounds__(512, 2) mega(Args a) {
    extern __shared__ __attribute__((aligned(16))) unsigned char lds_raw[];
    LAS unsigned char* lds = (LAS unsigned char*)lds_raw;
    const int tid0 = threadIdx.x;
    const int G = gridDim.x, bid = blockIdx.x;
    volatile LAS unsigned* MISC = (volatile LAS unsigned*)(lds + MISC_OFF);
    if (tid0 < 32) MISC[tid0] = 0u;
    __syncthreads();
    unsigned char* ws = a.ws;
    const int lo = a.ph_lo, hi = a.ph_hi;
    XcdBarrier bar; bar.bar = (unsigned*)(ws + WS_CTL) + CW_BAR + a.li * XCD_BAR_WORDS; bar.x = 0; bar.st = nullptr;
    if (hi - lo > 1) bar = xcd_barrier_post((unsigned*)(ws + WS_CTL) + CW_BAR + a.li * XCD_BAR_WORDS, MISC + 8);
    const float* x = a.in[0]; const float* c = a.in[1]; const float* ctx = a.in[2]; const float* cctx = a.in[3];
    const float* w_mod = a.in[4]; const float* b_mod = a.in[5];
    const float* g_pre_mix = a.in[6]; const float* g_post_mix = a.in[7]; const float* g_pre_ffn = a.in[8]; const float* g_post_ffn = a.in[9];
    const float* w_in = a.in[10]; const float* ln_g = a.in[11]; const float* ln_b = a.in[12]; const float* gws = a.in[13]; const float* gbs = a.in[14];
    const float* wd2f = a.in[15]; const float* bdf = a.in[16]; const float* wd2b = a.in[17]; const float* bdb = a.in[18];
    const float* out_g = a.in[19]; const float* w_out = a.in[20]; const float* w_fi = a.in[21]; const float* w_fo = a.in[22];
    float* MOD = (float*)(ws + WS_MOD); bf16* WIN = (bf16*)(ws + WS_WIN); bf16* WOUT = (bf16*)(ws + WS_WOUT); bf16* WFI = (bf16*)(ws + WS_WFI); bf16* WFO = (bf16*)(ws + WS_WFO);
    bf16* X = (bf16*)(ws + WS_X); bf16* H = (bf16*)(ws + WS_H); bf16* P = (bf16*)(ws + WS_P); bf16* CAT = (bf16*)(ws + WS_CAT); bf16* Y = (bf16*)(ws + WS_Y); bf16* HID = (bf16*)(ws + WS_HID);
    bf16* DS = (bf16*)(ws + WS_DS); bf16* SP = (bf16*)(ws + WS_SP); float* DEC = (float*)(ws + WS_DEC); bf16* WSB = (bf16*)(ws + WS_WSB); bf16* QKG = (bf16*)(ws + WS_QK); float* YP = (float*)(ws + WS_YP);

    if (IN(0)) REP(0) { PHASE_IDS();
        LAS float* act = (LAS float*)(lds + 8 * 8448);
        for (int i = tid; i < 5 * D; i += 512) { const int r = i / D, k = i % D; const float v = r < NB ? c[r * D + k] : cctx[k]; act[i] = silu_acc(v); }
        __syncthreads();
        for (int item = wave * G + bid; item < NL * (NMOD / 32); item += ngw) {
            const int cg = item % (NMOD / 32), l = item / (NMOD / 32), kq = lane >> 3;
            const int j = cg * 32 + 4 * (lane & 7);
            const float* w = w_mod + ((size_t)l * D + kq) * NMOD + j;
            f32x4 a0 = {0.f, 0.f, 0.f, 0.f}, a1 = a0, a2 = a0, a3 = a0, a4 = a0;
#pragma unroll 8
            for (int i = 0; i < D / 8; ++i) { const f32x4 xv = __builtin_nontemporal_load((const f32x4*)(w + (size_t)(8 * i) * NMOD)); const int k = 8 * i + kq;
                a0 += xv * act[0 * D + k]; a1 += xv * act[1 * D + k]; a2 += xv * act[2 * D + k]; a3 += xv * act[3 * D + k]; a4 += xv * act[4 * D + k]; }
#pragma unroll
            for (int t = 0; t < 4; ++t) {
#pragma unroll
                for (int o = 8; o < 64; o <<= 1) { a0[t] += __shfl_xor(a0[t], o); a1[t] += __shfl_xor(a1[t], o); a2[t] += __shfl_xor(a2[t], o); a3[t] += __shfl_xor(a3[t], o); a4[t] += __shfl_xor(a4[t], o); } }
            if (kq == 0) { const f32x4 bb = *(const f32x4*)(b_mod + (size_t)l * NMOD + j); float* o = MOD + (size_t)l * 5 * NMOD + j;
                *(f32x4*)(o) = a0 + bb; *(f32x4*)(o + NMOD) = a1 + bb; *(f32x4*)(o + 2 * NMOD) = a2 + bb; *(f32x4*)(o + 3 * NMOD) = a3 + bb; *(f32x4*)(o + 4 * NMOD) = a4 + bb; }
        }
        for (int it = bid * 512 + tid; it < NL * 8 * CH * CH / 8; it += G * 512) { const f32x4 a0 = *(const f32x4*)(gws + (size_t)it * 8), a1 = *(const f32x4*)(gws + (size_t)it * 8 + 4);
            u32x4 o; o.x = pk2(a0[0], a0[1]); o.y = pk2(a0[2], a0[3]); o.z = pk2(a1[0], a1[1]); o.w = pk2(a1[2], a1[3]); *(u32x4*)(WSB + (size_t)it * 8) = o; }
        LAS float* scr = (LAS float*)(lds + wave * 8448);
        int it0 = 0;
        conv_matrix(w_in, WIN, D, PIN, NP, 1, it0, gw, ngw, scr, lane);
        conv_matrix(w_out, WOUT, D, D, D, 0, it0, gw, ngw, scr, lane);
        conv_matrix(w_fi, WFI, D, 2 * FF, 2 * FF, 2, it0, gw, ngw, scr, lane);
        conv_matrix(w_fo, WFO, FF, D, D, 0, it0, gw, ngw, scr, lane);
    }
    SEAM(0);
    if (IN(1)) { PHASE_IDS();
        RowArgs r{}; r.xin_x = x; r.xin_c = ctx; r.X = X; r.Xw = X; r.H = H; r.modB = MOD; r.gB = g_pre_mix; r.mode = 0; r.write_h = 1;
        row_phase(r, M, lds, tid, lane, gw, ngw);
    }
    SEAM(1);
    run_layer<0>(a, lds, bar, tid0, G, bid, lo, hi);
    run_layer<1>(a, lds, bar, tid0, G, bid, lo, hi);
    run_layer<2>(a, lds, bar, tid0, G, bid, lo, hi);
    run_layer<3>(a, lds, bar, tid0, G, bid, lo, hi);
#undef IN
#undef SEAM
}

#ifndef MK_SPLIT
#define MK_SPLIT 0
#endif
extern "C" void kernel_launch(void* const* d_in, const int* in_sizes, int n_in, void* d_out, int out_size, void* d_ws, size_t ws_size, hipStream_t stream) {
    static int grid = 0;
    if (grid == 0) {
        if (n_in != 23 || ws_size < WS_END || out_size != MX * D) { fprintf(stderr, "kernel_launch: unexpected shapes (n_in %d, ws %zu, out %d)\n", n_in, ws_size, out_size); grid = -1; return; }
        int dev = 0, cus = 0, per_cu = 0;
        if (hipGetDevice(&dev) != hipSuccess || hipDeviceGetAttribute(&cus, hipDeviceAttributeMultiprocessorCount, dev) != hipSuccess) { grid = -1; return; }
        if (hipFuncSetAttribute((const void*)mega, hipFuncAttributeMaxDynamicSharedMemorySize, LDS_BYTES) != hipSuccess) { fprintf(stderr, "kernel_launch: hipFuncSetAttribute failed\n"); grid = -1; return; }
        if (hipOccupancyMaxActiveBlocksPerMultiprocessor(&per_cu, (const void*)mega, 512, LDS_BYTES) != hipSuccess || per_cu < 1) { fprintf(stderr, "kernel_launch: occupancy query says %d\n", per_cu); }
        (void)hipGetLastError();
        grid = cus;
    }
    if (grid < 0) return;
    (void)hipMemsetAsync((char*)d_ws + WS_CTL, 0, ZERO_BYTES, stream);
    Args a{};
    for (int i = 0; i < 23; ++i) a.in[i] = (const float*)d_in[i];
    a.out = (float*)d_out; a.ws = (unsigned char*)d_ws;
#if MK_SPLIT
    for (int p = 0; p < NPH; ++p) { a.ph_lo = p; a.ph_hi = p + 1; a.li = 0; hipLaunchKernelGGL(mega, dim3(grid), dim3(512), LDS_BYTES, stream, a); }
#else
    a.ph_lo = 0; a.ph_hi = NPH; a.li = 0;
    hipLaunchKernelGGL(mega, dim3(grid), dim3(512), LDS_BYTES, stream, a);
#endif
}
```

```cpp
#include <hip/hip_runtime.h>
#include <cstdio>
#include <cstdint>
namespace pg8 {
#define PG8_LAS __attribute__((address_space(3)))
typedef unsigned short bf16_t;
typedef short bf16x8 __attribute__((ext_vector_type(8)));
typedef float f32x4 __attribute__((ext_vector_type(4)));
typedef unsigned u32x4 __attribute__((ext_vector_type(4)));
constexpr int BM = 256, BK = 64, HALF = 128, HTB = HALF * BK * 2  , STAGE_BYTES = 8 * HTB, NXCD = 8, WGM = 8;

__host__ __device__ __forceinline__ int lds_byte(int r, int c) { const int st = (r >> 4) * 2 + (c >> 5), rr = r & 15, cc = c & 31, ob = rr * 64 + cc * 2; return st * 1024 + (ob ^ (((ob >> 9) & 1) << 5)); }
__host__ __device__ __forceinline__ void stage_rc(int b, int& R, int& C) { const int st = b / 1024, sb = b % 1024, swz = sb ^ (((sb >> 9) & 1) << 5); R = (st >> 1) * 16 + swz / 64; C = (st & 1) * 32 + (swz % 64) / 2; }
__host__ __device__ __forceinline__ int perm32(int rho) { const int n = rho >> 4, i = rho & 15; return 8 * (i >> 2) + 4 * n + (i & 3); }

struct Unit { int pm, pn, koff, ks; };
struct Gemm { const bf16_t* A; const bf16_t* Bt; int M, N, K, ld; };

struct StaticOrder {
    int nM, nN, nwg, G, c;
    __host__ __device__ void init(int M, int N, int G_, int c_) { nM = M / BM; nN = N / BM; nwg = nM * nN; G = G_; c = c_; }
    __host__ __device__ bool next(int i, Unit& u) const {
        const long L = (long)i * G + c; if (L >= nwg) return false;
        int wgid = (int)L; { const int q = nwg / NXCD, r = nwg % NXCD, xcd = wgid % NXCD, off = wgid / NXCD; wgid = (xcd < r ? xcd * (q + 1) : r * (q + 1) + (xcd - r) * q) + off; }
        const int nig = WGM * nN, gid = wgid / nig, fm = gid * WGM, gsz = (nM - fm) < WGM ? (nM - fm) : WGM;
        u.pm = fm + ((wgid % nig) % gsz); u.pn = (wgid % nig) / gsz; u.koff = 0; u.ks = 0; return true;
    }
    __device__ __forceinline__ void a_ready(const Unit&) const {}
    __device__ __forceinline__ void done(const Unit&) const {}
    __device__ __forceinline__ int nt(int full) const { return full; }
};
struct SplitOrder {
    int nN, ntiles, c, kt0, ktn;
    __host__ __device__ void init(int nM, int nN_, int KT, int c_) { nN = nN_; ntiles = nM * nN_; c = c_; const int ks = c / ntiles, base = (KT / 8) & ~1, rem = KT - 8 * base, nbig = rem / 2;
        ktn = base + (ks >= 8 - nbig ? 2 : 0); kt0 = ks * base + (ks > 8 - nbig ? 2 * (ks - (8 - nbig)) : 0); }
    __host__ __device__ bool next(int i, Unit& u) const { if (i != 0 || c >= 8 * ntiles) return false; const int t = c % ntiles; u.pm = t / nN; u.pn = t % nN; u.ks = c / ntiles; u.koff = kt0 * BK * 2; return true; }
    __device__ __forceinline__ void a_ready(const Unit&) const {}
    __device__ __forceinline__ void done(const Unit&) const {}
    __device__ __forceinline__ int nt(int) const { return ktn; }
};


__device__ __forceinline__ unsigned cvt_pk_bf16(float lo, float hi) { unsigned r; asm volatile("v_cvt_pk_bf16_f32 %0, %1, %2" : "=v"(r) : "v"(lo), "v"(hi)); return r; }
__device__ __forceinline__ float fast_sigmoid(float x) { return __builtin_amdgcn_rcpf(1.0f + __builtin_amdgcn_exp2f(-1.4426950408889634f * x)); }
__device__ __forceinline__ float gelu_tanh(float x) { const float y = 1.5957691216057308f * (x + 0.044715f * x * x * x); return x * fast_sigmoid(y); }
__device__ __forceinline__ float silu_f(float x) { return x * fast_sigmoid(x); }

struct EpiF32 {
    static constexpr bool PERM = false, AFTER_DRAIN = false;
    float* C; int ldc; int pad;
    __device__ __forceinline__ void operator()(const f32x4 (&acc)[2][2][4][2], const Unit& u, int wr, int wc, int fr, int fq) const {
        const int row0 = u.pm * BM + wr * 64 + fr, col0 = u.pn * BM + wc * 32 + 4 * fq;
#pragma unroll
        for (int ai = 0; ai < 2; ++ai)
#pragma unroll
            for (int m = 0; m < 4; ++m) { float* rowp = C + (size_t)(row0 + ai * HALF + m * 16) * ldc + col0;
#pragma unroll
                for (int bj = 0; bj < 2; ++bj)
#pragma unroll
                    for (int n = 0; n < 2; ++n) *(f32x4*)(rowp + bj * HALF + n * 16) = acc[ai][bj][m][n]; }
    }
};
struct EpiPartF32 {
    static constexpr bool PERM = false, AFTER_DRAIN = false;
    float* C; int ldc; int pad; size_t split_stride;
    __device__ __forceinline__ void operator()(const f32x4 (&acc)[2][2][4][2], const Unit& u, int wr, int wc, int fr, int fq) const {
        const int row0 = u.pm * BM + wr * 64 + fr, col0 = u.pn * BM + wc * 32 + 4 * fq; float* base = C + (size_t)u.ks * split_stride;
#pragma unroll
        for (int ai = 0; ai < 2; ++ai)
#pragma unroll
            for (int m = 0; m < 4; ++m) { float* rowp = base + (size_t)(row0 + ai * HALF + m * 16) * ldc + col0;
#pragma unroll
                for (int bj = 0; bj < 2; ++bj)
#pragma unroll
                    for (int n = 0; n < 2; ++n) *(f32x4*)(rowp + bj * HALF + n * 16) = acc[ai][bj][m][n]; }
    }
};
struct EpiProj {
    static constexpr bool PERM = true, AFTER_DRAIN = false;
    bf16_t* O; int ldc; int ngelu;
    __device__ __forceinline__ void operator()(const f32x4 (&acc)[2][2][4][2], const Unit& u, int wr, int wc, int fr, int fq) const {
        const int row0 = u.pm * BM + wr * 64 + fr, col0 = u.pn * BM + wc * 32 + 8 * fq;
        const bool act = u.pn < ngelu;
#pragma unroll
        for (int ai = 0; ai < 2; ++ai)
#pragma unroll
            for (int m = 0; m < 4; ++m) { bf16_t* rowp = O + (size_t)(row0 + ai * HALF + m * 16) * ldc + col0;
#pragma unroll
                for (int bj = 0; bj < 2; ++bj) { f32x4 v0 = acc[ai][bj][m][0], v1 = acc[ai][bj][m][1];
                    if (act) {
#pragma unroll
                        for (int j = 0; j < 4; ++j) { v0[j] = gelu_tanh(v0[j]); v1[j] = gelu_tanh(v1[j]); } }
                    u32x4 w; w.x = cvt_pk_bf16(v0[0], v0[1]); w.y = cvt_pk_bf16(v0[2], v0[3]); w.z = cvt_pk_bf16(v1[0], v1[1]); w.w = cvt_pk_bf16(v1[2], v1[3]);
                    *(u32x4*)(rowp + bj * HALF) = w; } }
    }
};
struct EpiSwiglu {
    static constexpr bool PERM = true, AFTER_DRAIN = false;
    bf16_t* O; int ldc; int pad;
    __device__ __forceinline__ void operator()(const f32x4 (&acc)[2][2][4][2], const Unit& u, int wr, int wc, int fr, int fq) const {
        const int row0 = u.pm * BM + wr * 64 + fr, col0 = u.pn * HALF + wc * 32 + 8 * fq;
#pragma unroll
        for (int ai = 0; ai < 2; ++ai)
#pragma unroll
            for (int m = 0; m < 4; ++m) { bf16_t* rowp = O + (size_t)(row0 + ai * HALF + m * 16) * ldc + col0;
                f32x4 h0, h1;
#pragma unroll
                for (int j = 0; j < 4; ++j) { h0[j] = silu_f(acc[ai][0][m][0][j]) * acc[ai][1][m][0][j]; h1[j] = silu_f(acc[ai][0][m][1][j]) * acc[ai][1][m][1][j]; }
                u32x4 w; w.x = cvt_pk_bf16(h0[0], h0[1]); w.y = cvt_pk_bf16(h0[2], h0[3]); w.z = cvt_pk_bf16(h1[0], h1[1]); w.w = cvt_pk_bf16(h1[2], h1[3]);
                *(u32x4*)rowp = w; }
    }
};

template <class Epi, class Sched, bool ALIGN_EPI = false, bool SP2 = false>
__device__ __forceinline__ void gemm_phase(PG8_LAS unsigned char* lds, const Gemm g, const Sched& S, const Epi& E) {
    int tid_o = threadIdx.x; asm volatile("" : "+v"(tid_o));
    const int tid = tid_o, wid = __builtin_amdgcn_readfirstlane(tid >> 6), lane = tid & 63, wr = wid >> 2, wc = wid & 3, fr = lane & 15, fq = lane >> 4;
    const int K = g.ld, nt = S.nt(g.K / BK);
    unsigned voffA[2], voffB[2];
#pragma unroll
    for (int i = 0; i < 2; ++i) { int R, C; stage_rc(tid * 16 + i * 8192, R, C); const int Rb = Epi::PERM ? ((R & ~31) + perm32(R & 31)) : R;
        voffA[i] = (unsigned)(R * K + C) * 2u; voffB[i] = (unsigned)(Rb * K + C) * 2u; }
    const size_t kstep = (size_t)(BK * 2);
    const size_t hstep = (size_t)HALF * K * 2;
    const size_t tstep = 2 * hstep;
    const unsigned ldsw = (unsigned)wid * 1024u;
    const int aoff = lds_byte(wr * 64 + fr, fq * 8), boff = lds_byte(wc * 32 + fr, fq * 8);
#define PG8_SA(b, h) (((b) * 2 + (h)) * HTB)
#define PG8_SB(b, h) ((4 + (b) * 2 + (h)) * HTB)
#define PG8_STAGE(bufoff, gbase, voff) do { _Pragma("unroll") for (int _i = 0; _i < 2; ++_i) \
        __builtin_amdgcn_global_load_lds((const unsigned*)((const char*)(gbase) + (voff)[_i]), (PG8_LAS unsigned*)(lds + (bufoff) + ldsw + _i * 8192), 16, 0, 0); } while (0)
#define PG8_LDA(dst, b, h) do { _Pragma("unroll") for (int m = 0; m < 4; ++m) _Pragma("unroll") for (int k = 0; k < 2; ++k) dst[m][k] = *(const PG8_LAS bf16x8*)(lds + PG8_SA(b, h) + aoff + m * 2048 + k * 1024); } while (0)
#define PG8_LDB(dst, b, h) do { _Pragma("unroll") for (int n = 0; n < 2; ++n) _Pragma("unroll") for (int k = 0; k < 2; ++k) dst[n][k] = *(const PG8_LAS bf16x8*)(lds + PG8_SB(b, h) + boff + n * 2048 + k * 1024); } while (0)
#define PG8_MMA(ai, bj, At, Bt) do { __builtin_amdgcn_s_setprio(1); _Pragma("unroll") for (int m = 0; m < 4; ++m) _Pragma("unroll") for (int n = 0; n < 2; ++n) _Pragma("unroll") for (int k = 0; k < 2; ++k) \
        acc[ai][bj][m][n] = __builtin_amdgcn_mfma_f32_16x16x32_bf16(Bt[n][k], At[m][k], acc[ai][bj][m][n], 0, 0, 0); __builtin_amdgcn_s_setprio(0); } while (0)
#define PG8_WAIT_V(n) asm volatile("s_waitcnt vmcnt(" #n ")" ::: "memory")
#define PG8_WAIT_L(n) asm volatile("s_waitcnt lgkmcnt(" #n ")" ::: "memory")
#define PG8_BAR __builtin_amdgcn_s_barrier()
#define PG8_SCHED __builtin_amdgcn_sched_barrier(0)
    Unit cur, nxt; int ui = 0;
    if (!S.next(0, cur)) return;
    f32x4 acc[2][2][4][2];
#pragma unroll
    for (int a = 0; a < 2; ++a)
#pragma unroll
        for (int b = 0; b < 2; ++b)
#pragma unroll
            for (int m = 0; m < 4; ++m)
#pragma unroll
                for (int n = 0; n < 2; ++n) acc[a][b][m][n] = (f32x4){0.f, 0.f, 0.f, 0.f};
    bf16x8 At[4][2], B0[2][2], B1[2][2];
    const char* cA = (const char*)g.A + (size_t)cur.pm * tstep + cur.koff; const char* cB = (const char*)g.Bt + (size_t)cur.pn * tstep + cur.koff;
    S.a_ready(cur);
    if constexpr (SP2) {
        PG8_STAGE(PG8_SB(0, 0), cB, voffB); PG8_STAGE(PG8_SB(0, 1), cB + hstep, voffB); PG8_STAGE(PG8_SA(0, 0), cA, voffA); PG8_STAGE(PG8_SA(0, 1), cA + hstep, voffA);
        if (wr == 1) PG8_BAR;
        PG8_WAIT_V(2); PG8_BAR;
        PG8_STAGE(PG8_SB(1, 0), cB + kstep, voffB); PG8_STAGE(PG8_SA(1, 0), cA + kstep, voffA); PG8_STAGE(PG8_SB(1, 1), cB + hstep + kstep, voffB);
        PG8_WAIT_V(6); PG8_BAR;
    } else {
        PG8_STAGE(PG8_SB(0, 0), cB, voffB); PG8_STAGE(PG8_SA(0, 0), cA, voffA); PG8_STAGE(PG8_SB(0, 1), cB + hstep, voffB); PG8_STAGE(PG8_SA(0, 1), cA + hstep, voffA);
        if (wr == 1) PG8_BAR;
        PG8_WAIT_V(4); PG8_BAR;
        PG8_STAGE(PG8_SB(1, 0), cB + kstep, voffB); PG8_STAGE(PG8_SA(1, 0), cA + kstep, voffA); PG8_STAGE(PG8_SB(1, 1), cB + hstep + kstep, voffB);
        PG8_WAIT_V(6); PG8_BAR;
    }
    for (;;) {
        const bool has_next = S.next(ui + 1, nxt);
        const char* nA = has_next ? (const char*)g.A + (size_t)nxt.pm * tstep + nxt.koff : cA; const char* nB = has_next ? (const char*)g.Bt + (size_t)nxt.pn * tstep + nxt.koff : cB;
        for (int t = 0; t < nt; t += 2) {
            const bool last = (t == nt - 2);
            const char* a1 = cA + (size_t)(t + 1) * kstep;
            const char* a2 = last ? nA : cA + (size_t)(t + 2) * kstep; const char* b2 = last ? nB : cB + (size_t)(t + 2) * kstep;
            const char* a3 = a2 + kstep; const char* b3 = b2 + kstep;
            if (last && has_next) S.a_ready(nxt);
            if constexpr (SP2) {
            PG8_LDB(B0, 0, 0); PG8_LDB(B1, 0, 1); PG8_SCHED; PG8_LDA(At, 0, 0); PG8_STAGE(PG8_SA(1, 1), a1 + hstep, voffA);
            PG8_WAIT_V(8); PG8_WAIT_L(0); PG8_BAR; PG8_MMA(0, 0, At, B0); PG8_MMA(0, 1, At, B1); PG8_BAR; PG8_SCHED;
            PG8_LDA(At, 0, 1); PG8_STAGE(PG8_SB(0, 0), b2, voffB); PG8_STAGE(PG8_SB(0, 1), b2 + hstep, voffB); PG8_STAGE(PG8_SA(0, 0), a2, voffA);
            PG8_WAIT_V(8); PG8_WAIT_L(0); PG8_BAR; PG8_MMA(1, 0, At, B0); PG8_MMA(1, 1, At, B1); PG8_BAR; PG8_SCHED;
            PG8_LDB(B0, 1, 0); PG8_LDB(B1, 1, 1); PG8_SCHED; PG8_LDA(At, 1, 0); PG8_STAGE(PG8_SA(0, 1), a2 + hstep, voffA);
            PG8_WAIT_V(8); PG8_WAIT_L(0); PG8_BAR; PG8_MMA(0, 0, At, B0); PG8_MMA(0, 1, At, B1); PG8_BAR; PG8_SCHED;
            PG8_LDA(At, 1, 1); PG8_STAGE(PG8_SB(1, 0), b3, voffB); PG8_STAGE(PG8_SB(1, 1), b3 + hstep, voffB); PG8_STAGE(PG8_SA(1, 0), a3, voffA);
            PG8_WAIT_V(8); PG8_WAIT_L(0); PG8_BAR; PG8_MMA(1, 0, At, B0); PG8_MMA(1, 1, At, B1); PG8_BAR; PG8_SCHED;
            } else {
            PG8_LDB(B0, 0, 0); PG8_SCHED; PG8_LDA(At, 0, 0); PG8_STAGE(PG8_SA(1, 1), a1 + hstep, voffA);
            PG8_WAIT_L(8); PG8_BAR; PG8_WAIT_L(0); PG8_MMA(0, 0, At, B0); PG8_BAR; PG8_SCHED;
            PG8_LDB(B1, 0, 1); PG8_STAGE(PG8_SB(0, 0), b2, voffB);
            PG8_BAR; PG8_WAIT_L(0); PG8_MMA(0, 1, At, B1); PG8_BAR;
            PG8_LDA(At, 0, 1); PG8_STAGE(PG8_SA(0, 0), a2, voffA);
            PG8_BAR; PG8_WAIT_L(0); PG8_MMA(1, 0, At, B0); PG8_BAR; PG8_SCHED;
            PG8_STAGE(PG8_SB(0, 1), b2 + hstep, voffB);
            PG8_WAIT_V(6); PG8_BAR; PG8_MMA(1, 1, At, B1); PG8_BAR;
            PG8_LDB(B0, 1, 0); PG8_SCHED; PG8_LDA(At, 1, 0); PG8_STAGE(PG8_SA(0, 1), a2 + hstep, voffA);
            PG8_WAIT_L(8); PG8_BAR; PG8_WAIT_L(0); PG8_MMA(0, 0, At, B0); PG8_BAR; PG8_SCHED;
            PG8_LDB(B1, 1, 1); PG8_STAGE(PG8_SB(1, 0), b3, voffB);
            PG8_BAR; PG8_WAIT_L(0); PG8_MMA(0, 1, At, B1); PG8_BAR;
            PG8_LDA(At, 1, 1); PG8_STAGE(PG8_SA(1, 0), a3, voffA);
            PG8_BAR; PG8_WAIT_L(0); PG8_MMA(1, 0, At, B0); PG8_BAR; PG8_SCHED;
            PG8_STAGE(PG8_SB(1, 1), b3 + hstep, voffB);
            PG8_WAIT_V(6); PG8_BAR; PG8_MMA(1, 1, At, B1); PG8_BAR;
            }
        }
        if constexpr (ALIGN_EPI) { if (wr == 0) PG8_BAR; }
        if constexpr (!Epi::AFTER_DRAIN) { E(acc, cur, wr, wc, fr, fq); S.done(cur); }
        if (!has_next) break;
#pragma unroll
        for (int a = 0; a < 2; ++a)
#pragma unroll
            for (int b = 0; b < 2; ++b)
#pragma unroll
                for (int m = 0; m < 4; ++m)
#pragma unroll
                    for (int n = 0; n < 2; ++n) acc[a][b][m][n] = (f32x4){0.f, 0.f, 0.f, 0.f};
        cur = nxt; cA = nA; cB = nB; ++ui;
        if constexpr (ALIGN_EPI) { if (wr == 1) PG8_BAR; }
    }
    PG8_WAIT_V(0);
    if constexpr (!ALIGN_EPI) { if (wr == 0) PG8_BAR; }
    PG8_BAR;
    if constexpr (Epi::AFTER_DRAIN) { E.fused(acc, cur, wr, wc, fr, fq, lds, wid, lane); S.done(cur); }
#undef PG8_SA
#undef PG8_SB
#undef PG8_STAGE
#undef PG8_LDA
#undef PG8_LDB
#undef PG8_MMA
#undef PG8_WAIT_V
#undef PG8_WAIT_L
#undef PG8_BAR
#undef PG8_SCHED
}
}
#define XB_TMO      128
#define XB_XCNT(j)  (256  + 64 * (j))
#define XB_XSUB(j)  (1280 + 64 * (j))
#define XB_XGEN(j)  (2304 + 64 * (j))
#define XB_TOP      3328
#define XB_TOPGEN   3392
#define XCD_BAR_WORDS 3456
#define XB_SPIN_CAP (1u << 18)
#define LAS __attribute__((address_space(3)))

__device__ __forceinline__ unsigned xb_ld(unsigned* p)              { return __hip_atomic_load(p, __ATOMIC_RELAXED, __HIP_MEMORY_SCOPE_AGENT); }
__device__ __forceinline__ unsigned xb_add(unsigned* p, unsigned v) { return __hip_atomic_fetch_add(p, v, __ATOMIC_RELAXED, __HIP_MEMORY_SCOPE_AGENT); }
__device__ __forceinline__ unsigned xb_xcc_id() { return (unsigned)__builtin_amdgcn_s_getreg((3 << 11) | 20) & 0xFu; }
#define XB_SPIN(cond, bar) do { unsigned _sp = 0; while (cond) { __builtin_amdgcn_s_sleep(1); \
    if ((++_sp & 255u) == 0u) { if (xb_ld(&(bar)[XB_TMO])) break; if (_sp > XB_SPIN_CAP) { atomicAdd(&(bar)[XB_TMO], 1u); break; } } } } while (0)

struct XcdBarrier {
    unsigned* bar; unsigned x;
    volatile LAS unsigned* st;
};

__device__ __forceinline__ XcdBarrier xcd_barrier_post(unsigned* bar, volatile LAS unsigned* st) {
    XcdBarrier b; b.bar = bar; b.x = xb_xcc_id(); b.st = st;
    if (threadIdx.x == 0) (void)xb_add(&bar[XB_XCNT(b.x)], 1u);
    return b;
}
__device__ __forceinline__ void xcd_barrier_complete(unsigned* bar, unsigned x, unsigned& nloc, unsigned& nx) {
    const unsigned G = gridDim.x * gridDim.y * gridDim.z;
    unsigned sum, cnt, mine, sp = 0u;
    for (;;) {
        sum = 0u; cnt = 0u; mine = 0u;
#pragma unroll
        for (unsigned j = 0; j < 16; ++j) { const unsigned c = xb_ld(&bar[XB_XCNT(j)]); sum += c; cnt += (c > 0u) ? 1u : 0u; mine = (j == x) ? c : mine; }
        if (sum == G) break;
        __builtin_amdgcn_s_sleep(1);
        if ((++sp & 255u) == 0u) { if (xb_ld(&bar[XB_TMO])) break; if (sp > XB_SPIN_CAP) { atomicAdd(&bar[XB_TMO], 1u); break; } }
    }
    nloc = mine > 0u ? mine : 1u; nx = cnt > 0u ? cnt : 1u;
}

__device__ __forceinline__ void xcd_barrier(const XcdBarrier& b) {
    asm volatile("s_waitcnt vmcnt(0)" ::: "memory");
    __syncthreads();
    if (threadIdx.x == 0) {
        unsigned* bar = b.bar;
        __builtin_amdgcn_s_waitcnt(0);
        unsigned nloc = b.st[0], nx = b.st[1];
        if (nloc == 0u) { xcd_barrier_complete(bar, b.x, nloc, nx); b.st[0] = nloc; b.st[1] = nx; }
        const unsigned old = xb_add(&bar[XB_XSUB(b.x)], 1u);
        const unsigned gen = old / nloc;
        if (old + 1u == (gen + 1u) * nloc) {
            __builtin_amdgcn_fence(__ATOMIC_RELEASE, "agent");
            asm volatile("s_waitcnt vmcnt(0)" ::: "memory");
            const unsigned og = xb_add(&bar[XB_TOP], 1u);
            const unsigned tg = og / nx;
            if (og + 1u == (tg + 1u) * nx) xb_add(&bar[XB_TOPGEN], 1u);
            else XB_SPIN(xb_ld(&bar[XB_TOPGEN]) == tg, bar);
            __builtin_amdgcn_fence(__ATOMIC_ACQUIRE, "agent");
            xb_add(&bar[XB_XGEN(b.x)], 1u);
            asm volatile("s_waitcnt vmcnt(0)" ::: "memory");
        } else {
            XB_SPIN(xb_ld(&bar[XB_XGEN(b.x)]) == gen, bar);
            __builtin_amdgcn_fence(__ATOMIC_ACQUIRE, "agent");
            asm volatile("s_waitcnt vmcnt(0)" ::: "memory");
        }
    }
    __syncthreads();
}

typedef unsigned short bf16;
typedef float f32x4 __attribute__((ext_vector_type(4)));
typedef unsigned u32x4 __attribute__((ext_vector_type(4)));
typedef unsigned u32x2 __attribute__((ext_vector_type(2)));
constexpr int D = 2048, NB = 4, SEQ = 4096, NL = 4, CTX = 256, CH = 128;
constexpr int MX = NB * SEQ, MC = NB * CTX, M = MX + MC;
constexpr int PIN = 5152, NP = 5376, FF = 5632, NMOD = 6 * D;
constexpr int C_U = 0, C_V = 1024, C_Q = 2048, C_K = 2560, C_VV = 3072, C_G = 4096, C_DF = 5120, C_DB = 5136;
constexpr int NCHUNK = M / CH;
constexpr float EPS = 1e-6f;
constexpr size_t MiB = 1u << 20;
constexpr size_t WS_CTL = 0, WS_MOD = 1 * MiB, WS_WIN = 2 * MiB, WS_WOUT = WS_WIN + 84 * MiB, WS_WFI = WS_WOUT + 32 * MiB, WS_WFO = WS_WFI + 176 * MiB,
                 WS_X = WS_WFO + 88 * MiB, WS_H = WS_X + 136 * MiB, WS_P = WS_H + 68 * MiB, WS_CAT = WS_P + 179 * MiB, WS_Y = WS_CAT + 68 * MiB, WS_HID = WS_Y + 136 * MiB,
                 WS_DS = WS_HID + 187 * MiB, WS_SP = WS_DS + 136 * MiB, WS_DEC = WS_SP + 68 * MiB, WS_WSB = WS_DEC + 1 * MiB, WS_QK = WS_WSB + 1 * MiB, WS_YP = WS_QK + 68 * MiB, WS_END = WS_YP + 64 * MiB;
static_assert((size_t)NL * NP * D * 2 <= 84 * MiB && (size_t)NL * 2 * FF * D * 2 <= 176 * MiB && (size_t)NL * D * FF * 2 <= 88 * MiB && (size_t)M * NP * 2 <= 179 * MiB && (size_t)M * FF * 2 <= 187 * MiB, "ws map");
constexpr int CW_BAR = 4096;
constexpr size_t ZERO_BYTES = (size_t)(CW_BAR + 3456) * 4;
static_assert(ZERO_BYTES % 16 == 0, "memset size");
constexpr int LDS_BYTES = 163840, MISC_OFF = LDS_BYTES - 256;

__device__ __forceinline__ float bf2f(bf16 b) { return __uint_as_float(((unsigned)b) << 16); }
__device__ __forceinline__ unsigned f2bf(float f) { unsigned u = __float_as_uint(f); return (u + 0x7fffu + ((u >> 16) & 1u)) >> 16; }
__device__ __forceinline__ unsigned pk2(float lo, float hi) { return f2bf(lo) | (f2bf(hi) << 16); }
__device__ __forceinline__ float wave_sum(float v) {
#pragma unroll
    for (int o = 1; o < 64; o <<= 1) v += __shfl_xor(v, o);
    return v;
}
__device__ __forceinline__ float sigmoid_acc(float x) { return 1.0f / (1.0f + __expf(-x)); }
__device__ __forceinline__ float silu_acc(float x) { return x * sigmoid_acc(x); }
__device__ __forceinline__ float log_sigmoid(float z) { return fminf(z, 0.f) - log1pf(__expf(-fabsf(z))); }
__device__ __forceinline__ int mod_row(int row) { return row < MX ? row / SEQ : NB; }
#define LDS_WAIT() asm volatile("s_waitcnt lgkmcnt(0)" ::: "memory")


__device__ __forceinline__ int map_col(int mode, int r) {
    if (mode == 0) return r;
    if (mode == 1) return r < PIN ? r : -1;
    const int pn = r >> 8, rr = r & 255; return rr < 128 ? pn * 128 + rr : FF + pn * 128 + (rr - 128);
}
__device__ __forceinline__ void transpose_item(const float* W, int K, int Nsrc, bf16* T, int n0, int c0, int k0, LAS float* scr, int lane) {
    if (c0 >= 0) {
#pragma unroll 8
        for (int i = 0; i < 32; ++i) { const int kk = 2 * i + (lane >> 5); scr[kk * 33 + (lane & 31)] = __builtin_nontemporal_load(W + (size_t)(k0 + kk) * Nsrc + c0 + (lane & 31)); }
    } else {
#pragma unroll 8
        for (int i = 0; i < 32; ++i) { const int kk = 2 * i + (lane >> 5); scr[kk * 33 + (lane & 31)] = 0.f; }
    }
    LDS_WAIT(); asm volatile("" ::: "memory");
    const int c = lane & 7;
#pragma unroll
    for (int j = 0; j < 4; ++j) { const int n = (lane >> 3) + 8 * j; const LAS float* s = scr + (8 * c) * 33 + n;
        u32x4 o; o.x = pk2(s[0 * 33], s[1 * 33]); o.y = pk2(s[2 * 33], s[3 * 33]); o.z = pk2(s[4 * 33], s[5 * 33]); o.w = pk2(s[6 * 33], s[7 * 33]);
        __builtin_nontemporal_store(o, (u32x4*)(T + (size_t)(n0 + n) * K + k0 + 8 * c)); }
    LDS_WAIT(); asm volatile("" ::: "memory");
}
__device__ __forceinline__ void conv_matrix(const float* W, bf16* T, int K, int Nsrc, int Ndst, int mode, int& it0, int gw, int ngw, LAS float* scr, int lane) {
    const int nblk = Ndst / 32, per_layer = (K / 64) * nblk, total = NL * per_layer;
    int first = ((gw - it0) % ngw + ngw) % ngw;
    for (int it = first; it < total; it += ngw) {
        const int l = it / per_layer, r = it % per_layer, kb = r / nblk, nb = r % nblk;
        transpose_item(W + (size_t)l * K * Nsrc, K, Nsrc, T + (size_t)l * Ndst * K, 32 * nb, map_col(mode, 32 * nb), 64 * kb, scr, lane);
    }
    it0 += total;
}
struct RowArgs { const float* xin_x; const float* xin_c; const float* YP; const bf16* Y; bf16* X; bf16* Xw; float* out; bf16* H; const float* modA; const float* modB; const float* gA; const float* gB; int mode; int write_h; int to_out; int pad; };
__device__ __forceinline__ void row_vectors(const RowArgs& a, LAS float* VEC, int tid) {
    for (int i = tid; i < 5 * (D / 4); i += 512) { const int r = i / (D / 4), c = (i % (D / 4)) * 4;
        if (a.mode != 0) { const f32x4 m = *(const f32x4*)(a.modA + (size_t)r * NMOD + (a.mode == 1 ? 2 : 5) * D + c), g = *(const f32x4*)(a.gA + c); *(LAS f32x4*)(VEC + (r * 3 + 0) * D + c) = m * g; }
        if (a.write_h) { const float* msh = (a.mode == 1 ? a.modA + (size_t)r * NMOD + 3 * D : a.modB + (size_t)r * NMOD);
            const f32x4 sh = *(const f32x4*)(msh + c), sc = *(const f32x4*)(msh + D + c), g = *(const f32x4*)(a.gB + c);
            *(LAS f32x4*)(VEC + (r * 3 + 1) * D + c) = g * (sc + 1.0f); *(LAS f32x4*)(VEC + (r * 3 + 2) * D + c) = sh; } }
}
__device__ __forceinline__ bool row_from_input(const RowArgs& a) { return !(a.mode == 2 || a.xin_x == nullptr); }
__device__ __forceinline__ f32x4 row_load_x(const RowArgs& a, int row, int off) {
    if (row_from_input(a)) { const float* p = row < MX ? a.xin_x + (size_t)row * D : a.xin_c + (size_t)(row - MX) * D; return __builtin_nontemporal_load((const f32x4*)(p + off)); }
    const u32x2 w = __builtin_nontemporal_load((const u32x2*)(a.X + (size_t)row * D + off));
    return (f32x4){__uint_as_float(w.x << 16), __uint_as_float(w.x & 0xffff0000u), __uint_as_float(w.y << 16), __uint_as_float(w.y & 0xffff0000u)};
}
#define RCOL(lane, j) (8 * (lane) + 512 * ((j) >> 1) + 4 * ((j) & 1))
__device__ __forceinline__ void row_unpack8(const u32x4 w, f32x4& lo, f32x4& hi) {
    lo = (f32x4){__uint_as_float(w.x << 16), __uint_as_float(w.x & 0xffff0000u), __uint_as_float(w.y << 16), __uint_as_float(w.y & 0xffff0000u)};
    hi = (f32x4){__uint_as_float(w.z << 16), __uint_as_float(w.z & 0xffff0000u), __uint_as_float(w.w << 16), __uint_as_float(w.w & 0xffff0000u)};
}
__device__ __forceinline__ void row_finish(const RowArgs& a, int row, int lane, f32x4 (&x)[8], const f32x4 (&y)[8], const LAS float* VEC) {
    const LAS float* V0 = VEC + (mod_row(row) * 3) * D;
    if (a.mode != 0) {
        float ss = 0.f;
#pragma unroll
        for (int j = 0; j < 8; ++j) ss += (y[j][0] * y[j][0] + y[j][1] * y[j][1]) + (y[j][2] * y[j][2] + y[j][3] * y[j][3]);
        const float rstd = rsqrtf(wave_sum(ss) * (1.f / D) + EPS);
#pragma unroll
        for (int j = 0; j < 8; ++j) { const f32x4 mg = *(const LAS f32x4*)(V0 + RCOL(lane, j)); x[j] = x[j] + mg * (y[j] * rstd); }
        if (a.to_out) { if (row < MX) {
#pragma unroll
            for (int j = 0; j < 8; ++j) __builtin_nontemporal_store(x[j], (f32x4*)(a.out + (size_t)row * D + RCOL(lane, j))); } }
        else {
#pragma unroll
            for (int m = 0; m < 4; ++m) { u32x4 w; w.x = pk2(x[2 * m][0], x[2 * m][1]); w.y = pk2(x[2 * m][2], x[2 * m][3]); w.z = pk2(x[2 * m + 1][0], x[2 * m + 1][1]); w.w = pk2(x[2 * m + 1][2], x[2 * m + 1][3]); __builtin_nontemporal_store(w, (u32x4*)(a.Xw + (size_t)row * D + 8 * lane + 512 * m)); } }
    }
    if (a.write_h) {
        float ss = 0.f;
#pragma unroll
        for (int j = 0; j < 8; ++j) ss += (x[j][0] * x[j][0] + x[j][1] * x[j][1]) + (x[j][2] * x[j][2] + x[j][3] * x[j][3]);
        const float rstd = rsqrtf(wave_sum(ss) * (1.f / D) + EPS);
        bf16* hr = a.H + (size_t)row * D;
#pragma unroll
        for (int m = 0; m < 4; ++m) { f32x4 h[2];
#pragma unroll
            for (int t = 0; t < 2; ++t) { const int j = 2 * m + t; const f32x4 gs = *(const LAS f32x4*)(V0 + D + RCOL(lane, j)), sh = *(const LAS f32x4*)(V0 + 2 * D + RCOL(lane, j)); h[t] = (x[j] * rstd) * gs + sh; }
            u32x4 w; w.x = pk2(h[0][0], h[0][1]); w.y = pk2(h[0][2], h[0][3]); w.z = pk2(h[1][0], h[1][1]); w.w = pk2(h[1][2], h[1][3]); *(u32x4*)(hr + 8 * lane + 512 * m) = w; }
    }
}
__device__ __forceinline__ void row_pass(const RowArgs& a, int row, int lane, const LAS float* VEC) {
    f32x4 x[8], y[8];
#pragma unroll
    for (int j = 0; j < 8; ++j) x[j] = row_load_x(a, row, RCOL(lane, j));
    if (a.mode != 0) {
        if (a.YP != nullptr && row >= MX) {
            const float* yp = a.YP + (size_t)(row - MX) * D;
#pragma unroll
            for (int j = 0; j < 8; ++j) { f32x4 s = *(const f32x4*)(yp + RCOL(lane, j));
#pragma unroll 1
                for (int k = 1; k < 8; ++k) s += *(const f32x4*)(yp + (size_t)k * MC * D + RCOL(lane, j));
                y[j] = s; }
        } else {
            const bf16* yr = a.Y + (size_t)row * D;
#pragma unroll
            for (int m = 0; m < 4; ++m) row_unpack8(*(const u32x4*)(yr + 8 * lane + 512 * m), y[2 * m], y[2 * m + 1]);
        }
    } else {
#pragma unroll
        for (int j = 0; j < 8; ++j) y[j] = (f32x4){0.f, 0.f, 0.f, 0.f};
    }
    row_finish(a, row, lane, x, y, VEC);
}
__device__ __forceinline__ void row_pass2(const RowArgs& a, int r0, int r1, int lane, const LAS float* VEC) {
    f32x4 x0[8], x1[8]; u32x4 w0[4], w1[4];
#pragma unroll
    for (int j = 0; j < 8; ++j) { x0[j] = row_load_x(a, r0, RCOL(lane, j)); x1[j] = row_load_x(a, r1, RCOL(lane, j)); }
    if (a.mode != 0) {
#pragma unroll
        for (int m = 0; m < 4; ++m) { w0[m] = __builtin_nontemporal_load((const u32x4*)(a.Y + (size_t)r0 * D + 8 * lane + 512 * m)); w1[m] = __builtin_nontemporal_load((const u32x4*)(a.Y + (size_t)r1 * D + 8 * lane + 512 * m)); }
    } else {
#pragma unroll
        for (int m = 0; m < 4; ++m) { w0[m] = (u32x4){0u, 0u, 0u, 0u}; w1[m] = (u32x4){0u, 0u, 0u, 0u}; }
    }
    { f32x4 y[8];
#pragma unroll
      for (int m = 0; m < 4; ++m) row_unpack8(w0[m], y[2 * m], y[2 * m + 1]);
      row_finish(a, r0, lane, x0, y, VEC); }
    { f32x4 y[8];
#pragma unroll
      for (int m = 0; m < 4; ++m) row_unpack8(w1[m], y[2 * m], y[2 * m + 1]);
      row_finish(a, r1, lane, x1, y, VEC); }
}
__device__ __forceinline__ void row_phase(const RowArgs& a, int nrows, LAS unsigned char* lds, int tid, int lane, int gw, int ngw) {
    LAS float* VEC = (LAS float*)lds;
    row_vectors(a, VEC, tid);
    __syncthreads();
    for (int r0 = gw; r0 < nrows; r0 += 2 * ngw) { const int r1 = r0 + ngw;
        if (r1 < MX) row_pass2(a, r0, r1, lane, VEC);
        else { row_pass(a, r0, lane, VEC); if (r1 < nrows) row_pass(a, r1, lane, VEC); } }
    __syncthreads();
}


typedef short bf16x8 __attribute__((ext_vector_type(8)));
typedef short s16x4 __attribute__((ext_vector_type(4)));
typedef short v4i16_t __attribute__((ext_vector_type(4)));
constexpr int PQ = 288, PV = 544;
constexpr int L_QT = 0, L_KT = 36864, L_ST = 0, L_V = 73728, L_DF = 143360, L_TOT = 151552;
__device__ __forceinline__ s16x4 tr_read(const LAS unsigned char* p) { return __builtin_bit_cast(s16x4, __builtin_amdgcn_ds_read_tr16_b64_v4i16((LAS v4i16_t*)p)); }
__device__ __forceinline__ bf16x8 cat8(s16x4 lo, s16x4 hi) { return (bf16x8){lo[0], lo[1], lo[2], lo[3], hi[0], hi[1], hi[2], hi[3]}; }
__device__ __forceinline__ float logsig_fast(float z) { return fminf(z, 0.f) - __logf(1.0f + __expf(-fabsf(z))); }
__device__ __forceinline__ f32x4 mfma16(bf16x8 a, bf16x8 b, f32x4 c) { return __builtin_amdgcn_mfma_f32_16x16x32_bf16(a, b, c, 0, 0, 0); }

__device__ __forceinline__ void v_tile_issue(const bf16* P, int cid, int h, u32x4 (&vr)[8], int tid) {
#pragma unroll
    for (int i = 0; i < 8; ++i) { const int idx = tid + 512 * i, row = idx >> 5, ch = idx & 31; vr[i] = *(const u32x4*)(P + (size_t)(cid * CH + row) * NP + C_VV + h * 256 + ch * 8); }
}
__device__ __forceinline__ void v_tile_park(const u32x4 (&vr)[8], LAS unsigned char* V, int tid) {
#pragma unroll
    for (int i = 0; i < 8; ++i) { const int idx = tid + 512 * i, row = idx >> 5, ch = idx & 31; *(LAS u32x4*)(V + row * PV + ch * 16) = vr[i]; }
}
constexpr int PB = 132;
__device__ __forceinline__ float gla_decay_tile(const bf16* P, const float* wd2, const float* bd, int cid, int h, int dir, LAS float* B, int wave, int tid) {
    asm volatile("" : "+v"(tid));
    const int g = (tid >> 4) & 3, li = tid & 15, dcol = h * 128 + 16 * wave + li;
    bf16x8 Bw = {0, 0, 0, 0, 0, 0, 0, 0}, A[8];
    if (g < 2) { u32x4 w; w.x = pk2(wd2[(8 * g + 0) * 512 + dcol], wd2[(8 * g + 1) * 512 + dcol]); w.y = pk2(wd2[(8 * g + 2) * 512 + dcol], wd2[(8 * g + 3) * 512 + dcol]);
        w.z = pk2(wd2[(8 * g + 4) * 512 + dcol], wd2[(8 * g + 5) * 512 + dcol]); w.w = pk2(wd2[(8 * g + 6) * 512 + dcol], wd2[(8 * g + 7) * 512 + dcol]); Bw = __builtin_bit_cast(bf16x8, w); }
    const float bdv = bd[dcol];
    const bf16* dfp = P + (size_t)(cid * CH + li) * NP + (dir ? C_DB : C_DF) + 8 * (g & 1);
#pragma unroll
    for (int s = 0; s < 8; ++s) { const int jt = dir ? 7 - s : s; const bf16x8 v = *(const bf16x8*)(dfp + (size_t)(16 * jt) * NP); A[s] = (g < 2) ? v : (bf16x8){0, 0, 0, 0, 0, 0, 0, 0}; }
    f32x4 bt[8]; float carry = 0.f;
#pragma unroll
    for (int s = 0; s < 8; ++s) {
        const f32x4 z = mfma16(A[s], Bw, (f32x4){0.f, 0.f, 0.f, 0.f});
        const float l0 = logsig_fast(z[0] + bdv) * (1.f / 16.f), l1 = logsig_fast(z[1] + bdv) * (1.f / 16.f), l2 = logsig_fast(z[2] + bdv) * (1.f / 16.f), l3 = logsig_fast(z[3] + bdv) * (1.f / 16.f);
        f32x4 pr; float t;
        if (!dir) { pr[0] = l0; pr[1] = pr[0] + l1; pr[2] = pr[1] + l2; pr[3] = pr[2] + l3; t = pr[3]; }
        else      { pr[3] = l3; pr[2] = pr[3] + l2; pr[1] = pr[2] + l1; pr[0] = pr[1] + l0; t = pr[0]; }
        float t2;
        if (!dir) { const float u1 = __shfl_up(t, 16); const float t1 = t + (g >= 1 ? u1 : 0.f); const float u2 = __shfl_up(t1, 32); t2 = t1 + (g >= 2 ? u2 : 0.f); }
        else      { const float u1 = __shfl_down(t, 16); const float t1 = t + (g <= 2 ? u1 : 0.f); const float u2 = __shfl_down(t1, 32); t2 = t1 + (g <= 1 ? u2 : 0.f); }
        const float base = carry + (t2 - t);
        bt[s] = pr + base;
        carry += __shfl(t2, dir ? li : li + 48); }
#pragma unroll
    for (int s = 0; s < 8; ++s) { const int jt = dir ? 7 - s : s;
#pragma unroll
        for (int r = 0; r < 4; ++r) B[(16 * jt + 4 * g + r) * PB + 16 * wave + li] = bt[s][r]; }
    return carry;
}
__device__ __forceinline__ void gla_g1_unit(const bf16* P, const float* wd2, const float* bd, bf16* DS, float* DEC, int cid, int h, int dir, LAS unsigned char* lds, int tid, int lane, int wave) {
    const int unit = (cid * 4 + h) * 2 + dir;
    asm volatile("" : "+v"(tid)); (void)lane;
    u32x4 vr[8], rk[4]; v_tile_issue(P, cid, h, vr, tid);
#pragma unroll
    for (int i = 0; i < 4; ++i) { const int idx = tid + 512 * i, row = idx >> 4, ch = idx & 15; rk[i] = *(const u32x4*)(P + (size_t)(cid * CH + row) * NP + C_K + h * 128 + ch * 8); }
    LAS float* B = (LAS float*)(lds + L_V); LAS float* DECL = (LAS float*)(lds + L_DF);
    { const float tot = gla_decay_tile(P, wd2, bd, cid, h, dir, B, wave, tid);
      if (((tid >> 4) & 3) == 0) { const float dc = __expf(tot); DEC[(size_t)unit * 128 + 16 * wave + (tid & 15)] = dc; DECL[16 * wave + (tid & 15)] = dc; } }
    __syncthreads();
    { int t2 = tid; asm volatile("" : "+v"(t2));
#pragma unroll
      for (int i = 0; i < 4; ++i) { const int idx = t2 + 512 * i, j = idx >> 4, c = idx & 15;
          const f32x4 b0 = *(const LAS f32x4*)(B + j * PB + 8 * c), b1 = *(const LAS f32x4*)(B + j * PB + 8 * c + 4);
          f32x4 k0, k1; row_unpack8(rk[i], k0, k1);
#pragma unroll
          for (int t = 0; t < 4; ++t) { k0[t] = k0[t] * __expf(-b0[t]); k1[t] = k1[t] * __expf(-b1[t]); }
          u32x4 kw; kw.x = pg8::cvt_pk_bf16(k0[0], k0[1]); kw.y = pg8::cvt_pk_bf16(k0[2], k0[3]); kw.z = pg8::cvt_pk_bf16(k1[0], k1[1]); kw.w = pg8::cvt_pk_bf16(k1[2], k1[3]);
          *(LAS u32x4*)(lds + L_KT + j * PQ + c * 16) = kw; } }
    __syncthreads();
    v_tile_park(vr, lds + L_V, tid);
    __syncthreads();
    int t2 = tid; asm volatile("" : "+v"(t2));
    const int wdb = wave >> 1, we = wave & 1, g = (t2 >> 4) & 3, li = t2 & 15, q = li >> 2, p = li & 3;
    const LAS unsigned char* KT = lds + L_KT; const LAS unsigned char* V = lds + L_V;
    f32x4 acc[2][8];
#pragma unroll
    for (int dt = 0; dt < 2; ++dt)
#pragma unroll
        for (int et = 0; et < 8; ++et) acc[dt][et] = (f32x4){0.f, 0.f, 0.f, 0.f};
#pragma unroll
    for (int ks = 0; ks < 4; ++ks) { const int row = 32 * ks + 8 * g + q;
        bf16x8 X[2], Y[8];
#pragma unroll
        for (int dt = 0; dt < 2; ++dt) X[dt] = cat8(tr_read(KT + row * PQ + (32 * wdb + 16 * dt + 4 * p) * 2), tr_read(KT + (row + 4) * PQ + (32 * wdb + 16 * dt + 4 * p) * 2));
#pragma unroll
        for (int et = 0; et < 8; ++et) Y[et] = cat8(tr_read(V + row * PV + (128 * we + 16 * et + 4 * p) * 2), tr_read(V + (row + 4) * PV + (128 * we + 16 * et + 4 * p) * 2));
#pragma unroll
        for (int et = 0; et < 8; ++et) { acc[0][et] = mfma16(X[0], Y[et], acc[0][et]); acc[1][et] = mfma16(X[1], Y[et], acc[1][et]); } }
#pragma unroll
    for (int dt = 0; dt < 2; ++dt) { const int d0 = 32 * wdb + 16 * dt + 4 * g; const f32x4 dc = *(const LAS f32x4*)(DECL + d0);
#pragma unroll
        for (int et = 0; et < 8; ++et) { const int e = 128 * we + 16 * et + li; const f32x4 v = acc[dt][et] * dc; u32x2 w; w.x = pg8::cvt_pk_bf16(v[0], v[1]); w.y = pg8::cvt_pk_bf16(v[2], v[3]); *(u32x2*)(DS + ((size_t)unit * 256 + e) * 128 + d0) = w; } }
    __syncthreads();
}
__device__ __forceinline__ int gla_chain_cid(int s, int b, int dir) { return dir ? (s < 2 ? 128 + 2 * b + (1 - s) : 32 * b + 31 - (s - 2)) : (s < 2 ? 128 + 2 * b + s : 32 * b + (s - 2)); }
__device__ __forceinline__ void gla_g2_item(const bf16* DS, const float* DEC, bf16* SP, int item) {
    const int chain = item >> 13, ed = item & 8191, b = chain >> 3, h = (chain >> 1) & 3, dir = chain & 1, e = ed >> 5, d0 = (ed & 31) * 4;
    f32x4 S = {0.f, 0.f, 0.f, 0.f};
#pragma unroll 2
    for (int s = 0; s < 34; ++s) { const int cid = gla_chain_cid(s, b, dir), unit = (cid * 4 + h) * 2 + dir; const size_t off = ((size_t)unit * 256 + e) * 128 + d0;
        const f32x4 dec = *(const f32x4*)(DEC + (size_t)unit * 128 + d0); const u32x2 dw = *(const u32x2*)(DS + off);
        const f32x4 ds = {__uint_as_float(dw.x << 16), __uint_as_float(dw.x & 0xffff0000u), __uint_as_float(dw.y << 16), __uint_as_float(dw.y & 0xffff0000u)};
        u32x2 w; w.x = pk2(S[0], S[1]); w.y = pk2(S[2], S[3]); *(u32x2*)(SP + off) = w;
        S = dec * S + ds; }
}
__device__ __forceinline__ void gla_g3_unit(const bf16* P, const float* wd2f, const float* bdf, const float* wd2b, const float* bdb, const bf16* SP, const float* out_g, bf16* CAT, int cid, int h, LAS unsigned char* lds, int tid, int lane, int wave) {
    asm volatile("" : "+v"(tid));
    const int w = wave; (void)lane;
    const LAS unsigned char* QT = lds + L_QT; const LAS unsigned char* KT = lds + L_KT; LAS unsigned char* ST = lds + L_ST; const LAS unsigned char* V = lds + L_V;
    static_assert(L_KT == L_QT + 128 * PQ && 128 * PB * 4 <= 2 * 128 * PQ, "q~ and k~ tiles are adjacent and hold the b tile");
    f32x4 o[2][8];
#pragma unroll
    for (int et = 0; et < 2; ++et)
#pragma unroll
        for (int it = 0; it < 8; ++it) o[et][it] = (f32x4){0.f, 0.f, 0.f, 0.f};
#pragma unroll
    for (int dir = 0; dir < 2; ++dir) {
        const int unit = (cid * 4 + h) * 2 + dir;
        { u32x4 rk[4], rq[4];
#pragma unroll
          for (int i = 0; i < 4; ++i) { const int idx = tid + 512 * i, row = idx >> 4, ch = idx & 15; const bf16* pr = P + (size_t)(cid * CH + row) * NP + h * 128 + ch * 8; rk[i] = *(const u32x4*)(pr + C_K); rq[i] = *(const u32x4*)(pr + C_Q); }
          LAS float* B = (LAS float*)(lds + L_QT);
          (void)gla_decay_tile(P, dir ? wd2b : wd2f, dir ? bdb : bdf, cid, h, dir, B, wave, tid);
          u32x4 vr[8]; if (dir == 0) v_tile_issue(P, cid, h, vr, tid);
          __syncthreads();
          u32x4 qw[4], kw[4];
#pragma unroll
          for (int i = 0; i < 4; ++i) { const int idx = tid + 512 * i, j = idx >> 4, c = idx & 15;
              const f32x4 b0 = *(const LAS f32x4*)(B + j * PB + 8 * c), b1 = *(const LAS f32x4*)(B + j * PB + 8 * c + 4);
              f32x4 q0, q1, k0, k1; row_unpack8(rq[i], q0, q1); row_unpack8(rk[i], k0, k1);
              f32x4 e0, e1;
#pragma unroll
              for (int t = 0; t < 4; ++t) { e0[t] = __expf(b0[t]); e1[t] = __expf(b1[t]); }
              q0 = q0 * e0 * 0.08838834764831845f; q1 = q1 * e1 * 0.08838834764831845f;
#pragma unroll
              for (int t = 0; t < 4; ++t) { k0[t] = k0[t] * __builtin_amdgcn_rcpf(e0[t]); k1[t] = k1[t] * __builtin_amdgcn_rcpf(e1[t]); }
              qw[i].x = pg8::cvt_pk_bf16(q0[0], q0[1]); qw[i].y = pg8::cvt_pk_bf16(q0[2], q0[3]); qw[i].z = pg8::cvt_pk_bf16(q1[0], q1[1]); qw[i].w = pg8::cvt_pk_bf16(q1[2], q1[3]);
              kw[i].x = pg8::cvt_pk_bf16(k0[0], k0[1]); kw[i].y = pg8::cvt_pk_bf16(k0[2], k0[3]); kw[i].z = pg8::cvt_pk_bf16(k1[0], k1[1]); kw[i].w = pg8::cvt_pk_bf16(k1[2], k1[3]); }
          if (dir == 0) v_tile_park(vr, lds + L_V, tid);
          __syncthreads();
#pragma unroll
          for (int i = 0; i < 4; ++i) { const int idx = tid + 512 * i, j = idx >> 4, c = idx & 15; *(LAS u32x4*)(lds + L_QT + j * PQ + c * 16) = qw[i]; *(LAS u32x4*)(lds + L_KT + j * PQ + c * 16) = kw[i]; }
          __syncthreads(); }
        int t2 = tid; asm volatile("" : "+v"(t2));
        const int g = (t2 >> 4) & 3, li = t2 & 15, q = li >> 2, p = li & 3;
        bf16x8 XS[2][4];
#pragma unroll
        for (int et = 0; et < 2; ++et)
#pragma unroll
            for (int ks = 0; ks < 4; ++ks) XS[et][ks] = *(const bf16x8*)(SP + (size_t)unit * 32768 + (size_t)(32 * w + 16 * et + li) * 128 + 32 * ks + 8 * g);
        u32x2 pw[8];
        { bf16x8 Yq[4];
#pragma unroll
          for (int ks = 0; ks < 4; ++ks) Yq[ks] = *(const LAS bf16x8*)(QT + (16 * w + li) * PQ + (32 * ks + 8 * g) * 2);
#pragma unroll
          for (int kp = 0; kp < 4; ++kp) {
            f32x4 s0 = {0.f, 0.f, 0.f, 0.f}, s1 = {0.f, 0.f, 0.f, 0.f};
            const int t0 = 2 * kp, t1 = 2 * kp + 1;
            const bool a0 = dir ? (t0 >= w) : (t0 <= w), a1 = dir ? (t1 >= w) : (t1 <= w);
            if (a0 && a1) {
                bf16x8 K0[4], K1[4];
#pragma unroll
                for (int ks = 0; ks < 4; ++ks) { K0[ks] = *(const LAS bf16x8*)(KT + (16 * t0 + li) * PQ + (32 * ks + 8 * g) * 2); K1[ks] = *(const LAS bf16x8*)(KT + (16 * t1 + li) * PQ + (32 * ks + 8 * g) * 2); }
#pragma unroll
                for (int ks = 0; ks < 4; ++ks) { s0 = mfma16(K0[ks], Yq[ks], s0); s1 = mfma16(K1[ks], Yq[ks], s1); }
            } else if (a0) {
                bf16x8 K0[4];
#pragma unroll
                for (int ks = 0; ks < 4; ++ks) K0[ks] = *(const LAS bf16x8*)(KT + (16 * t0 + li) * PQ + (32 * ks + 8 * g) * 2);
#pragma unroll
                for (int ks = 0; ks < 4; ++ks) s0 = mfma16(K0[ks], Yq[ks], s0);
            } else if (a1) {
                bf16x8 K1[4];
#pragma unroll
                for (int ks = 0; ks < 4; ++ks) K1[ks] = *(const LAS bf16x8*)(KT + (16 * t1 + li) * PQ + (32 * ks + 8 * g) * 2);
#pragma unroll
                for (int ks = 0; ks < 4; ++ks) s1 = mfma16(K1[ks], Yq[ks], s1);
            }
            if (t0 == w) {
#pragma unroll
                for (int r = 0; r < 4; ++r) { const bool keep = dir ? (4 * g + r >= li) : (4 * g + r <= li); s0[r] = keep ? s0[r] : 0.f; } }
            if (t1 == w) {
#pragma unroll
                for (int r = 0; r < 4; ++r) { const bool keep = dir ? (4 * g + r >= li) : (4 * g + r <= li); s1[r] = keep ? s1[r] : 0.f; } }
            pw[t0].x = pg8::cvt_pk_bf16(s0[0], s0[1]); pw[t0].y = pg8::cvt_pk_bf16(s0[2], s0[3]); pw[t1].x = pg8::cvt_pk_bf16(s1[0], s1[1]); pw[t1].y = pg8::cvt_pk_bf16(s1[2], s1[3]);
          } }
        __syncthreads();
        LAS unsigned char* PT = lds + L_KT;
#pragma unroll
        for (int jt = 0; jt < 8; ++jt) *(LAS u32x2*)(PT + (16 * w + li) * PQ + (16 * jt + 4 * g) * 2) = pw[jt];
        bf16x8 Xv[2][4];
#pragma unroll
        for (int et = 0; et < 2; ++et)
#pragma unroll
            for (int kp = 0; kp < 4; ++kp) Xv[et][kp] = cat8(tr_read(V + (32 * kp + 8 * g + q) * PV + (32 * w + 16 * et + 4 * p) * 2), tr_read(V + (32 * kp + 8 * g + q + 4) * PV + (32 * w + 16 * et + 4 * p) * 2));
        __syncthreads();
#pragma unroll
        for (int it = 0; it < 8; ++it) {
            bf16x8 Yi[4];
#pragma unroll
            for (int ks = 0; ks < 4; ++ks) Yi[ks] = *(const LAS bf16x8*)(QT + (16 * it + li) * PQ + (32 * ks + 8 * g) * 2);
            bf16x8 Pf[4];
#pragma unroll
            for (int kp = 0; kp < 4; ++kp) { const bool act = dir ? (kp >= (it >> 1)) : (kp <= (it >> 1)); if (act) Pf[kp] = *(const LAS bf16x8*)(PT + (16 * it + li) * PQ + (32 * kp + 8 * g) * 2); }
#pragma unroll
            for (int ks = 0; ks < 4; ++ks) { o[0][it] = mfma16(XS[0][ks], Yi[ks], o[0][it]); o[1][it] = mfma16(XS[1][ks], Yi[ks], o[1][it]); }
#pragma unroll
            for (int kp = 0; kp < 4; ++kp) { const bool act = dir ? (kp >= (it >> 1)) : (kp <= (it >> 1));
                if (act) { o[0][it] = mfma16(Xv[0][kp], Pf[kp], o[0][it]); o[1][it] = mfma16(Xv[1][kp], Pf[kp], o[1][it]); } }
        }
        __syncthreads();
    }
    int t3 = tid; asm volatile("" : "+v"(t3));
    const int g = (t3 >> 4) & 3, li = t3 & 15;
    u32x2 gwv[2][8];
#pragma unroll
    for (int et = 0; et < 2; ++et)
#pragma unroll
        for (int it = 0; it < 8; ++it) gwv[et][it] = *(const u32x2*)(P + ((size_t)cid * CH + 16 * it + li) * NP + C_G + h * 256 + 32 * w + 16 * et + 4 * g);
    LAS float* RED = (LAS float*)(lds + L_DF);
#pragma unroll
    for (int it = 0; it < 8; ++it) { float s = 0.f;
#pragma unroll
        for (int et = 0; et < 2; ++et) s += (o[et][it][0] * o[et][it][0] + o[et][it][1] * o[et][it][1]) + (o[et][it][2] * o[et][it][2] + o[et][it][3] * o[et][it][3]);
        s += __shfl_xor(s, 16); s += __shfl_xor(s, 32);
        if (g == 0) RED[w * 128 + 16 * it + li] = s; }
    __syncthreads();
    f32x4 gg[2];
#pragma unroll
    for (int et = 0; et < 2; ++et) gg[et] = *(const f32x4*)(out_g + h * 256 + 32 * w + 16 * et + 4 * g);
#pragma unroll
    for (int it = 0; it < 8; ++it) { float tot = 0.f;
#pragma unroll
        for (int ww = 0; ww < 8; ++ww) tot += RED[ww * 128 + 16 * it + li];
        const float rstd = rsqrtf(tot * (1.f / 256.f) + EPS); const size_t row = (size_t)cid * CH + 16 * it + li;
#pragma unroll
        for (int et = 0; et < 2; ++et) { const u32x2 gw = gwv[et][it];
            const float g0 = __uint_as_float(gw.x << 16), g1 = __uint_as_float(gw.x & 0xffff0000u), g2 = __uint_as_float(gw.y << 16), g3 = __uint_as_float(gw.y & 0xffff0000u);
            u32x2 ow; ow.x = pk2(o[et][it][0] * rstd * gg[et][0] * silu_acc(g0), o[et][it][1] * rstd * gg[et][1] * silu_acc(g1)); ow.y = pk2(o[et][it][2] * rstd * gg[et][2] * silu_acc(g2), o[et][it][3] * rstd * gg[et][3] * silu_acc(g3));
            *(u32x2*)(CAT + row * D + 1024 + h * 256 + 32 * w + 16 * et + 4 * g) = ow; } }
}

__device__ __forceinline__ void gmlp_unit_fast(const bf16* P, bf16* CAT, const float* ln_g, const float* ln_b, const bf16* WSB, const float* bs, int cid, int h, LAS unsigned char* lds, int tid, int wave) {
    asm volatile("" : "+v"(tid));
    LAS unsigned char* VL = lds;
    const int g = (tid >> 4) & 3, li = tid & 15, q = li >> 2, p = li & 3, w = wave;
    const size_t row = (size_t)cid * CH + 16 * w + li;
    bf16x8 Yw[4]; u32x2 uw[8];
#pragma unroll
    for (int ks = 0; ks < 4; ++ks) Yw[ks] = *(const bf16x8*)(WSB + ((size_t)(h * CH + 16 * w + li)) * CH + 32 * ks + 8 * g);
#pragma unroll
    for (int dt = 0; dt < 8; ++dt) uw[dt] = *(const u32x2*)(P + row * NP + C_U + h * 128 + 16 * dt + 4 * g);
    const float bsv = bs[h * CH + 16 * w + li];
    { const int j = tid >> 2, qd = tid & 3; const bf16* vp = P + (size_t)(cid * CH + j) * NP + C_V + h * 128 + qd * 32;
      float v[32]; float s = 0.f;
#pragma unroll
      for (int i = 0; i < 4; ++i) { const u32x4 w = *(const u32x4*)(vp + 8 * i);
#pragma unroll
          for (int e = 0; e < 4; ++e) { v[8 * i + 2 * e] = __uint_as_float(w[e] << 16); v[8 * i + 2 * e + 1] = __uint_as_float(w[e] & 0xffff0000u); } }
#pragma unroll
      for (int i = 0; i < 32; ++i) s += v[i];
      s += __shfl_xor(s, 1); s += __shfl_xor(s, 2); const float mu = s * (1.f / 128.f); float q = 0.f;
#pragma unroll
      for (int i = 0; i < 32; ++i) { v[i] -= mu; q += v[i] * v[i]; }
      q += __shfl_xor(q, 1); q += __shfl_xor(q, 2); const float rstd = rsqrtf(q * (1.f / 128.f) + EPS);
      const float* gp = ln_g + h * 128 + qd * 32; const float* bp = ln_b + h * 128 + qd * 32;
#pragma unroll
      for (int i = 0; i < 4; ++i) { const f32x4 g0 = *(const f32x4*)(gp + 8 * i), g1 = *(const f32x4*)(gp + 8 * i + 4), b0 = *(const f32x4*)(bp + 8 * i), b1 = *(const f32x4*)(bp + 8 * i + 4);
          u32x4 o; o.x = pk2(v[8 * i + 0] * rstd * g0[0] + b0[0], v[8 * i + 1] * rstd * g0[1] + b0[1]); o.y = pk2(v[8 * i + 2] * rstd * g0[2] + b0[2], v[8 * i + 3] * rstd * g0[3] + b0[3]);
          o.z = pk2(v[8 * i + 4] * rstd * g1[0] + b1[0], v[8 * i + 5] * rstd * g1[1] + b1[1]); o.w = pk2(v[8 * i + 6] * rstd * g1[2] + b1[2], v[8 * i + 7] * rstd * g1[3] + b1[3]);
          *(LAS u32x4*)(VL + j * PQ + (qd * 32 + 8 * i) * 2) = o; } }
    __syncthreads();
    f32x4 acc[8];
#pragma unroll
    for (int dt = 0; dt < 8; ++dt) acc[dt] = (f32x4){0.f, 0.f, 0.f, 0.f};
#pragma unroll
    for (int ks = 0; ks < 4; ++ks) {
        bf16x8 X[8];
#pragma unroll
        for (int dt = 0; dt < 8; ++dt) X[dt] = cat8(tr_read(VL + (32 * ks + 8 * g + q) * PQ + (16 * dt + 4 * p) * 2), tr_read(VL + (32 * ks + 8 * g + q + 4) * PQ + (16 * dt + 4 * p) * 2));
#pragma unroll
        for (int dt = 0; dt < 8; ++dt) acc[dt] = mfma16(X[dt], Yw[ks], acc[dt]);
    }
#pragma unroll
    for (int dt = 0; dt < 8; ++dt) { const int c0 = h * 128 + 16 * dt + 4 * g;
        const float u0 = __uint_as_float(uw[dt].x << 16), u1 = __uint_as_float(uw[dt].x & 0xffff0000u), u2 = __uint_as_float(uw[dt].y << 16), u3 = __uint_as_float(uw[dt].y & 0xffff0000u);
        u32x2 ow; ow.x = pk2(u0 * (acc[dt][0] + bsv), u1 * (acc[dt][1] + bsv)); ow.y = pk2(u2 * (acc[dt][2] + bsv), u3 * (acc[dt][3] + bsv));
        *(u32x2*)(CAT + row * D + c0) = ow; }
    __syncthreads();
}

constexpr int NPH = 2 + 9 * NL;
struct Args { const float* in[23]; float* out; unsigned char* ws; int ph_lo, ph_hi, li, pad; };

#ifndef DUP_MASK
#define DUP_MASK 0
#endif
#define REP(bit) for (int rep_ = 0; rep_ < (((DUP_MASK) >> (bit)) & 1) + 1; ++rep_)
#define IN(k) (lo <= (k) && (k) < hi)
#define PHASE_IDS() int tid = tid0; asm volatile("" : "+v"(tid)); const int lane = tid & 63, wave = __builtin_amdgcn_readfirstlane(tid >> 6), gw = bid * 8 + wave, ngw = G * 8; (void)lane; (void)gw; (void)ngw
#define SEAM(k) do { if (IN(k) && IN((k) + 1)) xcd_barrier(bar); } while (0)
template <int l> __device__ __forceinline__ void run_layer(const Args& a, LAS unsigned char* lds, const XcdBarrier& bar, int tid0, int G, int bid, int lo, int hi) {
    unsigned char* ws = a.ws;
    const float* x = a.in[0]; const float* ctx = a.in[2];
    const float* g_pre_mix = a.in[6]; const float* g_post_mix = a.in[7]; const float* g_pre_ffn = a.in[8]; const float* g_post_ffn = a.in[9];
    const float* ln_g = a.in[11]; const float* ln_b = a.in[12]; const float* gws = a.in[13]; const float* gbs = a.in[14];
    const float* wd2f = a.in[15]; const float* bdf = a.in[16]; const float* wd2b = a.in[17]; const float* bdb = a.in[18];
    const float* out_g = a.in[19];
    float* MOD = (float*)(ws + WS_MOD); bf16* WIN = (bf16*)(ws + WS_WIN); bf16* WOUT = (bf16*)(ws + WS_WOUT); bf16* WFI = (bf16*)(ws + WS_WFI); bf16* WFO = (bf16*)(ws + WS_WFO);
    bf16* X = (bf16*)(ws + WS_X); bf16* H = (bf16*)(ws + WS_H); bf16* P = (bf16*)(ws + WS_P); bf16* CAT = (bf16*)(ws + WS_CAT); bf16* Y = (bf16*)(ws + WS_Y); bf16* HID = (bf16*)(ws + WS_HID);
    bf16* DS = (bf16*)(ws + WS_DS); bf16* SP = (bf16*)(ws + WS_SP); float* DEC = (float*)(ws + WS_DEC); bf16* WSB = (bf16*)(ws + WS_WSB); bf16* QKG = (bf16*)(ws + WS_QK); float* YP = (float*)(ws + WS_YP);
        const int pb = 2 + 9 * l;
        constexpr bool LAST = (l == NL - 1);
        constexpr int NCH_OUT = LAST ? MX / CH : NCHUNK, MROWS = LAST ? MX : M;
        const float* modl = MOD + (size_t)l * 5 * NMOD;
        if (IN(pb + 0)) REP(1) { pg8::Gemm g{H, WIN + (size_t)l * NP * D, M, NP, D, D}; pg8::StaticOrder S; S.init(M, NP, G, bid); pg8::EpiProj E{P, NP, 8};
            pg8::gemm_phase<pg8::EpiProj, pg8::StaticOrder, true, true>(lds, g, S, E); }
        SEAM(pb + 0);
        constexpr int NGM = NCH_OUT * 8, NGM1 = 384;
        if (IN(pb + 1)) REP(2) { PHASE_IDS();
            for (int u = bid; u < NCHUNK * 8; u += G) { const int dir = u & 1, h = (u >> 1) & 3, cid = u >> 3;
                gla_g1_unit(P, (dir ? wd2b : wd2f) + l * 16 * 512, (dir ? bdb : bdf) + l * 512, DS, DEC, cid, h, dir, lds, tid, lane, wave); }
            if (G == 256) { if (bid >= 64) for (int u = bid - 64; u < NGM1; u += 192)
                gmlp_unit_fast(P, CAT, ln_g + l * 1024, ln_b + l * 1024, WSB + (size_t)l * 8 * CH * CH, gbs + l * 8 * CH, u >> 3, u & 7, lds, tid, wave); }
            else for (int u = bid; u < NGM1; u += G)
                gmlp_unit_fast(P, CAT, ln_g + l * 1024, ln_b + l * 1024, WSB + (size_t)l * 8 * CH * CH, gbs + l * 8 * CH, u >> 3, u & 7, lds, tid, wave);
        }
        SEAM(pb + 1);
        if (IN(pb + 2)) REP(3) { PHASE_IDS();
            for (int it = bid * 512 + tid; it < 32 * 8192; it += G * 512) gla_g2_item(DS, DEC, SP, it);
        }
        SEAM(pb + 2);
        if (IN(pb + 3)) REP(4) { PHASE_IDS();
            for (int u = bid; u < NCH_OUT * 4; u += G)
                gla_g3_unit(P, wd2f + l * 16 * 512, bdf + l * 512, wd2b + l * 16 * 512, bdb + l * 512, SP, out_g + l * 1024, CAT, u >> 2, u & 3, lds, tid, lane, wave);
            if (G == 256 && !LAST) { if (bid >= 32) for (int u = NGM1 + bid - 32; u < NGM; u += 224)
                gmlp_unit_fast(P, CAT, ln_g + l * 1024, ln_b + l * 1024, WSB + (size_t)l * 8 * CH * CH, gbs + l * 8 * CH, u >> 3, u & 7, lds, tid, wave); }
            else for (int u = NGM1 + bid; u < NGM; u += G)
                gmlp_unit_fast(P, CAT, ln_g + l * 1024, ln_b + l * 1024, WSB + (size_t)l * 8 * CH * CH, gbs + l * 8 * CH, u >> 3, u & 7, lds, tid, wave);
        }
        SEAM(pb + 3);
        if (IN(pb + 4)) REP(5) { { pg8::Gemm g{CAT, WOUT + (size_t)l * D * D, MX, D, D, D}; pg8::StaticOrder S; S.init(MX, D, G, bid); pg8::EpiProj E{Y, D, 0};
              pg8::gemm_phase<pg8::EpiProj, pg8::StaticOrder, true, true>(lds, g, S, E); }
            if (!LAST) { pg8::Gemm g{CAT + (size_t)MX * D, WOUT + (size_t)l * D * D, MC, D, D, D}; pg8::SplitOrder S; S.init(MC / 256, D / 256, D / 64, bid); pg8::EpiPartF32 E{YP, D, 0, (size_t)MC * D};
              pg8::gemm_phase<pg8::EpiPartF32, pg8::SplitOrder, false, true>(lds, g, S, E); } }
        SEAM(pb + 4);
        if (IN(pb + 5)) { PHASE_IDS();
            RowArgs r{}; r.xin_x = l == 0 ? x : nullptr; r.xin_c = l == 0 ? ctx : nullptr; r.Y = Y; r.YP = LAST ? nullptr : YP; r.X = X; r.Xw = X; r.H = H; r.modA = modl; r.gA = g_post_mix + l * D; r.gB = g_pre_ffn + l * D; r.mode = 1; r.write_h = 1;
            if ((DUP_MASK >> 8) & 1) { RowArgs d = r; d.Xw = (bf16*)HID; d.H = (bf16*)(ws + WS_QK); d.out = (float*)HID; row_phase(d, MROWS, lds, tid, lane, gw, ngw); }
            row_phase(r, MROWS, lds, tid, lane, gw, ngw);
        }
        SEAM(pb + 5);
        if (IN(pb + 6)) REP(6) { pg8::Gemm g{H, WFI + (size_t)l * 2 * FF * D, MROWS, 2 * FF, D, D}; pg8::StaticOrder S; S.init(MROWS, 2 * FF, G, bid); pg8::EpiSwiglu E{HID, FF};
            pg8::gemm_phase<pg8::EpiSwiglu, pg8::StaticOrder, true, true>(lds, g, S, E); }
        SEAM(pb + 6);
        if (IN(pb + 7)) REP(7) { { pg8::Gemm g{HID, WFO + (size_t)l * D * FF, MX, D, FF, FF}; pg8::StaticOrder S; S.init(MX, D, G, bid); pg8::EpiProj E{Y, D, 0};
              pg8::gemm_phase<pg8::EpiProj, pg8::StaticOrder, true, true>(lds, g, S, E); }
            if (!LAST) { pg8::Gemm g{HID + (size_t)MX * FF, WFO + (size_t)l * D * FF, MC, D, FF, FF}; pg8::SplitOrder S; S.init(MC / 256, D / 256, FF / 64, bid); pg8::EpiPartF32 E{YP, D, 0, (size_t)MC * D};
              pg8::gemm_phase<pg8::EpiPartF32, pg8::SplitOrder, false, true>(lds, g, S, E); } }
        SEAM(pb + 7);
        if (IN(pb + 8)) { PHASE_IDS();
            RowArgs r{}; r.Y = Y; r.YP = LAST ? nullptr : YP; r.X = X; r.Xw = X; r.out = a.out; r.H = H; r.modA = modl; r.modB = modl + 5 * NMOD; r.gA = g_post_ffn + l * D; r.gB = g_pre_mix + (l + 1 < NL ? l + 1 : l) * D; r.mode = 2; r.write_h = (l + 1 < NL); r.to_out = (l + 1 == NL);
            if ((DUP_MASK >> 8) & 1) { RowArgs d = r; d.Xw = (bf16*)HID; d.H = (bf16*)(ws + WS_QK); d.out = (float*)HID; row_phase(d, MROWS, lds, tid, lane, gw, ngw); }
            row_phase(r, MROWS, lds, tid, lane, gw, ngw);
        }
        SEAM(pb + 8);
}
__global__ void __launch_bounds__(512, 2) mega(Args a) {
    extern __shared__ __attribute__((aligned(16))) unsigned char lds_raw[];
    LAS unsigned char* lds = (LAS unsigned char*)lds_raw;
    const int tid0 = threadIdx.x;
    const int G = gridDim.x, bid = blockIdx.x;
    volatile LAS unsigned* MISC = (volatile LAS unsigned*)(lds + MISC_OFF);
    if (tid0 < 32) MISC[tid0] = 0u;
    __syncthreads();
    unsigned char* ws = a.ws;
    const int lo = a.ph_lo, hi = a.ph_hi;
    XcdBarrier bar; bar.bar = (unsigned*)(ws + WS_CTL) + CW_BAR + a.li * XCD_BAR_WORDS; bar.x = 0; bar.st = nullptr;
    if (hi - lo > 1) bar = xcd_barrier_post((unsigned*)(ws + WS_CTL) + CW_BAR + a.li * XCD_BAR_WORDS, MISC + 8);
    const float* x = a.in[0]; const float* c = a.in[1]; const float* ctx = a.in[2]; const float* cctx = a.in[3];
    const float* w_mod = a.in[4]; const float* b_mod = a.in[5];
    const float* g_pre_mix = a.in[6]; const float* g_post_mix = a.in[7]; const float* g_pre_ffn = a.in[8]; const float* g_post_ffn = a.in[9];
    const float* w_in = a.in[10]; const float* ln_g = a.in[11]; const float* ln_b = a.in[12]; const float* gws = a.in[13]; const float* gbs = a.in[14];
    const float* wd2f = a.in[15]; const float* bdf = a.in[16]; const float* wd2b = a.in[17]; const float* bdb = a.in[18];
    const float* out_g = a.in[19]; const float* w_out = a.in[20]; const float* w_fi = a.in[21]; const float* w_fo = a.in[22];
    float* MOD = (float*)(ws + WS_MOD); bf16* WIN = (bf16*)(ws + WS_WIN); bf16* WOUT = (bf16*)(ws + WS_WOUT); bf16* WFI = (bf16*)(ws + WS_WFI); bf16* WFO = (bf16*)(ws + WS_WFO);
    bf16* X = (bf16*)(ws + WS_X); bf16* H = (bf16*)(ws + WS_H); bf16* P = (bf16*)(ws + WS_P); bf16* CAT = (bf16*)(ws + WS_CAT); bf16* Y = (bf16*)(ws + WS_Y); bf16* HID = (bf16*)(ws + WS_HID);
    bf16* DS = (bf16*)(ws + WS_DS); bf16* SP = (bf16*)(ws + WS_SP); float* DEC = (float*)(ws + WS_DEC); bf16* WSB = (bf16*)(ws + WS_WSB); bf16* QKG = (bf16*)(ws + WS_QK); float* YP = (float*)(ws + WS_YP);

    if (IN(0)) REP(0) { PHASE_IDS();
        LAS float* act = (LAS float*)(lds + 8 * 8448);
        for (int i = tid; i < 5 * D; i += 512) { const int r = i / D, k = i % D; const float v = r < NB ? c[r * D + k] : cctx[k]; act[i] = silu_acc(v); }
        __syncthreads();
        for (int item = wave * G + bid; item < NL * (NMOD / 32); item += ngw) {
            const int cg = item % (NMOD / 32), l = item / (NMOD / 32), kq = lane >> 3;
            const int j = cg * 32 + 4 * (lane & 7);
            const float* w = w_mod + ((size_t)l * D + kq) * NMOD + j;
            f32x4 a0 = {0.f, 0.f, 0.f, 0.f}, a1 = a0, a2 = a0, a3 = a0, a4 = a0;
#pragma unroll 8
            for (int i = 0; i < D / 8; ++i) { const f32x4 xv = __builtin_nontemporal_load((const f32x4*)(w + (size_t)(8 * i) * NMOD)); const int k = 8 * i + kq;
                a0 += xv * act[0 * D + k]; a1 += xv * act[1 * D + k]; a2 += xv * act[2 * D + k]; a3 += xv * act[3 * D + k]; a4 += xv * act[4 * D + k]; }
#pragma unroll
            for (int t = 0; t < 4; ++t) {
#pragma unroll
                for (int o = 8; o < 64; o <<= 1) { a0[t] += __shfl_xor(a0[t], o); a1[t] += __shfl_xor(a1[t], o); a2[t] += __shfl_xor(a2[t], o); a3[t] += __shfl_xor(a3[t], o); a4[t] += __shfl_xor(a4[t], o); } }
            if (kq == 0) { const f32x4 bb = *(const f32x4*)(b_mod + (size_t)l * NMOD + j); float* o = MOD + (size_t)l * 5 * NMOD + j;
                *(f32x4*)(o) = a0 + bb; *(f32x4*)(o + NMOD) = a1 + bb; *(f32x4*)(o + 2 * NMOD) = a2 + bb; *(f32x4*)(o + 3 * NMOD) = a3 + bb; *(f32x4*)(o + 4 * NMOD) = a4 + bb; }
        }
        for (int it = bid * 512 + tid; it < NL * 8 * CH * CH / 8; it += G * 512) { const f32x4 a0 = *(const f32x4*)(gws + (size_t)it * 8), a1 = *(const f32x4*)(gws + (size_t)it * 8 + 4);
            u32x4 o; o.x = pk2(a0[0], a0[1]); o.y = pk2(a0[2], a0[3]); o.z = pk2(a1[0], a1[1]); o.w = pk2(a1[2], a1[3]); *(u32x4*)(WSB + (size_t)it * 8) = o; }
        LAS float* scr = (LAS float*)(lds + wave * 8448);
        int it0 = 0;
        conv_matrix(w_in, WIN, D, PIN, NP, 1, it0, gw, ngw, scr, lane);
        conv_matrix(w_out, WOUT, D, D, D, 0, it0, gw, ngw, scr, lane);
        conv_matrix(w_fi, WFI, D, 2 * FF, 2 * FF, 2, it0, gw, ngw, scr, lane);
        conv_matrix(w_fo, WFO, FF, D, D, 0, it0, gw, ngw, scr, lane);
    }
    SEAM(0);
    if (IN(1)) { PHASE_IDS();
        RowArgs r{}; r.xin_x = x; r.xin_c = ctx; r.X = X; r.Xw = X; r.H = H; r.modB = MOD; r.gB = g_pre_mix; r.mode = 0; r.write_h = 1;
        row_phase(r, M, lds, tid, lane, gw, ngw);
    }
    SEAM(1);
    run_layer<0>(a, lds, bar, tid0, G, bid, lo, hi);
    run_layer<1>(a, lds, bar, tid0, G, bid, lo, hi);
    run_layer<2>(a, lds, bar, tid0, G, bid, lo, hi);
    run_layer<3>(a, lds, bar, tid0, G, bid, lo, hi);
#undef IN
#undef SEAM
}

#ifndef MK_SPLIT
#define MK_SPLIT 0
#endif
extern "C" void kernel_launch(void* const* d_in, const int* in_sizes, int n_in, void* d_out, int out_size, void* d_ws, size_t ws_size, hipStream_t stream) {
    static int grid = 0;
    if (grid == 0) {
        if (n_in != 23 || ws_size < WS_END || out_size != MX * D) { fprintf(stderr, "kernel_launch: unexpected shapes (n_in %d, ws %zu, out %d)\n", n_in, ws_size, out_size); grid = -1; return; }
        int dev = 0, cus = 0, per_cu = 0;
        if (hipGetDevice(&dev) != hipSuccess || hipDeviceGetAttribute(&cus, hipDeviceAttributeMultiprocessorCount, dev) != hipSuccess) { grid = -1; return; }
        if (hipFuncSetAttribute((const void*)mega, hipFuncAttributeMaxDynamicSharedMemorySize, LDS_BYTES) != hipSuccess) { fprintf(stderr, "kernel_launch: hipFuncSetAttribute failed\n"); grid = -1; return; }
        if (hipOccupancyMaxActiveBlocksPerMultiprocessor(&per_cu, (const void*)mega, 512, LDS_BYTES) != hipSuccess || per_cu < 1) { fprintf(stderr, "kernel_launch: occupancy query says %d\n", per_cu); }
        (void)hipGetLastError();
        grid = cus;
    }
    if (grid < 0) return;
    (void)hipMemsetAsync((char*)d_ws + WS_CTL, 0, ZERO_BYTES, stream);
    Args a{};
    for (int i = 0; i < 23; ++i) a.in[i] = (const float*)d_in[i];
    a.out = (float*)d_out; a.ws = (unsigned char*)d_ws;
#if MK_SPLIT
    for (int p = 0; p < NPH; ++p) { a.ph_lo = p; a.ph_hi = p + 1; a.li = 0; hipLaunchKernelGGL(mega, dim3(grid), dim3(512), LDS_BYTES, stream, a); }
#else
    a.ph_lo = 0; a.ph_hi = NPH; a.li = 0;
    hipLaunchKernelGGL(mega, dim3(grid), dim3(512), LDS_BYTES, stream, a);
#endif
}
```
